# Optimizing an MI355X kernel written in HIP

```python
import jax, jax.numpy as jnp
from jax import lax
import numpy as np

D_MODEL = 1024
BATCH = 16
SEQ = 2048
DEPTH = 4

GRID_W = 64
CTX_LEN = 256
N_MIXERS = 3
ROPE_THETA = 10000.0
EPS = 1e-6
Q_BLOCK = 128
NEG_INF = -1e30

A_HEADS = 16
A_KV_HEADS = 4
A_HEAD_DIM = 64
B_HEADS = 16
B_Q_RANK = 384
B_KV_RANK = 256
B_NOPE_DIM = 64
B_ROPE_DIM = 32
B_V_DIM = 64
C_HEADS = 16
C_HEAD_DIM = 64
NA_ROWS = 8
NA_COLS = 16
N_EXPERTS = 16
EXPERT_FF = 1024
EC_CAPACITY_FACTOR = 2

N_A = (DEPTH + 2) // 3
N_B = (DEPTH + 1) // 3
N_C = DEPTH // 3

kernel_name = "hybrid_diffusion_gqa_mla_natten_ecmoe"


def rms_norm(x, w):
    xf = x.astype(jnp.float32)
    y = xf * lax.rsqrt(jnp.mean(xf * xf, axis=-1, keepdims=True) + EPS)
    return (y * w.astype(jnp.float32)).astype(x.dtype)


def modulate(h, shift, scale):
    return h * (1.0 + scale[:, None]) + shift[:, None]


def axial_rope_tables(n_tokens, rot_dim, dtype):
    n_freq = rot_dim // 4
    inv = jnp.float32(ROPE_THETA) ** (-jnp.arange(n_freq, dtype=jnp.float32) / n_freq)
    t = jnp.arange(n_tokens, dtype=jnp.int32)
    row = (t // GRID_W).astype(jnp.float32)
    col = (t % GRID_W).astype(jnp.float32)
    ang = jnp.concatenate([row[:, None] * inv, col[:, None] * inv], axis=-1)
    return jnp.cos(ang).astype(dtype), jnp.sin(ang).astype(dtype)


def apply_rope(x, cos, sin):
    half = x.shape[-1] // 2
    x1, x2 = x[..., :half], x[..., half:]
    shp = (1, x.shape[1]) + (1,) * (x.ndim - 3) + (half,)
    c, s = cos.reshape(shp), sin.reshape(shp)
    return jnp.concatenate([x1 * c - x2 * s, x1 * s + x2 * c], axis=-1)


def attend(q, k, v):
    scale = q.shape[-1] ** -0.5
    s = jnp.einsum('bqhgd,bkhd->bhgqk', q, k, preferred_element_type=jnp.float32) * scale
    p = jax.nn.softmax(s, axis=-1).astype(v.dtype)
    return jnp.einsum('bhgqk,bkhd->bqhgd', p, v)


def blocked_attend(q, k, v):
    B, T = q.shape[:2]
    nb = T // Q_BLOCK
    qb = jnp.moveaxis(q.reshape((B, nb, Q_BLOCK) + q.shape[2:]), 1, 0)
    ob = lax.map(lambda qi: attend(qi, k, v), qb)
    return jnp.moveaxis(ob, 0, 1).reshape((B, T) + ob.shape[3:])


def gqa_axial_mixer(h_lat, h_ctx, w_qkv, q_norm, k_norm, w_o, need_ctx):
    G = A_HEADS // A_KV_HEADS
    nq = A_HEADS * A_HEAD_DIM
    nk = A_KV_HEADS * A_HEAD_DIM

    def project(h):
        B, T, _ = h.shape
        qkv = h @ w_qkv
        q = qkv[..., :nq].reshape(B, T, A_KV_HEADS, G, A_HEAD_DIM)
        k = qkv[..., nq:nq + nk].reshape(B, T, A_KV_HEADS, A_HEAD_DIM)
        v = qkv[..., nq + nk:].reshape(B, T, A_KV_HEADS, A_HEAD_DIM)
        return rms_norm(q, q_norm), rms_norm(k, k_norm), v

    B, T = h_lat.shape[:2]
    q_l, k_l, v_l = project(h_lat)
    q_c, k_c, v_c = project(h_ctx)
    cos, sin = axial_rope_tables(T, A_HEAD_DIM, h_lat.dtype)
    q_l = apply_rope(q_l, cos, sin)
    k_l = apply_rope(k_l, cos, sin)
    k_all = jnp.concatenate([k_c, k_l], axis=1)
    v_all = jnp.concatenate([v_c, v_l], axis=1)
    out_l = blocked_attend(q_l, k_all, v_all).reshape(B, T, nq) @ w_o
    out_c = None
    if need_ctx:
        out_c = attend(q_c, k_c, v_c).reshape(B, h_ctx.shape[1], nq) @ w_o
    return out_l, out_c


def mla_mixer(h_lat, h_ctx, w_dq, q_lat_norm, w_uq, w_dkv, kv_lat_norm, w_ukv, q_norm, k_norm, w_o, need_ctx):
    qd = B_NOPE_DIM + B_ROPE_DIM

    def project(h):
        B, T, _ = h.shape
        cq = rms_norm(h @ w_dq, q_lat_norm)
        q = (cq @ w_uq).reshape(B, T, B_HEADS, qd)
        kv_a = h @ w_dkv
        ckv = rms_norm(kv_a[..., :B_KV_RANK], kv_lat_norm)
        k_rope = kv_a[..., B_KV_RANK:]
        kv = (ckv @ w_ukv).reshape(B, T, B_HEADS, B_NOPE_DIM + B_V_DIM)
        q_nope = rms_norm(q[..., :B_NOPE_DIM], q_norm[:B_NOPE_DIM])
        q_rope = rms_norm(q[..., B_NOPE_DIM:], q_norm[B_NOPE_DIM:])
        k_nope = rms_norm(kv[..., :B_NOPE_DIM], k_norm[:B_NOPE_DIM])
        k_rope = rms_norm(k_rope, k_norm[B_NOPE_DIM:])
        return q_nope, q_rope, k_nope, k_rope, kv[..., B_NOPE_DIM:]

    def assemble(q_nope, q_rope, k_nope, k_rope, v):
        q = jnp.concatenate([q_nope, q_rope], axis=-1)[:, :, :, None, :]
        k_rope_h = jnp.broadcast_to(k_rope[:, :, None, :], k_nope.shape[:3] + (B_ROPE_DIM,))
        k = jnp.concatenate([k_nope, k_rope_h], axis=-1)
        return q, k, v

    B, T = h_lat.shape[:2]
    q_nope_l, q_rope_l, k_nope_l, k_rope_l, v_l = project(h_lat)
    cos, sin = axial_rope_tables(T, B_ROPE_DIM, h_lat.dtype)
    q_l, k_l, v_l = assemble(q_nope_l, apply_rope(q_rope_l, cos, sin), k_nope_l, apply_rope(k_rope_l, cos, sin), v_l)
    q_c, k_c, v_c = assemble(*project(h_ctx))
    k_all = jnp.concatenate([k_c, k_l], axis=1)
    v_all = jnp.concatenate([v_c, v_l], axis=1)
    out_l = blocked_attend(q_l, k_all, v_all).reshape(B, T, B_HEADS * B_V_DIM) @ w_o
    out_c = None
    if need_ctx:
        out_c = attend(q_c, k_c, v_c).reshape(B, h_ctx.shape[1], B_HEADS * B_V_DIM) @ w_o
    return out_l, out_c


def neighbourhood_mixer(h_lat, h_ctx, w_qkv, q_norm, k_norm, rpb, w_o, need_ctx):
    hd = C_HEADS * C_HEAD_DIM

    def project(h):
        B, T, _ = h.shape
        qkv = h @ w_qkv
        q = qkv[..., :hd].reshape(B, T, C_HEADS, C_HEAD_DIM)
        k = qkv[..., hd:2 * hd].reshape(B, T, C_HEADS, C_HEAD_DIM)
        v = qkv[..., 2 * hd:].reshape(B, T, C_HEADS, C_HEAD_DIM)
        return rms_norm(q, q_norm), rms_norm(k, k_norm), v

    B, T = h_lat.shape[:2]
    q_l, k_l, v_l = project(h_lat)
    q_c, k_c, v_c = project(h_ctx)
    rows = T // GRID_W
    kr = min(NA_ROWS, rows)
    kc = min(NA_COLS, GRID_W)
    scale = C_HEAD_DIM ** -0.5
    k_grid = k_l.reshape(B, rows, GRID_W, C_HEADS, C_HEAD_DIM)
    v_grid = v_l.reshape(B, rows, GRID_W, C_HEADS, C_HEAD_DIM)
    q_rows = jnp.moveaxis(q_l.reshape(B, rows, GRID_W, C_HEADS, C_HEAD_DIM), 1, 0)
    col = jnp.arange(GRID_W)
    col_start = jnp.clip(col - kc // 2, 0, GRID_W - kc)
    col_mask = (col[None, :] >= col_start[:, None]) & (col[None, :] < col_start[:, None] + kc)
    win_mask = jnp.tile(col_mask, (1, kr))
    dc_idx = jnp.clip(col[None, :] - col[:, None] + NA_COLS - 1, 0, 2 * NA_COLS - 2)
    rpb_f = rpb.astype(jnp.float32)
    n_win = kr * GRID_W

    def row_fn(args):
        r, q_row = args
        rs = jnp.clip(r - kr // 2, 0, rows - kr)
        k_band = lax.dynamic_slice_in_dim(k_grid, rs, kr, axis=1).reshape(B, n_win, C_HEADS, C_HEAD_DIM)
        v_band = lax.dynamic_slice_in_dim(v_grid, rs, kr, axis=1).reshape(B, n_win, C_HEADS, C_HEAD_DIM)
        dr_idx = rs + jnp.arange(kr) - r + NA_ROWS - 1
        bias = rpb_f[:, dr_idx[None, :, None], dc_idx[:, None, :]].reshape(C_HEADS, GRID_W, n_win)
        s_win = jnp.einsum('bqhd,bkhd->bhqk', q_row, k_band, preferred_element_type=jnp.float32) * scale + bias[None]
        s_win = jnp.where(win_mask[None, None], s_win, NEG_INF)
        s_ctx = jnp.einsum('bqhd,bkhd->bhqk', q_row, k_c, preferred_element_type=jnp.float32) * scale
        p = jax.nn.softmax(jnp.concatenate([s_win, s_ctx], axis=-1), axis=-1).astype(v_l.dtype)
        return (jnp.einsum('bhqk,bkhd->bqhd', p[..., :n_win], v_band)
                + jnp.einsum('bhqk,bkhd->bqhd', p[..., n_win:], v_c))

    o_l = lax.map(row_fn, (jnp.arange(rows, dtype=jnp.int32), q_rows))
    out_l = jnp.moveaxis(o_l, 0, 1).reshape(B, T, hd) @ w_o
    out_c = None
    if need_ctx:
        out_c = attend(q_c[:, :, :, None, :], k_c, v_c).reshape(B, h_ctx.shape[1], hd) @ w_o
    return out_l, out_c


def expert_choice_ffn(h, router, w_gate, w_up, w_down):
    B, T, _ = h.shape
    cap = max(1, min(T, EC_CAPACITY_FACTOR * T // N_EXPERTS))
    aff = jax.nn.softmax((h @ router).astype(jnp.float32), axis=-1)
    gate, idx = lax.top_k(jnp.swapaxes(aff, 1, 2), cap)
    bidx = jnp.arange(B)[:, None, None]
    xg = h[bidx, idx]
    hid = jax.nn.silu(jnp.einsum('becd,edf->becf', xg, w_gate)) * jnp.einsum('becd,edf->becf', xg, w_up)
    y = jnp.einsum('becf,efd->becd', hid, w_down) * gate[..., None].astype(h.dtype)
    return jnp.zeros_like(h).at[bidx, idx].add(y)


def setup_inputs(seed: int = 0) -> dict:
    key = jax.random.key(seed)
    ks = iter(jax.random.split(key, 40))
    D = D_MODEL

    def nrm(shape, fan_in, scale=1.0):
        return jax.random.normal(next(ks), shape, jnp.float32) * (scale * fan_in ** -0.5)

    def gain(shape):
        return 1.0 + 0.1 * jax.random.normal(next(ks), shape, jnp.float32)

    return {
        "x": jax.random.normal(next(ks), (BATCH, SEQ, D), jnp.float32),
        "c": jax.random.normal(next(ks), (BATCH, D), jnp.float32),
        "ctx": jax.random.normal(next(ks), (BATCH, CTX_LEN, D), jnp.float32),
        "c_ctx": jax.random.normal(next(ks), (D,), jnp.float32),
        "ada_w": nrm((DEPTH, D, 6 * D), D, 0.5),
        "ada_b": 0.02 * jax.random.normal(next(ks), (DEPTH, 6 * D), jnp.float32),
        "norm1_w": gain((DEPTH, D)),
        "norm2_w": gain((DEPTH, D)),
        "a_wqkv": nrm((N_A, D, (A_HEADS + 2 * A_KV_HEADS) * A_HEAD_DIM), D),
        "a_qnorm": gain((N_A, A_HEAD_DIM)),
        "a_knorm": gain((N_A, A_HEAD_DIM)),
        "a_wo": nrm((N_A, A_HEADS * A_HEAD_DIM, D), A_HEADS * A_HEAD_DIM),
        "b_wdq": nrm((N_B, D, B_Q_RANK), D),
        "b_qnorm_lat": gain((N_B, B_Q_RANK)),
        "b_wuq": nrm((N_B, B_Q_RANK, B_HEADS * (B_NOPE_DIM + B_ROPE_DIM)), B_Q_RANK),
        "b_wdkv": nrm((N_B, D, B_KV_RANK + B_ROPE_DIM), D),
        "b_kvnorm_lat": gain((N_B, B_KV_RANK)),
        "b_wukv": nrm((N_B, B_KV_RANK, B_HEADS * (B_NOPE_DIM + B_V_DIM)), B_KV_RANK),
        "b_qnorm": gain((N_B, B_NOPE_DIM + B_ROPE_DIM)),
        "b_knorm": gain((N_B, B_NOPE_DIM + B_ROPE_DIM)),
        "b_wo": nrm((N_B, B_HEADS * B_V_DIM, D), B_HEADS * B_V_DIM),
        "c_wqkv": nrm((N_C, D, 3 * C_HEADS * C_HEAD_DIM), D),
        "c_qnorm": gain((N_C, C_HEAD_DIM)),
        "c_knorm": gain((N_C, C_HEAD_DIM)),
        "c_rpb": 0.1 * jax.random.normal(next(ks), (N_C, C_HEADS, 2 * NA_ROWS - 1, 2 * NA_COLS - 1), jnp.float32),
        "c_wo": nrm((N_C, C_HEADS * C_HEAD_DIM, D), C_HEADS * C_HEAD_DIM),
        "moe_router": nrm((DEPTH, D, N_EXPERTS), D),
        "moe_wg": nrm((DEPTH, N_EXPERTS, D, EXPERT_FF), D),
        "moe_wu": nrm((DEPTH, N_EXPERTS, D, EXPERT_FF), D),
        "moe_wd": nrm((DEPTH, N_EXPERTS, EXPERT_FF, D), EXPERT_FF),
    }


def reference(x, c, ctx, c_ctx, ada_w, ada_b, norm1_w, norm2_w,
              a_wqkv, a_qnorm, a_knorm, a_wo,
              b_wdq, b_qnorm_lat, b_wuq, b_wdkv, b_kvnorm_lat, b_wukv, b_qnorm, b_knorm, b_wo,
              c_wqkv, c_qnorm, c_knorm, c_rpb, c_wo,
              moe_router, moe_wg, moe_wu, moe_wd):
    s_lat = jax.nn.silu(c)
    s_ctx = jax.nn.silu(c_ctx)[None]
    for i in range(DEPTH):
        need_ctx = i < DEPTH - 1
        m_l = jnp.split(s_lat @ ada_w[i] + ada_b[i], 6, axis=-1)
        m_c = jnp.split(s_ctx @ ada_w[i] + ada_b[i], 6, axis=-1)
        h_l = modulate(rms_norm(x, norm1_w[i]), m_l[0], m_l[1])
        h_c = modulate(rms_norm(ctx, norm1_w[i]), m_c[0], m_c[1])
        kind, j = i % N_MIXERS, i // N_MIXERS
        if kind == 0:
            out_l, out_c = gqa_axial_mixer(h_l, h_c, a_wqkv[j], a_qnorm[j], a_knorm[j], a_wo[j], need_ctx)
        elif kind == 1:
            out_l, out_c = mla_mixer(h_l, h_c, b_wdq[j], b_qnorm_lat[j], b_wuq[j], b_wdkv[j], b_kvnorm_lat[j],
                                     b_wukv[j], b_qnorm[j], b_knorm[j], b_wo[j], need_ctx)
        else:
            out_l, out_c = neighbourhood_mixer(h_l, h_c, c_wqkv[j], c_qnorm[j], c_knorm[j], c_rpb[j], c_wo[j], need_ctx)
        x = x + m_l[2][:, None] * out_l
        x = x + m_l[5][:, None] * expert_choice_ffn(modulate(rms_norm(x, norm2_w[i]), m_l[3], m_l[4]),
                                                    moe_router[i], moe_wg[i], moe_wu[i], moe_wd[i])
        if need_ctx:
            ctx = ctx + m_c[2][:, None] * out_c
            ctx = ctx + m_c[5][:, None] * expert_choice_ffn(modulate(rms_norm(ctx, norm2_w[i]), m_c[3], m_c[4]),
                                                            moe_router[i], moe_wg[i], moe_wu[i], moe_wd[i])
    return x
```

```cpp
#include <hip/hip_runtime.h>
#include <hip/hip_bf16.h>
#include <cstdio>
#include <cstdint>
#include <cmath>

#ifndef MK_PER_PHASE
#define MK_PER_PHASE 0
#endif

#define GAS __attribute__((address_space(1)))
#define LAS __attribute__((address_space(3)))
typedef unsigned short bf16;
typedef short bf16x8 __attribute__((ext_vector_type(8)));
typedef short s16x4 __attribute__((ext_vector_type(4)));
typedef float f32x4 __attribute__((ext_vector_type(4)));
typedef float f32x16 __attribute__((ext_vector_type(16)));
typedef unsigned u32x4 __attribute__((ext_vector_type(4)));
typedef unsigned u32x2 __attribute__((ext_vector_type(2)));
typedef GAS unsigned gu32;

constexpr int D = 1024, NB = 16, SEQ = 2048, CTXL = 256, DEPTH = 4;
constexpr int RL = NB * SEQ, RC = NB * CTXL, RT = RL + RC;
constexpr int NE = 16, SLOTS_E = 4608, NSLOT = NE * SLOTS_E;
constexpr float EPS = 1e-6f, LOG2E = 1.4426950408889634f;
constexpr int NWAVES = 8, NTHR = 512;

constexpr size_t MiB = 1u << 20;
constexpr size_t WS_CTL = 0, CTL_ZERO_BYTES = 64 * 1024;
constexpr size_t WS_MOD = 1 * MiB;
constexpr size_t WS_MODP = 3 * MiB;
constexpr size_t WS_ROPE = 17 * MiB;
constexpr size_t WS_AFF = 18 * MiB;
constexpr size_t WS_INV = 21 * MiB;
constexpr size_t WS_GIDX = 24 * MiB;
constexpr size_t WS_GATE = 24 * MiB + 512 * 1024;
constexpr size_t WS_RSQ = 25 * MiB;
constexpr size_t WS_RSQP = 34 * MiB;
constexpr size_t WS_XC = 26 * MiB;
constexpr size_t WS_WS = 42 * MiB;
constexpr size_t WO_AQKV0 = 0, WO_AQKV1 = 3 * MiB, WO_AWO0 = 6 * MiB, WO_AWO1 = 8 * MiB, WO_BDN = 10 * MiB, WO_BUQ = 11 * MiB + 512 * 1024,
                 WO_BUKV = 13 * MiB, WO_BWO = 14 * MiB, WO_CQKV = 16 * MiB, WO_CWO = 22 * MiB;
constexpr size_t WS_WMOE = 66 * MiB;
constexpr size_t WS_H = 450 * MiB;
constexpr size_t WS_ACT = 522 * MiB;
constexpr size_t AO_Q = 0, AO_K = 108 * MiB, AO_V = 216 * MiB, AO_O = 288 * MiB, AO_CQ = 360 * MiB, AO_CKV = 387 * MiB, AO_HID = 0, AO_Y = 144 * MiB;
constexpr size_t WS_WOUT = 927 * MiB;
constexpr size_t WS_END = 999 * MiB;

constexpr int CW_BAR = 4096;
constexpr int LDS_BYTES = 147456, MISC_OFF = 131072 + 320;

#define LDS_WAIT() asm volatile("s_waitcnt lgkmcnt(0)" ::: "memory")
#define VM_WAIT() asm volatile("s_waitcnt vmcnt(0)" ::: "memory")
__device__ __forceinline__ unsigned f2bf(float f) { unsigned u = __builtin_bit_cast(unsigned, f); return (u + 0x7fffu + ((u >> 16) & 1u)) >> 16; }
__device__ __forceinline__ unsigned pk2(float lo, float hi) { return f2bf(lo) | (f2bf(hi) << 16); }
__device__ __forceinline__ float bf2f(unsigned h) { return __builtin_bit_cast(float, h << 16); }
__device__ __forceinline__ unsigned cvt_pk_bf16(float lo, float hi) { unsigned r; asm volatile("v_cvt_pk_bf16_f32 %0, %1, %2" : "=v"(r) : "v"(lo), "v"(hi)); return r; }
__device__ __forceinline__ u32x4 pack8(const f32x4 a, const f32x4 b) { u32x4 w; w.x = cvt_pk_bf16(a[0], a[1]); w.y = cvt_pk_bf16(a[2], a[3]); w.z = cvt_pk_bf16(b[0], b[1]); w.w = cvt_pk_bf16(b[2], b[3]); return w; }
__device__ __forceinline__ float wave_sum(float v) {
#pragma unroll
    for (int o = 1; o < 64; o <<= 1) v += __shfl_xor(v, o);
    return v;
}
__device__ __forceinline__ float sum4sq(const f32x4 a) { return (a[0] * a[0] + a[1] * a[1]) + (a[2] * a[2] + a[3] * a[3]); }
__device__ __forceinline__ float red_fq(float s) { s += __shfl_xor(s, 16); s += __shfl_xor(s, 32); return s; }

namespace pg8 {
constexpr int BM = 256, BK = 64, HALF = 128, HTB = HALF * BK * 2, NXCD = 8, WGM = 8;
__host__ __device__ __forceinline__ int lds_byte(int r, int c) { const int st = (r >> 4) * 2 + (c >> 5), rr = r & 15, cc = c & 31, ob = rr * 64 + cc * 2; return st * 1024 + (ob ^ (((ob >> 9) & 1) << 5)); }
__host__ __device__ __forceinline__ void stage_rc(int b, int& R, int& C) { const int st = b / 1024, sb = b % 1024, swz = sb ^ (((sb >> 9) & 1) << 5); R = (st >> 1) * 16 + swz / 64; C = (st & 1) * 32 + (swz % 64) / 2; }
__host__ __device__ __forceinline__ int perm32(int rho) { const int n = rho >> 4, i = rho & 15; return 8 * (i >> 2) + 4 * n + (i & 3); }
struct Unit { int pm, pn; };
struct Gemm { const bf16* A; const bf16* Bt; int K; const int* gidx; };
struct StaticOrder {
    int nM, nN, nwg, G, c, pm0;
    __device__ void init(int M, int N, int G_, int c_, int pm0_ = 0) { nM = M / BM; nN = N / BM; nwg = nM * nN; G = G_; c = c_; pm0 = pm0_; }
    __device__ bool next(int i, Unit& u) const {
        const long L = (long)i * G + c; if (L >= nwg) return false;
        int wgid = (int)L; { const int q = nwg / NXCD, r = nwg % NXCD, xcd = wgid % NXCD, off = wgid / NXCD; wgid = (xcd < r ? xcd * (q + 1) : r * (q + 1) + (xcd - r) * q) + off; }
        const int nig = WGM * nN, gid = wgid / nig, fm = gid * WGM, gsz = (nM - fm) < WGM ? (nM - fm) : WGM;
        u.pm = pm0 + fm + ((wgid % nig) % gsz); u.pn = (wgid % nig) / gsz; return true;
    }
};
struct MoeOrder {
    int njt, npn, G, c;
    __device__ bool next(int i, Unit& u) const {
        const int x = c & 7, w = c >> 3, per = 2 * njt * npn;
        const int q = i * (G >> 3) + w; if (q >= per) return false;
        const int pe = njt * npn, el = q / pe, qq = q - el * pe, e = 2 * x + el, gsz = (njt % 8 == 0) ? 8 : 6, pg = gsz * npn, gi = qq / pg, r = qq - gi * pg;
        const int j = gi * gsz + r % gsz, pn = r / gsz;
        u.pm = e * 18 + j; u.pn = e * npn + pn; return true;
    }
};
template <class Epi, class Sched, bool GATHER>
__device__ __forceinline__ void gemm_phase(LAS unsigned char* lds, const Gemm g, const Sched& S, const Epi& E) {
    int tid_ = threadIdx.x; asm volatile("" : "+v"(tid_));
    const int tid = tid_, wid = __builtin_amdgcn_readfirstlane(tid >> 6), lane = tid & 63, wr = wid >> 2, wc = wid & 3, fr = lane & 15, fq = lane >> 4;
    const int K = g.K, nt = K / BK;
    unsigned voffB[2]; int RA[2]; unsigned CA[2];
#pragma unroll
    for (int i = 0; i < 2; ++i) { int R, C; stage_rc(tid * 16 + i * 8192, R, C); voffB[i] = (unsigned)(R * K + C) * 2u; RA[i] = R; CA[i] = (unsigned)C * 2u; }
    const size_t kstep = (size_t)(BK * 2);
    const unsigned hstep = (unsigned)HALF * (unsigned)K * 2u;
    const size_t tstep = 2 * (size_t)hstep;
    const unsigned ldsw = (unsigned)wid * 1024u;
    const int aoff = lds_byte(wr * 64 + fr, fq * 8), boff = lds_byte(wc * 32 + fr, fq * 8);
#define PG8_SA(b, h) (((b) * 2 + (h)) * HTB)
#define PG8_SB(b, h) ((4 + (b) * 2 + (h)) * HTB)
#define PG8_STAGE(bufoff, gbase, voff) do { _Pragma("unroll") for (int _i = 0; _i < 2; ++_i) \
        __builtin_amdgcn_global_load_lds((const unsigned*)((const char*)(gbase) + (voff)[_i]), (LAS unsigned*)(lds + (bufoff) + ldsw + _i * 8192), 16, 0, 0); } while (0)
#define PG8_LDA(dst, b, h) do { _Pragma("unroll") for (int m = 0; m < 4; ++m) _Pragma("unroll") for (int k = 0; k < 2; ++k) dst[m][k] = *(const LAS bf16x8*)(lds + PG8_SA(b, h) + aoff + m * 2048 + k * 1024); } while (0)
#define PG8_LDB(dst, b, h) do { _Pragma("unroll") for (int n = 0; n < 2; ++n) _Pragma("unroll") for (int k = 0; k < 2; ++k) dst[n][k] = *(const LAS bf16x8*)(lds + PG8_SB(b, h) + boff + n * 2048 + k * 1024); } while (0)
#define PG8_MMA(ai, bj, At, Bt) do { __builtin_amdgcn_s_setprio(1); _Pragma("unroll") for (int m = 0; m < 4; ++m) _Pragma("unroll") for (int n = 0; n < 2; ++n) _Pragma("unroll") for (int k = 0; k < 2; ++k) \
        acc[ai][bj][m][n] = __builtin_amdgcn_mfma_f32_16x16x32_bf16(Bt[n][k], At[m][k], acc[ai][bj][m][n], 0, 0, 0); __builtin_amdgcn_s_setprio(0); } while (0)
#define PG8_WAIT_V(n) asm volatile("s_waitcnt vmcnt(" #n ")" ::: "memory")
#define PG8_WAIT_L(n) asm volatile("s_waitcnt lgkmcnt(" #n ")" ::: "memory")
#define PG8_BAR __builtin_amdgcn_s_barrier()
#define PG8_SCHED __builtin_amdgcn_sched_barrier(0)
#define PG8_MKOFF(o, u) do { _Pragma("unroll") for (int _h = 0; _h < 2; ++_h) _Pragma("unroll") for (int _i = 0; _i < 2; ++_i) \
        o[_h][_i] = GATHER ? (unsigned)g.gidx[(u).pm * 256 + _h * 128 + RA[_i]] * (unsigned)(K * 2) + CA[_i] : (unsigned)(RA[_i] * K * 2) + CA[_i] + (unsigned)_h * hstep; } while (0)
    Unit cur, nxt; int ui = 0;
    if (!S.next(0, cur)) return;
    f32x4 acc[2][2][4][2];
#pragma unroll
    for (int a = 0; a < 2; ++a)
#pragma unroll
        for (int b = 0; b < 2; ++b)
#pragma unroll
            for (int m = 0; m < 4; ++m)
#pragma unroll
                for (int n = 0; n < 2; ++n) acc[a][b][m][n] = (f32x4){0.f, 0.f, 0.f, 0.f};
    bf16x8 At[4][2], B0[2][2], B1[2][2];
    unsigned cO[2][2], nO[2][2];
    const char* cA = GATHER ? (const char*)g.A : (const char*)g.A + (size_t)cur.pm * tstep; const char* cB = (const char*)g.Bt + (size_t)cur.pn * tstep;
    PG8_STAGE(PG8_SB(0, 0), cB, voffB); PG8_STAGE(PG8_SB(0, 1), cB + hstep, voffB);
    PG8_MKOFF(cO, cur);
    PG8_STAGE(PG8_SA(0, 0), cA, cO[0]); PG8_STAGE(PG8_SA(0, 1), cA, cO[1]);
    if (wr == 1) PG8_BAR;
    PG8_WAIT_V(2); PG8_BAR;
    PG8_STAGE(PG8_SB(1, 0), cB + kstep, voffB); PG8_STAGE(PG8_SA(1, 0), cA + kstep, cO[0]); PG8_STAGE(PG8_SB(1, 1), cB + hstep + kstep, voffB);
    PG8_WAIT_V(6); PG8_BAR;
    for (;;) {
        const bool has_next = S.next(ui + 1, nxt);
        const char* nA = has_next ? (GATHER ? (const char*)g.A : (const char*)g.A + (size_t)nxt.pm * tstep) : cA; const char* nB = has_next ? (const char*)g.Bt + (size_t)nxt.pn * tstep : cB;
        if (has_next) {
            if (GATHER) {
#pragma unroll
                for (int h = 0; h < 2; ++h)
#pragma unroll
                    for (int i = 0; i < 2; ++i) nO[h][i] = (unsigned)g.gidx[nxt.pm * 256 + h * 128 + RA[i]];
            } else { PG8_MKOFF(nO, nxt); }
        } else {
#pragma unroll
            for (int h = 0; h < 2; ++h)
#pragma unroll
                for (int i = 0; i < 2; ++i) nO[h][i] = cO[h][i]; }
#pragma unroll 1
        for (int t = 0; t < nt; t += 2) {
            const bool last = (t == nt - 2);
            const char* a1 = cA + (size_t)(t + 1) * kstep;
            const char* a2 = last ? nA : cA + (size_t)(t + 2) * kstep; const char* b2 = last ? nB : cB + (size_t)(t + 2) * kstep;
            const char* a3 = a2 + kstep; const char* b3 = b2 + kstep;
            unsigned o2[2][2];
#pragma unroll
            for (int h = 0; h < 2; ++h)
#pragma unroll
                for (int i = 0; i < 2; ++i) o2[h][i] = cO[h][i];
            if (last) {
                asm volatile("" : "+v"(nO[0][0]), "+v"(nO[0][1]), "+v"(nO[1][0]), "+v"(nO[1][1]));
                if (GATHER && has_next) {
#pragma unroll
                    for (int h = 0; h < 2; ++h)
#pragma unroll
                        for (int i = 0; i < 2; ++i) nO[h][i] = nO[h][i] * (unsigned)(K * 2) + CA[i];
                }
#pragma unroll
                for (int h = 0; h < 2; ++h)
#pragma unroll
                    for (int i = 0; i < 2; ++i) o2[h][i] = nO[h][i];
            }
            PG8_LDB(B0, 0, 0); PG8_LDB(B1, 0, 1); PG8_SCHED; PG8_LDA(At, 0, 0); PG8_STAGE(PG8_SA(1, 1), a1, cO[1]);
            PG8_WAIT_V(8); PG8_WAIT_L(0); PG8_BAR; PG8_MMA(0, 0, At, B0); PG8_MMA(0, 1, At, B1); PG8_BAR; PG8_SCHED;
            PG8_LDA(At, 0, 1); PG8_STAGE(PG8_SB(0, 0), b2, voffB); PG8_STAGE(PG8_SB(0, 1), b2 + hstep, voffB); PG8_STAGE(PG8_SA(0, 0), a2, o2[0]);
            PG8_WAIT_V(8); PG8_WAIT_L(0); PG8_BAR; PG8_MMA(1, 0, At, B0); PG8_MMA(1, 1, At, B1); PG8_BAR; PG8_SCHED;
            PG8_LDB(B0, 1, 0); PG8_LDB(B1, 1, 1); PG8_SCHED; PG8_LDA(At, 1, 0); PG8_STAGE(PG8_SA(0, 1), a2, o2[1]);
            PG8_WAIT_V(8); PG8_WAIT_L(0); PG8_BAR; PG8_MMA(0, 0, At, B0); PG8_MMA(0, 1, At, B1); PG8_BAR; PG8_SCHED;
            PG8_LDA(At, 1, 1); PG8_STAGE(PG8_SB(1, 0), b3, voffB); PG8_STAGE(PG8_SB(1, 1), b3 + hstep, voffB); PG8_STAGE(PG8_SA(1, 0), a3, o2[0]);
            PG8_WAIT_V(8); PG8_WAIT_L(0); PG8_BAR; PG8_MMA(1, 0, At, B0); PG8_MMA(1, 1, At, B1); PG8_BAR; PG8_SCHED;
        }
        if (wr == 0) PG8_BAR;
        { int fr_ = fr, fq_ = fq; asm volatile("" : "+v"(fr_), "+v"(fq_)); E(acc, cur, wr, wc, fr_, fq_); }
        if (!has_next) break;
#pragma unroll
        for (int a = 0; a < 2; ++a)
#pragma unroll
            for (int b = 0; b < 2; ++b)
#pragma unroll
                for (int m = 0; m < 4; ++m)
#pragma unroll
                    for (int n = 0; n < 2; ++n) acc[a][b][m][n] = (f32x4){0.f, 0.f, 0.f, 0.f};
        cur = nxt; cA = nA; cB = nB; ++ui;
#pragma unroll
        for (int h = 0; h < 2; ++h)
#pragma unroll
            for (int i = 0; i < 2; ++i) cO[h][i] = nO[h][i];
        if (wr == 1) PG8_BAR;
    }
    PG8_WAIT_V(0);
    PG8_BAR;
#undef PG8_SA
#undef PG8_SB
#undef PG8_STAGE
#undef PG8_LDA
#undef PG8_LDB
#undef PG8_MMA
#undef PG8_WAIT_V
#undef PG8_WAIT_L
#undef PG8_BAR
#undef PG8_SCHED
#undef PG8_MKOFF
}
}

template <int KIND> struct EpiQKV {
    bf16* act; const float *qg, *kg, *cosT, *sinT;
    __device__ __forceinline__ void operator()(const f32x4 (&acc)[2][2][4][2], const pg8::Unit& u, int wr, int wc, int fr, int fq) const {
        constexpr int NQ = 16, NK = (KIND == 0) ? 4 : 16, KVP = (KIND == 0) ? 256 : 1024;
        const int hs = 4 * u.pn + wc;
        const int type = hs < NQ ? 0 : (hs < NQ + NK ? 1 : 2);
        const int hh = type == 0 ? hs : (type == 1 ? hs - NQ : hs - NQ - NK);
        bf16* dst = act + (type == 0 ? AO_Q / 2 : (type == 1 ? AO_K / 2 : AO_V / 2)); const int pitch = type == 0 ? 1024 : KVP;
        const int dbase = 8 * fq;
        f32x4 g[2][2];
#pragma unroll
        for (int bj = 0; bj < 2; ++bj)
#pragma unroll
            for (int n = 0; n < 2; ++n) { const f32x4 a = *(const f32x4*)(qg + dbase + 32 * bj + 4 * n), b = *(const f32x4*)(kg + dbase + 32 * bj + 4 * n); g[bj][n] = (type == 0) ? a : b; }
        const float qs = type == 0 ? 0.125f * LOG2E : 1.f;
#pragma unroll
        for (int ai = 0; ai < 2; ++ai)
#pragma unroll
            for (int m = 0; m < 4; ++m) {
                const int row = u.pm * 256 + ai * 128 + wr * 64 + m * 16 + fr;
                f32x4 v[2][2];
#pragma unroll
                for (int bj = 0; bj < 2; ++bj)
#pragma unroll
                    for (int n = 0; n < 2; ++n) v[bj][n] = acc[ai][bj][m][n];
                if (type != 2) {
                    float ss = (sum4sq(v[0][0]) + sum4sq(v[0][1])) + (sum4sq(v[1][0]) + sum4sq(v[1][1]));
                    ss = red_fq(ss);
                    const float rinv = rsqrtf(ss * (1.f / 64.f) + EPS) * qs;
#pragma unroll
                    for (int bj = 0; bj < 2; ++bj)
#pragma unroll
                        for (int n = 0; n < 2; ++n) v[bj][n] = v[bj][n] * rinv * g[bj][n];
                    if (KIND == 0 && row < RL) {
                        const int pos = row & (SEQ - 1);
#pragma unroll
                        for (int n = 0; n < 2; ++n) {
                            const f32x4 c = *(const f32x4*)(cosT + pos * 32 + dbase + 4 * n), s = *(const f32x4*)(sinT + pos * 32 + dbase + 4 * n);
                            const f32x4 x1 = v[0][n], x2 = v[1][n];
                            v[0][n] = x1 * c - x2 * s; v[1][n] = x1 * s + x2 * c;
                        }
                    }
                }
                bf16* rp = dst + (size_t)row * pitch + hh * 64 + dbase;
#pragma unroll
                for (int bj = 0; bj < 2; ++bj) *(u32x4*)(rp + 32 * bj) = pack8(v[bj][0], v[bj][1]);
            }
    }
};
struct EpiWo {
    bf16* wout; const float* mod;
    __device__ __forceinline__ void operator()(const f32x4 (&acc)[2][2][4][2], const pg8::Unit& u, int wr, int wc, int fr, int fq) const {
        const int bi = u.pm < 128 ? (u.pm >> 3) : 16;
        const int col0 = u.pn * 256 + 32 * wc + 8 * fq;
        const float* m2 = mod + bi * 6144 + 2 * 1024 + col0;
        f32x4 mv[2][2];
#pragma unroll
        for (int bj = 0; bj < 2; ++bj)
#pragma unroll
            for (int n = 0; n < 2; ++n) mv[bj][n] = *(const f32x4*)(m2 + 128 * bj + 4 * n);
#pragma unroll
        for (int ai = 0; ai < 2; ++ai)
#pragma unroll
            for (int m = 0; m < 4; ++m) {
                const int row = u.pm * 256 + ai * 128 + wr * 64 + m * 16 + fr;
                bf16* wp = wout + (size_t)row * D + col0;
#pragma unroll
                for (int bj = 0; bj < 2; ++bj) *(u32x4*)(wp + 128 * bj) = pack8(mv[bj][0] * acc[ai][bj][m][0], mv[bj][1] * acc[ai][bj][m][1]);
            }
    }
};
struct EpiMoeGU {
    bf16* HID;
    __device__ __forceinline__ void operator()(const f32x4 (&acc)[2][2][4][2], const pg8::Unit& u, int wr, int wc, int fr, int fq) const {
        const int f0 = 128 * (u.pn & 7) + 32 * wc + 8 * fq;
#pragma unroll
        for (int ai = 0; ai < 2; ++ai)
#pragma unroll
            for (int m = 0; m < 4; ++m) {
                const int row = u.pm * 256 + ai * 128 + wr * 64 + m * 16 + fr;
                f32x4 h[2];
#pragma unroll
                for (int n = 0; n < 2; ++n) { const f32x4 gt = acc[ai][0][m][n], up = acc[ai][1][m][n];
#pragma unroll
                    for (int j = 0; j < 4; ++j) h[n][j] = gt[j] * __builtin_amdgcn_rcpf(1.f + __expf(-gt[j])) * up[j]; }
                *(u32x4*)(HID + (size_t)row * 1024 + f0) = pack8(h[0], h[1]);
            }
    }
};
struct EpiMoeDown {
    bf16* Y; const float* GATE;
    __device__ __forceinline__ void operator()(const f32x4 (&acc)[2][2][4][2], const pg8::Unit& u, int wr, int wc, int fr, int fq) const {
        const int col0 = 256 * (u.pn & 3) + 32 * wc + 8 * fq;
#pragma unroll
        for (int ai = 0; ai < 2; ++ai)
#pragma unroll
            for (int m = 0; m < 4; ++m) {
                const int row = u.pm * 256 + ai * 128 + wr * 64 + m * 16 + fr;
                const float gt = GATE[row];
#pragma unroll
                for (int bj = 0; bj < 2; ++bj) *(u32x4*)(Y + (size_t)row * 1024 + col0 + 128 * bj) = pack8(acc[ai][bj][m][0] * gt, acc[ai][bj][m][1] * gt);
            }
    }
};
struct EpiBdown {
    bf16 *CQ, *CKV, *Km; float *rsqp; const float *kg, *cosT, *sinT;
    __device__ __forceinline__ void operator()(const f32x4 (&acc)[2][2][4][2], const pg8::Unit& u, int wr, int wc, int fr, int fq) const {
        const int pn = u.pn;
#pragma unroll
        for (int ai = 0; ai < 2; ++ai)
#pragma unroll
            for (int m = 0; m < 4; ++m) {
                const int row = u.pm * 256 + ai * 128 + wr * 64 + m * 16 + fr;
                if (pn != 1) {
                    bf16* dst = (pn == 0 ? CQ + (size_t)row * 384 : CKV + (size_t)row * 256) + 32 * wc + 8 * fq;
                    float ss = 0.f;
#pragma unroll
                    for (int bj = 0; bj < 2; ++bj) { ss += sum4sq(acc[ai][bj][m][0]) + sum4sq(acc[ai][bj][m][1]); *(u32x4*)(dst + 128 * bj) = pack8(acc[ai][bj][m][0], acc[ai][bj][m][1]); }
                    ss = red_fq(ss);
                    if (fq == 0) rsqp[(size_t)row * 12 + (pn == 0 ? 0 : 8) + wc] = ss;
                } else {
                    float ss = sum4sq(acc[ai][0][m][0]) + sum4sq(acc[ai][0][m][1]);
                    *(u32x4*)(CQ + (size_t)row * 384 + 256 + 32 * wc + 8 * fq) = pack8(acc[ai][0][m][0], acc[ai][0][m][1]);
                    ss = red_fq(ss);
                    if (fq == 0) rsqp[(size_t)row * 12 + 4 + wc] = ss;
                    if (wc == 0) {
                        f32x4 a = acc[ai][1][m][0], b = acc[ai][1][m][1];
                        float s2 = red_fq(sum4sq(a) + sum4sq(b));
                        const float rinv = rsqrtf(s2 * (1.f / 32.f) + EPS);
                        a = a * rinv * *(const f32x4*)(kg + 4 * fq); b = b * rinv * *(const f32x4*)(kg + 16 + 4 * fq);
                        if (row < RL) { const int pos = row & (SEQ - 1); const f32x4 c = *(const f32x4*)(cosT + pos * 16 + 4 * fq), s = *(const f32x4*)(sinT + pos * 16 + 4 * fq);
                            const f32x4 x1 = a, x2 = b; a = x1 * c - x2 * s; b = x1 * s + x2 * c; }
                        u32x2 wa, wb; wa.x = cvt_pk_bf16(a[0], a[1]); wa.y = cvt_pk_bf16(a[2], a[3]); wb.x = cvt_pk_bf16(b[0], b[1]); wb.y = cvt_pk_bf16(b[2], b[3]);
                        bf16* kp = Km + (size_t)row * 1536 + 64 + 4 * fq;
#pragma unroll
                        for (int h = 0; h < 16; ++h) { *(u32x2*)(kp + 96 * h) = wa; *(u32x2*)(kp + 96 * h + 16) = wb; }
                    }
                }
            }
    }
};
struct EpiBuq {
    bf16* Qm; const float *rsqp, *qg, *cosT, *sinT;
    __device__ __forceinline__ void operator()(const f32x4 (&acc)[2][2][4][2], const pg8::Unit& u, int wr, int wc, int fr, int fq) const {
        const float C2 = 0.10206207261596575f * LOG2E;
        const int pn = u.pn;
#pragma unroll
        for (int ai = 0; ai < 2; ++ai)
#pragma unroll
            for (int m = 0; m < 4; ++m) {
                const int row = u.pm * 256 + ai * 128 + wr * 64 + m * 16 + fr;
                const f32x4 p0_ = *(const f32x4*)(rsqp + (size_t)row * 12), p1_ = *(const f32x4*)(rsqp + (size_t)row * 12 + 4);
                const float al = rsqrtf((((p0_[0] + p0_[1]) + (p0_[2] + p0_[3])) + ((p1_[0] + p1_[1]) + (p1_[2] + p1_[3]))) * (1.f / 384.f) + EPS);
                if (pn < 4) {
                    const int head = 4 * pn + wc;
                    f32x4 v[2][2]; float ss = 0.f;
#pragma unroll
                    for (int bj = 0; bj < 2; ++bj)
#pragma unroll
                        for (int n = 0; n < 2; ++n) { v[bj][n] = acc[ai][bj][m][n] * al; ss += sum4sq(v[bj][n]); }
                    ss = red_fq(ss);
                    const float rinv = rsqrtf(ss * (1.f / 64.f) + EPS) * C2;
                    bf16* rp = Qm + (size_t)row * 1536 + head * 96 + 8 * fq;
#pragma unroll
                    for (int bj = 0; bj < 2; ++bj) { const f32x4 g0 = *(const f32x4*)(qg + 32 * bj + 8 * fq), g1 = *(const f32x4*)(qg + 32 * bj + 8 * fq + 4);
                        *(u32x4*)(rp + 32 * bj) = pack8(v[bj][0] * rinv * g0, v[bj][1] * rinv * g1); }
                } else {
#pragma unroll
                    for (int bj = 0; bj < 2; ++bj) {
                        const int head = 8 * (pn - 4) + 4 * bj + wc;
                        f32x4 a = acc[ai][bj][m][0] * al, b = acc[ai][bj][m][1] * al;
                        const float ss = red_fq(sum4sq(a) + sum4sq(b));
                        const float rinv = rsqrtf(ss * (1.f / 32.f) + EPS) * C2;
                        a = a * rinv * *(const f32x4*)(qg + 64 + 4 * fq); b = b * rinv * *(const f32x4*)(qg + 80 + 4 * fq);
                        if (row < RL) { const int pos = row & (SEQ - 1); const f32x4 c = *(const f32x4*)(cosT + pos * 16 + 4 * fq), s = *(const f32x4*)(sinT + pos * 16 + 4 * fq);
                            const f32x4 x1 = a, x2 = b; a = x1 * c - x2 * s; b = x1 * s + x2 * c; }
                        u32x2 wa, wb; wa.x = cvt_pk_bf16(a[0], a[1]); wa.y = cvt_pk_bf16(a[2], a[3]); wb.x = cvt_pk_bf16(b[0], b[1]); wb.y = cvt_pk_bf16(b[2], b[3]);
                        bf16* rp = Qm + (size_t)row * 1536 + head * 96 + 64 + 4 * fq;
                        *(u32x2*)rp = wa; *(u32x2*)(rp + 16) = wb;
                    }
                }
                asm volatile("" ::: "memory");
            }
    }
};
struct EpiBukv {
    bf16 *Km, *Vm; const float *rsqp, *kg;
    __device__ __forceinline__ void operator()(const f32x4 (&acc)[2][2][4][2], const pg8::Unit& u, int wr, int wc, int fr, int fq) const {
        const int pn = u.pn;
#pragma unroll
        for (int ai = 0; ai < 2; ++ai)
#pragma unroll
            for (int m = 0; m < 4; ++m) {
                const int row = u.pm * 256 + ai * 128 + wr * 64 + m * 16 + fr;
                const f32x4 p2_ = *(const f32x4*)(rsqp + (size_t)row * 12 + 8);
                const float al = rsqrtf(((p2_[0] + p2_[1]) + (p2_[2] + p2_[3])) * (1.f / 256.f) + EPS);
                f32x4 v[2][2]; float ss = 0.f;
#pragma unroll
                for (int bj = 0; bj < 2; ++bj)
#pragma unroll
                    for (int n = 0; n < 2; ++n) { v[bj][n] = acc[ai][bj][m][n] * al; ss += sum4sq(v[bj][n]); }
                if (pn < 4) {
                    ss = red_fq(ss);
                    const float rinv = rsqrtf(ss * (1.f / 64.f) + EPS);
                    bf16* rp = Km + (size_t)row * 1536 + (4 * pn + wc) * 96 + 8 * fq;
#pragma unroll
                    for (int bj = 0; bj < 2; ++bj) { const f32x4 g0 = *(const f32x4*)(kg + 32 * bj + 8 * fq), g1 = *(const f32x4*)(kg + 32 * bj + 8 * fq + 4);
                        *(u32x4*)(rp + 32 * bj) = pack8(v[bj][0] * rinv * g0, v[bj][1] * rinv * g1); }
                } else {
                    bf16* rp = Vm + (size_t)row * 1024 + (4 * (pn - 4) + wc) * 64 + 8 * fq;
#pragma unroll
                    for (int bj = 0; bj < 2; ++bj) *(u32x4*)(rp + 32 * bj) = pack8(v[bj][0], v[bj][1]);
                }
                asm volatile("" ::: "memory");
            }
    }
};

__device__ __forceinline__ int crow(int r, int hi) { return (r & 3) + 8 * (r >> 2) + 4 * hi; }
template <int DK, int MODE>
__device__ __forceinline__ void attn_unit(LAS unsigned char* lds, const bf16* Qp, int qpitch, const bf16* Kp, int kpitch, const bf16* Vp, int vpitch, bf16* Op,
                                          int qrow0, int base0, int n0, int base1, int NT, int g4, int lo, const float* rpbh) {
    constexpr int KSTR = DK * 2 + 16, KSZ = 64 * KSTR, CPR = DK / 8, NCH = 64 * CPR;
    int tid_ = threadIdx.x; asm volatile("" : "+v"(tid_));
    const int tid = tid_, lane = tid & 63, r32 = lane & 31, hi = lane >> 5; const int wid = __builtin_amdgcn_readfirstlane(tid >> 6);
    LAS unsigned char* Kl = lds; LAS unsigned char* Vl = lds + 2 * KSZ; LAS float* rpbL = (LAS float*)(lds + 2 * KSZ + 16384);
    const int kr0 = tid / CPR, kc0 = tid % CPR, kr1 = (tid + 512) / CPR, kc1 = (tid + 512) % CPR; const bool k2 = (tid + 512) < NCH;
    const int vr = tid >> 3, vc = tid & 7;
    const unsigned kdst0 = kr0 * KSTR + kc0 * 16, kdst1 = kr1 * KSTR + kc1 * 16, vdst = (vc >> 2) * 4096 + vr * 64 + (vc & 3) * 16;
    if (MODE == 2) { if (tid < 15 * 32) { const int dr = tid >> 5, dc = tid & 31; rpbL[tid] = dc < 31 ? rpbh[dr * 31 + dc] * LOG2E : 0.f; } }
    bf16x8 qf[DK / 16];
    { const bf16* qp = Qp + (size_t)(qrow0 + wid * 32 + r32) * qpitch + hi * 8;
#pragma unroll
      for (int d0 = 0; d0 < DK / 16; ++d0) qf[d0] = *(const bf16x8*)(qp + 16 * d0); }
    f32x16 o0, o1;
#pragma unroll
    for (int i = 0; i < 16; ++i) { o0[i] = 0.f; o1[i] = 0.f; }
    float mrun = -1e30f, lrun = 0.f;
    const int rq = g4 + (wid >> 1), rs = min(max(rq - 4, 0), 24), cq = 32 * (wid & 1) + r32, cs = min(max(cq - 8, 0), 48);
    const unsigned vb = (4 * hi + ((lane & 15) >> 2)) * 64 + ((lane >> 4) & 1) * 32 + (lane & 3) * 8;
    u32x4 kreg0, kreg1, vreg;
#define ATT_TROW(t) ((t) < n0 ? base0 + 64 * (t) : base1 + 64 * ((t) - n0))
#define ATT_LOAD(t) do { const int tr_ = ATT_TROW(t); kreg0 = *(const u32x4*)(Kp + (size_t)(tr_ + kr0) * kpitch + kc0 * 8); \
        if (k2) kreg1 = *(const u32x4*)(Kp + (size_t)(tr_ + kr1) * kpitch + kc1 * 8); vreg = *(const u32x4*)(Vp + (size_t)(tr_ + vr) * vpitch + vc * 8); } while (0)
#define ATT_WRITE(b) do { *(LAS u32x4*)(Kl + (b) * KSZ + kdst0) = kreg0; if (k2) *(LAS u32x4*)(Kl + (b) * KSZ + kdst1) = kreg1; *(LAS u32x4*)(Vl + (b) * 8192 + vdst) = vreg; } while (0)
    ATT_LOAD(0); ATT_WRITE(0);
    __syncthreads();
    for (int t = 0; t < NT; ++t) {
        const int b = t & 1;
        if (t + 1 < NT) ATT_LOAD(t + 1);
        bool active = true;
        if (MODE == 2) { if (t < n0) { const int kr = lo + t; active = (kr >= rs) && (kr < rs + 8); } }
        if (active) {
            f32x16 p0, p1;
#pragma unroll
            for (int i = 0; i < 16; ++i) { p0[i] = 0.f; p1[i] = 0.f; }
            const LAS unsigned char* kb = Kl + b * KSZ + r32 * KSTR + hi * 16;
#pragma unroll
            for (int d0 = 0; d0 < DK / 16; ++d0) {
                const bf16x8 ka = *(const LAS bf16x8*)(kb + d0 * 32), kc = *(const LAS bf16x8*)(kb + 32 * KSTR + d0 * 32);
                p0 = __builtin_amdgcn_mfma_f32_32x32x16_bf16(ka, qf[d0], p0, 0, 0, 0);
                p1 = __builtin_amdgcn_mfma_f32_32x32x16_bf16(kc, qf[d0], p1, 0, 0, 0);
            }
            if (MODE == 2) { if (t < n0) {
                const LAS float* brow = rpbL + (lo + t - rq + 7) * 32;
                int cq_ = cq, cs_ = cs; asm volatile("" : "+v"(cq_), "+v"(cs_));
#pragma unroll
                for (int i = 0; i < 16; ++i) {
                    const int kc_ = crow(i, hi);
                    { const int rel = kc_ - cs_; const int bi = min(max(kc_ - cq_ + 15, 0), 30); p0[i] = ((unsigned)rel < 16u) ? p0[i] + brow[bi] : -1e30f; }
                    { const int rel = kc_ + 32 - cs_; const int bi = min(max(kc_ + 32 - cq_ + 15, 0), 30); p1[i] = ((unsigned)rel < 16u) ? p1[i] + brow[bi] : -1e30f; }
                    if ((i & 3) == 3) asm volatile("" ::: "memory");
                } } }
            float mx = fmaxf(p0[0], p1[0]);
#pragma unroll
            for (int i = 1; i < 16; ++i) mx = fmaxf(mx, fmaxf(p0[i], p1[i]));
            mx = fmaxf(mx, __shfl_xor(mx, 32));
            const float mnew = fmaxf(mrun, mx), alpha = __builtin_amdgcn_exp2f(mrun - mnew);
            mrun = mnew; lrun *= alpha;
            float rsum = 0.f;
#pragma unroll
            for (int i = 0; i < 16; ++i) { o0[i] *= alpha; o1[i] *= alpha; p0[i] = __builtin_amdgcn_exp2f(p0[i] - mnew); p1[i] = __builtin_amdgcn_exp2f(p1[i] - mnew); rsum += p0[i] + p1[i]; }
            lrun += rsum;
            bf16x8 pf[4];
#pragma unroll
            for (int ks = 0; ks < 4; ++ks) { u32x4 w;
                if (ks < 2) { const int s8 = 8 * ks; w.x = cvt_pk_bf16(p0[s8], p0[s8 + 1]); w.y = cvt_pk_bf16(p0[s8 + 2], p0[s8 + 3]); w.z = cvt_pk_bf16(p0[s8 + 4], p0[s8 + 5]); w.w = cvt_pk_bf16(p0[s8 + 6], p0[s8 + 7]); }
                else { const int s8 = 8 * (ks - 2); w.x = cvt_pk_bf16(p1[s8], p1[s8 + 1]); w.y = cvt_pk_bf16(p1[s8 + 2], p1[s8 + 3]); w.z = cvt_pk_bf16(p1[s8 + 4], p1[s8 + 5]); w.w = cvt_pk_bf16(p1[s8 + 6], p1[s8 + 7]); }
                pf[ks] = __builtin_bit_cast(bf16x8, w); }
            const LAS unsigned char* vbase = Vl + b * 8192 + vb;
#pragma unroll
            for (int ks = 0; ks < 4; ++ks) {
                const s16x4 a0 = __builtin_bit_cast(s16x4, __builtin_amdgcn_ds_read_tr16_b64_v4i16((LAS s16x4*)(vbase + ks * 1024)));
                const s16x4 a1 = __builtin_bit_cast(s16x4, __builtin_amdgcn_ds_read_tr16_b64_v4i16((LAS s16x4*)(vbase + ks * 1024 + 512)));
                const s16x4 c0 = __builtin_bit_cast(s16x4, __builtin_amdgcn_ds_read_tr16_b64_v4i16((LAS s16x4*)(vbase + 4096 + ks * 1024)));
                const s16x4 c1 = __builtin_bit_cast(s16x4, __builtin_amdgcn_ds_read_tr16_b64_v4i16((LAS s16x4*)(vbase + 4096 + ks * 1024 + 512)));
                const bf16x8 v0 = (bf16x8){a0[0], a0[1], a0[2], a0[3], a1[0], a1[1], a1[2], a1[3]}, v1 = (bf16x8){c0[0], c0[1], c0[2], c0[3], c1[0], c1[1], c1[2], c1[3]};
                o0 = __builtin_amdgcn_mfma_f32_32x32x16_bf16(v0, pf[ks], o0, 0, 0, 0);
                o1 = __builtin_amdgcn_mfma_f32_32x32x16_bf16(v1, pf[ks], o1, 0, 0, 0);
            }
        }
        if (t + 1 < NT) ATT_WRITE(b ^ 1);
        __syncthreads();
    }
#undef ATT_TROW
#undef ATT_LOAD
#undef ATT_WRITE
    lrun += __shfl_xor(lrun, 32);
    const float il = 1.f / lrun;
    bf16* op = Op + (size_t)(qrow0 + wid * 32 + r32) * 1024 + 4 * hi;
#pragma unroll
    for (int g = 0; g < 4; ++g) {
        u32x2 w0, w1; w0.x = cvt_pk_bf16(o0[4 * g] * il, o0[4 * g + 1] * il); w0.y = cvt_pk_bf16(o0[4 * g + 2] * il, o0[4 * g + 3] * il);
        w1.x = cvt_pk_bf16(o1[4 * g] * il, o1[4 * g + 1] * il); w1.y = cvt_pk_bf16(o1[4 * g + 2] * il, o1[4 * g + 3] * il);
        *(u32x2*)(op + 8 * g) = w0; *(u32x2*)(op + 32 + 8 * g) = w1;
    }
}

template <int DK>
__device__ __forceinline__ void attn_unit_pipe(LAS unsigned char* lds, const bf16* Qp, int qpitch, const bf16* Kp, int kpitch, const bf16* Vp, int vpitch, bf16* Op,
                                               int qrow0, int base0, int n0, int base1, int NT) {
    constexpr int KSTR = DK * 2 + 16, KSZ = 64 * KSTR, CPR = DK / 8, NCH = 64 * CPR;
    int tid_ = threadIdx.x; asm volatile("" : "+v"(tid_));
    const int tid = tid_, lane = tid & 63, r32 = lane & 31, hi = lane >> 5; const int wid = __builtin_amdgcn_readfirstlane(tid >> 6);
    LAS unsigned char* Kl = lds; LAS unsigned char* Vl = lds + 2 * KSZ;
    const int kr0 = tid / CPR, kc0 = tid % CPR, kr1 = (tid + 512) / CPR, kc1 = (tid + 512) % CPR; const bool k2 = (tid + 512) < NCH;
    const int vr = tid >> 3, vc = tid & 7;
    const unsigned kdst0 = kr0 * KSTR + kc0 * 16, kdst1 = kr1 * KSTR + kc1 * 16, vdst = (vc >> 2) * 4096 + vr * 64 + (vc & 3) * 16;
    bf16x8 qf[DK / 16];
    { const bf16* qp = Qp + (size_t)(qrow0 + wid * 32 + r32) * qpitch + hi * 8;
#pragma unroll
      for (int d0 = 0; d0 < DK / 16; ++d0) qf[d0] = *(const bf16x8*)(qp + 16 * d0); }
    f32x16 o0, o1, pc0, pc1, pn0, pn1;
#pragma unroll
    for (int i = 0; i < 16; ++i) { o0[i] = 0.f; o1[i] = 0.f; }
    float mrun = -1e30f, lrun = 0.f;
    const unsigned vb = (4 * hi + ((lane & 15) >> 2)) * 64 + ((lane >> 4) & 1) * 32 + (lane & 3) * 8;
    const unsigned kbo = r32 * KSTR + hi * 16;
    u32x4 kreg0, kreg1, vreg;
#define AP_TROW(t) ((t) < n0 ? base0 + 64 * (t) : base1 + 64 * ((t) - n0))
#define AP_LOADK(t) do { const int tr_ = AP_TROW(t); kreg0 = *(const u32x4*)(Kp + (size_t)(tr_ + kr0) * kpitch + kc0 * 8); if (k2) kreg1 = *(const u32x4*)(Kp + (size_t)(tr_ + kr1) * kpitch + kc1 * 8); } while (0)
#define AP_LOADV(t) do { const int tr_ = AP_TROW(t); vreg = *(const u32x4*)(Vp + (size_t)(tr_ + vr) * vpitch + vc * 8); } while (0)
#define AP_WRITEK(b) do { *(LAS u32x4*)(Kl + (b) * KSZ + kdst0) = kreg0; if (k2) *(LAS u32x4*)(Kl + (b) * KSZ + kdst1) = kreg1; } while (0)
#define AP_WRITEV(b) do { *(LAS u32x4*)(Vl + (b) * 8192 + vdst) = vreg; } while (0)
#define AP_QK(P0, P1, b) do { const LAS unsigned char* kb_ = Kl + (b) * KSZ + kbo; \
        _Pragma("unroll") for (int i_ = 0; i_ < 16; ++i_) { P0[i_] = 0.f; P1[i_] = 0.f; } \
        _Pragma("unroll") for (int d0 = 0; d0 < DK / 16; ++d0) { \
            const bf16x8 ka_ = *(const LAS bf16x8*)(kb_ + d0 * 32), kc_ = *(const LAS bf16x8*)(kb_ + 32 * KSTR + d0 * 32); \
            P0 = __builtin_amdgcn_mfma_f32_32x32x16_bf16(ka_, qf[d0], P0, 0, 0, 0); P1 = __builtin_amdgcn_mfma_f32_32x32x16_bf16(kc_, qf[d0], P1, 0, 0, 0); } } while (0)
#define AP_SMPV(P0, P1, b) do { \
        float mx_ = fmaxf(P0[0], P1[0]); \
        _Pragma("unroll") for (int i_ = 1; i_ < 16; ++i_) mx_ = fmaxf(mx_, fmaxf(P0[i_], P1[i_])); \
        mx_ = fmaxf(mx_, __shfl_xor(mx_, 32)); \
        if (__any(mx_ > mrun)) { const float mnew_ = fmaxf(mrun, mx_), alpha_ = __builtin_amdgcn_exp2f(mrun - mnew_); mrun = mnew_; lrun *= alpha_; \
            _Pragma("unroll") for (int i_ = 0; i_ < 16; ++i_) { o0[i_] *= alpha_; o1[i_] *= alpha_; } } \
        float rsum_ = 0.f; \
        _Pragma("unroll") for (int i_ = 0; i_ < 16; ++i_) { P0[i_] = __builtin_amdgcn_exp2f(P0[i_] - mrun); P1[i_] = __builtin_amdgcn_exp2f(P1[i_] - mrun); rsum_ += P0[i_] + P1[i_]; } \
        lrun += rsum_; \
        bf16x8 pf_[4]; \
        _Pragma("unroll") for (int ks = 0; ks < 4; ++ks) { u32x4 w_; \
            if (ks < 2) { const int s8 = 8 * ks; w_.x = cvt_pk_bf16(P0[s8], P0[s8 + 1]); w_.y = cvt_pk_bf16(P0[s8 + 2], P0[s8 + 3]); w_.z = cvt_pk_bf16(P0[s8 + 4], P0[s8 + 5]); w_.w = cvt_pk_bf16(P0[s8 + 6], P0[s8 + 7]); } \
            else { const int s8 = 8 * (ks - 2); w_.x = cvt_pk_bf16(P1[s8], P1[s8 + 1]); w_.y = cvt_pk_bf16(P1[s8 + 2], P1[s8 + 3]); w_.z = cvt_pk_bf16(P1[s8 + 4], P1[s8 + 5]); w_.w = cvt_pk_bf16(P1[s8 + 6], P1[s8 + 7]); } \
            pf_[ks] = __builtin_bit_cast(bf16x8, w_); } \
        const LAS unsigned char* vbase_ = Vl + (b) * 8192 + vb; \
        _Pragma("unroll") for (int ks = 0; ks < 4; ++ks) { \
            const s16x4 a0_ = __builtin_bit_cast(s16x4, __builtin_amdgcn_ds_read_tr16_b64_v4i16((LAS s16x4*)(vbase_ + ks * 1024))); \
            const s16x4 a1_ = __builtin_bit_cast(s16x4, __builtin_amdgcn_ds_read_tr16_b64_v4i16((LAS s16x4*)(vbase_ + ks * 1024 + 512))); \
            const s16x4 c0_ = __builtin_bit_cast(s16x4, __builtin_amdgcn_ds_read_tr16_b64_v4i16((LAS s16x4*)(vbase_ + 4096 + ks * 1024))); \
            const s16x4 c1_ = __builtin_bit_cast(s16x4, __builtin_amdgcn_ds_read_tr16_b64_v4i16((LAS s16x4*)(vbase_ + 4096 + ks * 1024 + 512))); \
            const bf16x8 v0_ = (bf16x8){a0_[0], a0_[1], a0_[2], a0_[3], a1_[0], a1_[1], a1_[2], a1_[3]}, v1_ = (bf16x8){c0_[0], c0_[1], c0_[2], c0_[3], c1_[0], c1_[1], c1_[2], c1_[3]}; \
            o0 = __builtin_amdgcn_mfma_f32_32x32x16_bf16(v0_, pf_[ks], o0, 0, 0, 0); o1 = __builtin_amdgcn_mfma_f32_32x32x16_bf16(v1_, pf_[ks], o1, 0, 0, 0); } } while (0)
    AP_LOADK(0); AP_LOADV(0); AP_WRITEK(0); AP_WRITEV(0);
    AP_LOADK(1); AP_WRITEK(1);
    __syncthreads();
    AP_QK(pc0, pc1, 0);
    __syncthreads();
    for (int t = 0; t < NT; ++t) {
        const int b = t & 1;
        const bool more1 = t + 1 < NT, more2 = t + 2 < NT;
        if (more2) AP_LOADK(t + 2);
        if (more1) AP_LOADV(t + 1);
        if (wid < 4) {
            if (more1) AP_QK(pn0, pn1, b ^ 1);
            AP_SMPV(pc0, pc1, b);
        } else {
            AP_SMPV(pc0, pc1, b);
            if (more1) AP_QK(pn0, pn1, b ^ 1);
        }
        if (more2) AP_WRITEK(b);
        if (more1) AP_WRITEV(b ^ 1);
        pc0 = pn0; pc1 = pn1;
        __syncthreads();
    }
#undef AP_TROW
#undef AP_LOADK
#undef AP_LOADV
#undef AP_WRITEK
#undef AP_WRITEV
#undef AP_QK
#undef AP_SMPV
    lrun += __shfl_xor(lrun, 32);
    const float il = 1.f / lrun;
    bf16* op = Op + (size_t)(qrow0 + wid * 32 + r32) * 1024 + 4 * hi;
#pragma unroll
    for (int g = 0; g < 4; ++g) {
        u32x2 w0, w1; w0.x = cvt_pk_bf16(o0[4 * g] * il, o0[4 * g + 1] * il); w0.y = cvt_pk_bf16(o0[4 * g + 2] * il, o0[4 * g + 3] * il);
        w1.x = cvt_pk_bf16(o1[4 * g] * il, o1[4 * g + 1] * il); w1.y = cvt_pk_bf16(o1[4 * g + 2] * il, o1[4 * g + 3] * il);
        *(u32x2*)(op + 8 * g) = w0; *(u32x2*)(op + 32 + 8 * g) = w1;
    }
}

namespace attn_body {
using bf16=__hip_bfloat16;
using bf16x8=__attribute__((ext_vector_type(8)))short;
using s16x4=__attribute__((ext_vector_type(4)))short;
using f32x16=__attribute__((ext_vector_type(16)))float;
using u32x4=__attribute__((ext_vector_type(4)))unsigned;
constexpr int D=64;
constexpr int NW=8,QBLK=32,QB=QBLK*NW,KVBLK=64;
constexpr int ATTN_UNIT_ROWS=QB;
__device__ __forceinline__ int crow(int r,int hi){return (r&3)+8*(r>>2)+4*hi;}
#define SBAR() __builtin_amdgcn_sched_barrier(0)
__device__ __forceinline__ void cmask(f32x16&p0,f32x16&p1,int jb,int qrel,int hi){
  const float NEG=-INFINITY; int kb=64*jb+4*hi;
  #pragma unroll
  for(int r=0;r<16;++r){int kv=kb+(r&3)+8*(r>>2); if(kv>qrel)p0[r]=NEG; if(kv+32>qrel)p1[r]=NEG;}
}

constexpr int NSLOT=3, SLOTB=8192;
constexpr int LDS_K=0, LDS_V=NSLOT*SLOTB, LDS_WS=2*NSLOT*SLOTB, LDS_OST=LDS_WS+NW*64*4, LDS_BYTES=LDS_OST+NW*4096;
constexpr float C2=0.125f*1.4426950408889634f;
__device__ __forceinline__ void glds16(const void*gsrc,unsigned lds_dst){unsigned keep;
  asm volatile("s_mov_b32 %0, m0\n\ts_mov_b32 m0, %2\n\ts_nop 0\n\tglobal_load_lds_dwordx4 %1, off\n\ts_mov_b32 m0, %0":"=&s"(keep):"v"(gsrc),"s"(lds_dst):"memory");}
__device__ __forceinline__ float max3f(float a,float b,float c){float r;asm("v_max3_f32 %0, %1, %2, %3":"=v"(r):"v"(a),"v"(b),"v"(c));return r;}
__device__ __forceinline__ float max2f(float a,float b){float r;asm("v_max_f32_e32 %0, %1, %2":"=v"(r):"v"(a),"v"(b));return r;}
__device__ __forceinline__ float fadd_s(float a,float b){float r;asm("v_add_f32_e32 %0, %1, %2":"=v"(r):"v"(a),"v"(b));return r;}
__device__ __forceinline__ float fsub_s(float a,float b){float r;asm("v_sub_f32_e32 %0, %1, %2":"=v"(r):"v"(a),"v"(b));return r;}
constexpr unsigned NA_STRIP=736u;
typedef float f32x2_t __attribute__((ext_vector_type(2))); typedef __bf16 bf16x2_t __attribute__((ext_vector_type(2)));
__device__ __forceinline__ unsigned cvtpk_s(float lo,float hi){f32x2_t v={lo,hi};bf16x2_t b=__builtin_convertvector(v,bf16x2_t);return __builtin_bit_cast(unsigned,b);}
#define WAIT_BAR(N) asm volatile("s_waitcnt vmcnt(" #N ") lgkmcnt(0)\n\ts_barrier":::"memory")

template<int ND> __device__ __forceinline__ void qkt(f32x16&p0,f32x16&p1,const char*Kslot,const bf16x8*qr,const f32x16&negm,int r32,int hi){
  const char*kb=Kslot+hi*1024+r32*16;
  #pragma unroll
  for(int d0=0;d0<ND;++d0){
    const bf16x8 b0=*reinterpret_cast<const bf16x8*>(kb+d0*2048);
    const bf16x8 b1=*reinterpret_cast<const bf16x8*>(kb+d0*2048+512);
    if(d0==0){p0=__builtin_amdgcn_mfma_f32_32x32x16_bf16(b0,qr[0],negm,0,0,0);p1=__builtin_amdgcn_mfma_f32_32x32x16_bf16(b1,qr[0],negm,0,0,0);}
    else{p0=__builtin_amdgcn_mfma_f32_32x32x16_bf16(b0,qr[d0],p0,0,0,0);p1=__builtin_amdgcn_mfma_f32_32x32x16_bf16(b1,qr[d0],p1,0,0,0);}}
}
typedef __attribute__((address_space(3))) const char* lds_cptr;
typedef short v4i16_t __attribute__((ext_vector_type(4)));
__device__ __forceinline__ void kload8(bf16x8*kf,lds_cptr kp){
  kf[0]=*(const __attribute__((address_space(3))) bf16x8*)(kp);      kf[1]=*(const __attribute__((address_space(3))) bf16x8*)(kp+512);
  kf[2]=*(const __attribute__((address_space(3))) bf16x8*)(kp+2048); kf[3]=*(const __attribute__((address_space(3))) bf16x8*)(kp+2560);
  kf[4]=*(const __attribute__((address_space(3))) bf16x8*)(kp+4096); kf[5]=*(const __attribute__((address_space(3))) bf16x8*)(kp+4608);
  kf[6]=*(const __attribute__((address_space(3))) bf16x8*)(kp+6144); kf[7]=*(const __attribute__((address_space(3))) bf16x8*)(kp+6656);
}
__device__ __forceinline__ void kload2(bf16x8*kf,lds_cptr kp,int j){ kf[2*j]=*(const __attribute__((address_space(3))) bf16x8*)(kp+j*2048); kf[2*j+1]=*(const __attribute__((address_space(3))) bf16x8*)(kp+j*2048+512); }
__device__ __forceinline__ s16x4 vtr(lds_cptr p){ return __builtin_bit_cast(s16x4,__builtin_amdgcn_ds_read_tr16_b64_v4i16((__attribute__((address_space(3))) v4i16_t*)p)); }
__device__ __forceinline__ float rowmax(const f32x16&p0,const f32x16&p1){
  float a=max3f(p0[0],p0[1],p1[0]),b=max3f(p0[2],p0[3],p1[1]);a=max3f(a,p1[2],p1[3]);
  #pragma unroll
  for(int r=4;r<16;r+=4){a=max3f(a,p0[r],p0[r+1]);b=max3f(b,p0[r+2],p0[r+3]);a=max3f(a,p1[r],p1[r+1]);b=max3f(b,p1[r+2],p1[r+3]);}
  const float m=max2f(a,b);
  auto rr=__builtin_amdgcn_permlane32_swap(__float_as_uint(m),__float_as_uint(m),false,false);
  return max2f(__uint_as_float(rr[0]),__uint_as_float(rr[1]));
}
__device__ __forceinline__ void pv(f32x16*o,int vb,bf16x8 pa0,bf16x8 pa1,bf16x8 pa2,bf16x8 pa3){
  #pragma unroll
  for(int d0=0;d0<2;++d0){s16x4 lo[4],hi[4];
    #pragma unroll
    for(int ks=0;ks<4;++ks){
      asm volatile("ds_read_b64_tr_b16 %0,%1 offset:%c2":"=&v"(lo[ks]):"v"(vb),"i"(d0*4096+ks*1024):"memory");
      asm volatile("ds_read_b64_tr_b16 %0,%1 offset:%c2":"=&v"(hi[ks]):"v"(vb),"i"(d0*4096+ks*1024+512):"memory");}
    asm volatile("s_waitcnt lgkmcnt(0)":::"memory");SBAR();
    #define PK(k) (bf16x8){lo[k][0],lo[k][1],lo[k][2],lo[k][3],hi[k][0],hi[k][1],hi[k][2],hi[k][3]}
    o[d0]=__builtin_amdgcn_mfma_f32_32x32x16_bf16(pa0,PK(0),o[d0],0,0,0);
    o[d0]=__builtin_amdgcn_mfma_f32_32x32x16_bf16(pa1,PK(1),o[d0],0,0,0);
    o[d0]=__builtin_amdgcn_mfma_f32_32x32x16_bf16(pa2,PK(2),o[d0],0,0,0);
    o[d0]=__builtin_amdgcn_mfma_f32_32x32x16_bf16(pa3,PK(3),o[d0],0,0,0);
    #undef PK
  }
}

#ifndef ATTN_STORE16
#define ATTN_STORE16(p,v) (*(u32x4*)(p)=(v))
#endif
struct NextU { bool on; const bf16*Q; const bf16*K; const bf16*V; int qrow0, base0; };
template<int THRL,bool NA=false,int DK=64,bool PFQ=true> __device__ __forceinline__ int attn_unit(const bf16*Qw0,int QP,const bf16*__restrict__ Kh,const bf16*__restrict__ Vh,int KP,int VP,bf16*Ow0,int qrow0,int base0,int n0,int base1,int NT,char*shm,
                                                                bf16x8 (&qr)[6],bool pre,int s0,const NextU&nx,int g4=0,int lo=0,int nwin=0){
  int tid_=threadIdx.x; asm volatile("":"+v"(tid_));
  const int tid=tid_,lane=tid&63,r32=lane&31,hi=lane>>5; const int wid=__builtin_amdgcn_readfirstlane(tid>>6);
  constexpr int ND=DK/16, KSLOT=64*DK*2, L_K=0, L_V=NSLOT*KSLOT, L_WS=L_V+NSLOT*SLOTB, L_OST=L_WS+NW*64*4;
  #define KO(sl) ((DK==64)?(sl):((sl)+((sl)>>1)))
  #define WAIT_BARK(a_,b_) do{ if(DK==64){WAIT_BAR(a_);}else{WAIT_BAR(b_);} }while(0)
  const bf16*Qw=Qw0+(long)(qrow0+wid*QBLK)*QP;
  const unsigned lds0=(unsigned)(uintptr_t)shm;
  float*wsf=(float*)(shm+L_WS)+wid*64;
  const __attribute__((address_space(3))) float*rpbL=(const __attribute__((address_space(3))) float*)((__attribute__((address_space(3))) const char*)shm+86016);
  const int na_rq=g4+(wid>>1), na_rs=min(max(na_rq-4,0),24), na_cq=32*(wid&1)+r32;
  const unsigned na_base=(unsigned)(uintptr_t)rpbL+16u*(unsigned)hi+4u*(unsigned)(na_cq<8?112+80*na_cq:(na_cq>56?128+80*(na_cq-57):56-na_cq));
  const unsigned na_flat=(unsigned)(uintptr_t)rpbL+15u*4u*NA_STRIP+16u*(unsigned)hi;
  const bf16*ksrc=Kh+(long)lane*KP+wid*8;
  const bf16*vsrc=Vh+(long)(16*(wid&3)+(lane>>2))*VP+(wid>>2)*32+(lane&3)*8;
  const bf16*ksrc2=Kh+(long)lane*KP+(8+(wid&3))*8;
  const unsigned kdst=lds0+L_K+wid*1024, kdst2=lds0+L_K+(8+(wid&3))*1024, vdst=lds0+L_V+wid*1024;
  #define TROW(t) ((t)<n0?base0+64*(t):base1+64*((t)-n0))
  #define DMA_K(t,slot) do{ glds16(ksrc+(long)TROW(t)*KP,(unsigned)__builtin_amdgcn_readfirstlane(kdst+KO(slot))); if(DK==96) glds16(ksrc2+(long)TROW(t)*KP,(unsigned)__builtin_amdgcn_readfirstlane(kdst2+KO(slot))); }while(0)
  #define DMA_V(t,slot) glds16(vsrc+(long)TROW(t)*VP,(unsigned)__builtin_amdgcn_readfirstlane(vdst+(slot)))
  #define DMA_KN(t,slot) do{ glds16(ksrc+dKn_+(long)(b0n_+64*(t))*KP,(unsigned)__builtin_amdgcn_readfirstlane(kdst+KO(slot))); if(DK==96) glds16(ksrc2+dKn_+(long)(b0n_+64*(t))*KP,(unsigned)__builtin_amdgcn_readfirstlane(kdst2+KO(slot))); }while(0)
  #define DMA_VN(t,slot) glds16(vsrc+dVn_+(long)(b0n_+64*(t))*VP,(unsigned)__builtin_amdgcn_readfirstlane(vdst+(slot)))
  const int vb0=(int)(lds0+L_V)+((lane>>4)&1)*32+(lane&3)*8+(4*hi+((lane&15)>>2))*64;
  const char*Kbase=shm+L_K; bf16x8 kf[12];
  const lds_cptr shm3=(lds_cptr)shm; const lds_cptr kp0=shm3+L_K+hi*1024+r32*16; const lds_cptr vp0=shm3+L_V+((lane>>4)&1)*32+(lane&3)*8+(4*hi+((lane&15)>>2))*64;
  const int s1=(s0==(NSLOT-1)*SLOTB)?0:s0+SLOTB, s2=(s1==(NSLOT-1)*SLOTB)?0:s1+SLOTB;
  if(!pre){ DMA_K(0,s0);DMA_V(0,s0);DMA_K(1,s1); }
  if(!pre||!PFQ){
    #pragma unroll
    for(int d0=0;d0<ND;++d0)qr[d0]=*reinterpret_cast<const bf16x8*>(&Qw[(long)r32*QP+d0*16+hi*8]);
  }
  float z_; asm volatile("v_mov_b32 %0, 0":"=v"(z_));
  float mhat=0.f,l_reg=0.f;f32x16 o[2],negm,zero16;
  #pragma unroll
  for(int r=0;r<16;++r){o[0][r]=z_;o[1][r]=z_;negm[r]=z_;zero16[r]=z_;}
  if(!NA){asm volatile("":"+v"(negm));}
  #define CMASK(P0,P1,t) do{}while(0)
  bool resc=false, na_m0=true;
  #define START(P0,P1) do{ const float rm=rowmax(P0,P1); resc=false; \
    { float dl=rm; if(NA){ if(__builtin_expect(__any(__builtin_fabsf(rm)>(float)THRL),0)){ na_m0=false; } else { dl=0.f; } } mhat=fadd_s(mhat,dl); \
      _Pragma("unroll") for(int r=0;r<16;++r){P0[r]=fsub_s(P0[r],dl);P1[r]=fsub_s(P1[r],dl);} \
      if(!NA){ _Pragma("unroll") for(int r=0;r<16;++r)negm[r]=-mhat; asm volatile("":"+v"(negm)); } } \
    _Pragma("unroll") for(int r=0;r<16;++r)P0[r]=__builtin_amdgcn_exp2f(P0[r]); }while(0)
  #define RESC() do{ if(resc){ asm volatile("s_waitcnt lgkmcnt(0)":::"memory"); \
      _Pragma("unroll") for(int d_=0;d_<2;++d_) _Pragma("unroll") for(int r=0;r<16;++r)o[d_][r]*=wsf[crow(r,hi)]; } }while(0)
  f32x16 pA0,pA1,pB0,pB1;
  int sl_prev=s0,sl_cur=s0,sl_next=s1;
  #define ROT() do{sl_prev=sl_cur;sl_cur=sl_next;sl_next=(sl_next==(NSLOT-1)*SLOTB)?0:sl_next+SLOTB;}while(0)
  if(!pre){
    DMA_K(2,s2);
    WAIT_BARK(3,5);
  } else { if(PFQ){ WAIT_BAR(4); } else { WAIT_BAR(0); } }
  DMA_V(1,s1);
  qkt<ND>(pA0,pA1,Kbase+KO(s0),qr,zero16,r32,hi);asm volatile("s_nop 15\n\ts_nop 7":"+v"(pA0),"+v"(pA1));CMASK(pA0,pA1,0);
  START(pA0,pA1);
  _Pragma("unroll") for(int r=0;r<16;++r)pA1[r]=__builtin_amdgcn_exp2f(pA1[r]);
  if(NA){ _Pragma("unroll") for(int r=0;r<16;++r){pB0[r]=z_;pB1[r]=z_;} }
  WAIT_BAR(1);
  DMA_K(3,s0);
  ROT();
  _Pragma("unroll") for(int j_=0;j_<ND;++j_) kload2(kf,kp0+KO(sl_cur),j_);
  WAIT_BARK(2,3);
  s16x4 vlo[8],vhi[8]; u32x4 pw0,pw1,pw2,pw3;
  #define PKW(P,B) cvtpk_s(P[B],P[B+1])
  #define PAF(k) __builtin_bit_cast(bf16x8,pw##k)
  #define VFR(i) (bf16x8){vlo[i][0],vlo[i][1],vlo[i][2],vlo[i][3],vhi[i][0],vhi[i][1],vhi[i][2],vhi[i][3]}
  #define PIN(x) asm volatile("":"+v"(x))
  #define MX3(a,b,c) __builtin_fmaxf(__builtin_fmaxf((a),(b)),(c))
  #define GAPA(MF,A0,A1,A2,A3,W0,W1,PW) do{ MF; sacc+=A0; sacc+=A1; sacc+=A2; sacc+=A3; PIN(sacc); W0; W1; PIN(PW); SBAR(); }while(0)
  #define EX(v) __builtin_amdgcn_exp2f(v)
  #define GAPB(MF,X,B,FILL) do{ MF; X[B]=EX(X[B]); X[B+1]=EX(X[B+1]); X[B+2]=EX(X[B+2]); X[B+3]=EX(X[B+3]); PIN(X); FILL; SBAR(); }while(0)
  #define LDSF(x) (*(const __attribute__((address_space(3))) float*)(x))
  #define NAC(r) (4u*(unsigned)(((r)&3)+8*((r)>>2)))
  #define NAF_LD(F0,F1,g) do{ F0[2*(g)]=LDSF(na_a+NAC(2*(g))); F0[2*(g)+1]=LDSF(na_a+NAC(2*(g)+1)); F1[2*(g)]=LDSF(na_a+NAC(2*(g))+128u); F1[2*(g)+1]=LDSF(na_a+NAC(2*(g)+1)+128u); }while(0)
  #define NAF_FIN(F0,F1,g) do{ F0[2*(g)]-=mhat; F0[2*(g)+1]-=mhat; F1[2*(g)]-=mhat; F1[2*(g)+1]-=mhat; }while(0)
  #define NAF(F0,F1,g) do{ if(NA){ NAF_LD(F0,F1,g); } }while(0)
  #define VRD(i) do{ vlo[i]=vtr(vp_+(((i)>>2)*4096+((i)&3)*1024)); vhi[i]=vtr(vp_+(((i)>>2)*4096+((i)&3)*1024+512)); }while(0)
  #define KRD(G,j) do{ if(G){ kload2(kf,kp0+KO(sl_next),j); SBAR(); } }while(0)
  #define STEP(C0,C1,P0,P1,t,GK,GV,GL,NX) do{ \
    if(NA){ if(__builtin_expect(!na_m0,0)){ _Pragma("unroll") for(int r=0;r<16;++r){C0[r]-=mhat;C1[r]-=mhat;} } } \
    SBAR(); \
    const lds_cptr vp_=vp0+sl_prev; \
    VRD(0); SBAR(); float sacc=(P0[0]+P0[1]); \
    GAPA(C0=__builtin_amdgcn_mfma_f32_32x32x16_bf16(kf[0],qr[0],(NA?C0:negm),0,0,0), P0[2],P0[3],P0[4],P0[5],     pw0[0]=PKW(P0,0), pw0[1]=PKW(P0,2), pw0); \
    VRD(4); SBAR(); GAPA(C1=__builtin_amdgcn_mfma_f32_32x32x16_bf16(kf[1],qr[0],(NA?C1:negm),0,0,0), P0[6],P0[7],P0[8],P0[9],     pw0[2]=PKW(P0,4), pw0[3]=PKW(P0,6), pw0); \
    VRD(1); SBAR(); GAPA(C0=__builtin_amdgcn_mfma_f32_32x32x16_bf16(kf[2],qr[1],C0,0,0,0),   P0[10],P0[11],P0[12],P0[13], pw1[0]=PKW(P0,8), pw1[1]=PKW(P0,10), pw1); \
    VRD(5); SBAR(); GAPA(C1=__builtin_amdgcn_mfma_f32_32x32x16_bf16(kf[3],qr[1],C1,0,0,0),   P0[14],P0[15],P1[0],P1[1],   pw1[2]=PKW(P0,12),pw1[3]=PKW(P0,14), pw1); \
    VRD(2); SBAR(); GAPA(C0=__builtin_amdgcn_mfma_f32_32x32x16_bf16(kf[4],qr[2],C0,0,0,0),   P1[2],P1[3],P1[4],P1[5],     pw2[0]=PKW(P1,0), pw2[1]=PKW(P1,2), pw2); \
    VRD(6); SBAR(); GAPA(C1=__builtin_amdgcn_mfma_f32_32x32x16_bf16(kf[5],qr[2],C1,0,0,0),   P1[6],P1[7],P1[8],P1[9],     pw2[2]=PKW(P1,4), pw2[3]=PKW(P1,6), pw2); \
    VRD(3); SBAR(); GAPA(C0=__builtin_amdgcn_mfma_f32_32x32x16_bf16(kf[6],qr[3],C0,0,0,0),   P1[10],P1[11],P1[12],P1[13], pw3[0]=PKW(P1,8), pw3[1]=PKW(P1,10), pw3); \
    VRD(7); SBAR(); GAPA(C1=__builtin_amdgcn_mfma_f32_32x32x16_bf16(kf[7],qr[3],C1,0,0,0),   P1[14],P1[15],0.f,0.f,       pw3[2]=PKW(P1,12),pw3[3]=PKW(P1,14), pw3); \
    if(DK==96){ C0=__builtin_amdgcn_mfma_f32_32x32x16_bf16(kf[8],qr[4],C0,0,0,0); SBAR(); C1=__builtin_amdgcn_mfma_f32_32x32x16_bf16(kf[9],qr[4],C1,0,0,0); SBAR(); \
      C0=__builtin_amdgcn_mfma_f32_32x32x16_bf16(kf[10],qr[5],C0,0,0,0); SBAR(); C1=__builtin_amdgcn_mfma_f32_32x32x16_bf16(kf[11],qr[5],C1,0,0,0); SBAR(); } \
    l_reg+=sacc; \
    if(GK){DMA_K((t)+3,sl_cur);} if(GV){DMA_V((t)+1,sl_next);} \
    if(NX){ const long dKn_=nx.K-Kh,dVn_=nx.V-Vh; const int b0n_=nx.base0; DMA_KN(0,sl_next); DMA_VN(0,sl_next); DMA_KN(1,sl_prev); DMA_KN(2,sl_cur); } \
    CMASK(C0,C1,t); \
    { float a=MX3(C0[0],C0[1],C1[0]),b=MX3(C0[2],C0[3],C1[1]); a=MX3(a,C1[2],C1[3]); \
      _Pragma("unroll") for(int r=4;r<16;r+=4){a=MX3(a,C0[r],C0[r+1]);b=MX3(b,C0[r+2],C0[r+3]);a=MX3(a,C1[r],C1[r+1]);b=MX3(b,C1[r+2],C1[r+3]);} \
      float rm=__builtin_fmaxf(a,b); { auto rr=__builtin_amdgcn_permlane32_swap(__float_as_uint(rm),__float_as_uint(rm),false,false); rm=__builtin_fmaxf(__uint_as_float(rr[0]),__uint_as_float(rr[1])); } \
      resc=false; \
      if(__builtin_expect(__any(rm>(float)THRL),0)){ const float dl=__builtin_fmaxf(rm,0.f); mhat+=dl; \
        _Pragma("unroll") for(int r=0;r<16;++r){C0[r]-=dl;C1[r]-=dl;} \
        if(!NA){ _Pragma("unroll") for(int r=0;r<16;++r)negm[r]=-mhat; asm volatile("":"+v"(negm)); } \
        const float f=__builtin_amdgcn_exp2f(-dl); l_reg*=f; if(hi==0)wsf[r32]=f; resc=true; if(NA){na_m0=false;} } } \
    unsigned na_a=0u; if(NA){ const int tn_=(t)+1,tw_=tn_-4,kr_=lo+tw_; const bool cx_=tn_<4; \
      const bool win_=!cx_&&tw_<nwin&&kr_>=na_rs&&kr_<na_rs+8;     \
      na_a=win_?na_base+(4u*NA_STRIP)*(unsigned)(kr_-na_rq+7):na_flat+(cx_?0u:272u); asm volatile("":"+v"(na_a)); } \
    SBAR(); \
    GAPB(o[0]=__builtin_amdgcn_mfma_f32_32x32x16_bf16(PAF(0),VFR(0),o[0],0,0,0), C0,0,NAF(P0,P1,0)); \
    GAPB(o[1]=__builtin_amdgcn_mfma_f32_32x32x16_bf16(PAF(0),VFR(4),o[1],0,0,0), C0,4,NAF(P0,P1,1)); \
    KRD(GL,0); GAPB(o[0]=__builtin_amdgcn_mfma_f32_32x32x16_bf16(PAF(1),VFR(1),o[0],0,0,0), C0,8,NAF(P0,P1,2)); \
    KRD(GL,1); GAPB(o[1]=__builtin_amdgcn_mfma_f32_32x32x16_bf16(PAF(1),VFR(5),o[1],0,0,0), C0,12,NAF(P0,P1,3)); \
    KRD(GL,2); GAPB(o[0]=__builtin_amdgcn_mfma_f32_32x32x16_bf16(PAF(2),VFR(2),o[0],0,0,0), C1,0,NAF(P0,P1,4)); \
    KRD(GL,3); GAPB(o[1]=__builtin_amdgcn_mfma_f32_32x32x16_bf16(PAF(2),VFR(6),o[1],0,0,0), C1,4,NAF(P0,P1,5)); \
    if(DK==96){KRD(GL,4);} GAPB(o[0]=__builtin_amdgcn_mfma_f32_32x32x16_bf16(PAF(3),VFR(3),o[0],0,0,0), C1,8,NAF(P0,P1,6)); \
    if(DK==96){KRD(GL,5);} GAPB(o[1]=__builtin_amdgcn_mfma_f32_32x32x16_bf16(PAF(3),VFR(7),o[1],0,0,0), C1,12,NAF(P0,P1,7)); \
    }while(0)
  int t=1;
  if constexpr(DK==64){
    for(;t+3<NT;t+=2){
      STEP(pB0,pB1,pA0,pA1,t,true,true,true,false);     WAIT_BARK(2,3); RESC(); ROT();
      STEP(pA0,pA1,pB0,pB1,t+1,true,true,true,false);   WAIT_BARK(2,3); RESC(); ROT();
    }
    STEP(pB0,pB1,pA0,pA1,t,false,true,true,false);      WAIT_BAR(1); RESC(); ROT();
    STEP(pA0,pA1,pB0,pB1,t+1,false,true,true,false);    WAIT_BAR(1); RESC(); ROT();
  } else {
    for(;t+5<NT;t+=2){
      STEP(pB0,pB1,pA0,pA1,t,true,true,true,false);     WAIT_BARK(2,3); RESC(); ROT();
      STEP(pA0,pA1,pB0,pB1,t+1,true,true,true,false);   WAIT_BARK(2,3); RESC(); ROT();
    }
    #define ENDW(tt) do{ if((tt)+3<NT){WAIT_BARK(2,3);} else {WAIT_BAR(1);} }while(0)
    for(;t+1<NT;t+=2){
      STEP(pB0,pB1,pA0,pA1,t,(t+3<NT),(t+1<NT),(t+1<NT),false);       ENDW(t);   RESC(); ROT();
      STEP(pA0,pA1,pB0,pB1,t+1,(t+4<NT),(t+2<NT),(t+2<NT),false);     ENDW(t+1); RESC(); ROT();
    }
    #undef ENDW
  }
  STEP(pB0,pB1,pA0,pA1,NT-1,false,false,false,nx.on);
  if(nx.on){ WAIT_BARK(4,7); } else { WAIT_BAR(0); }
  RESC();
  { float sacc=pB0[0]+pB0[1]; _Pragma("unroll") for(int r=2;r<16;++r)sacc+=pB0[r]; _Pragma("unroll") for(int r=0;r<16;++r)sacc+=pB1[r]; l_reg+=sacc;
    pw0=(u32x4){PKW(pB0,0),PKW(pB0,2),PKW(pB0,4),PKW(pB0,6)};pw1=(u32x4){PKW(pB0,8),PKW(pB0,10),PKW(pB0,12),PKW(pB0,14)};pw2=(u32x4){PKW(pB1,0),PKW(pB1,2),PKW(pB1,4),PKW(pB1,6)};pw3=(u32x4){PKW(pB1,8),PKW(pB1,10),PKW(pB1,12),PKW(pB1,14)};
    SBAR(); pv(o,vb0+sl_cur,PAF(0),PAF(1),PAF(2),PAF(3)); }
  if(PFQ&&nx.on){ const bf16*Qn=nx.Q+(long)(nx.qrow0+wid*QBLK)*QP;
    #pragma unroll
    for(int d0=0;d0<ND;++d0)qr[d0]=*reinterpret_cast<const bf16x8*>(&Qn[(long)r32*QP+d0*16+hi*8]); }
  #undef PKW
  #undef PAF
  #undef VFR
  #undef PIN
  #undef MX3
  #undef GAPA
  #undef GAPB
  #undef NAF
  #undef NAF_LD
  #undef NAF_FIN
  #undef NAC
  #undef LDSF
  #undef EX
  #undef VRD
  #undef KRD
  #undef STEP
  {auto rr=__builtin_amdgcn_permlane32_swap(__float_as_uint(l_reg),__float_as_uint(l_reg),false,false);l_reg=__uint_as_float(rr[0])+__uint_as_float(rr[1]);}
  if(hi==0)wsf[32+r32]=l_reg;asm volatile("s_waitcnt lgkmcnt(0)":::"memory");
  float rli[16];
  #pragma unroll
  for(int r=0;r<16;++r)rli[r]=__builtin_amdgcn_rcpf(wsf[32+crow(r,hi)]);
  bf16*Ow=Ow0+(long)(qrow0+wid*QBLK)*1024;
  { bf16*stg=(bf16*)(shm+L_OST)+wid*2048;
    #pragma unroll
    for(int r=0;r<16;++r){const int orow=crow(r,hi);
      #pragma unroll
      for(int d0=0;d0<2;++d0)stg[orow*64+d0*32+r32]=__float2bfloat16(o[d0][r]*rli[r]);}
    asm volatile("s_waitcnt lgkmcnt(0)":::"memory");
    #pragma unroll
    for(int i=0;i<4;++i){const int row=i*8+(lane>>3),ch=lane&7; const u32x4 v=*(const u32x4*)(stg+row*64+ch*8); ATTN_STORE16(Ow+(long)row*1024+ch*8,v);} }
  asm volatile("s_waitcnt lgkmcnt(0)\n\ts_barrier":::"memory");
  #undef DMA_K
  #undef DMA_KN
  #undef DMA_VN
  #undef KO
  #undef WAIT_BARK
  #undef TROW
  #undef DMA_V
  #undef CMASK
  #undef START
  #undef RESC
  #undef ROT
  return sl_next;
}
constexpr int ATTN_LDS_BYTES=LDS_BYTES;
#undef SBAR
#undef WAIT_BAR
}
#define XB_TMO      128
#define XB_XCNT(j)  (256  + 64 * (j))
#define XB_XSUB(j)  (1280 + 64 * (j))
#define XB_XGEN(j)  (2304 + 64 * (j))
#define XB_TOP      3328
#define XB_TOPGEN   3392
#define XCD_BAR_WORDS 3456
#define XB_SPIN_CAP (1u << 18)
__device__ __forceinline__ unsigned xb_ld(unsigned* p)              { return __hip_atomic_load(p, __ATOMIC_RELAXED, __HIP_MEMORY_SCOPE_AGENT); }
__device__ __forceinline__ unsigned xb_add(unsigned* p, unsigned v) { return __hip_atomic_fetch_add(p, v, __ATOMIC_RELAXED, __HIP_MEMORY_SCOPE_AGENT); }
__device__ __forceinline__ unsigned xb_xcc_id() { return (unsigned)__builtin_amdgcn_s_getreg((3 << 11) | 20) & 0xFu; }
#define XB_SPIN(cond, bar) do { unsigned _sp = 0; while (cond) { __builtin_amdgcn_s_sleep(1); \
    if ((++_sp & 255u) == 0u) { if (xb_ld(&(bar)[XB_TMO])) break; if (_sp > XB_SPIN_CAP) { atomicAdd(&(bar)[XB_TMO], 1u); break; } } } } while (0)
struct XcdBarrier { unsigned* bar; unsigned x; volatile LAS unsigned* st; };
__device__ __forceinline__ XcdBarrier xcd_barrier_post(unsigned* bar, volatile LAS unsigned* st) {
    XcdBarrier b; b.bar = bar; b.x = xb_xcc_id(); b.st = st;
    if (threadIdx.x == 0) (void)xb_add(&bar[XB_XCNT(b.x)], 1u);
    return b;
}
__device__ __forceinline__ void xcd_barrier_complete(unsigned* bar, unsigned x, unsigned& nloc, unsigned& nx) {
    const unsigned G = gridDim.x * gridDim.y * gridDim.z;
    unsigned sum, cnt, mine, sp = 0u;
    for (;;) {
        sum = 0u; cnt = 0u; mine = 0u;
#pragma unroll
        for (unsigned j = 0; j < 16; ++j) { const unsigned c = xb_ld(&bar[XB_XCNT(j)]); sum += c; cnt += (c > 0u) ? 1u : 0u; mine = (j == x) ? c : mine; }
        if (sum == G) break;
        __builtin_amdgcn_s_sleep(1);
        if ((++sp & 255u) == 0u) { if (xb_ld(&bar[XB_TMO])) break; if (sp > XB_SPIN_CAP) { atomicAdd(&bar[XB_TMO], 1u); break; } }
    }
    nloc = mine > 0u ? mine : 1u; nx = cnt > 0u ? cnt : 1u;
}
__device__ __forceinline__ void xcd_barrier(const XcdBarrier& b) {
    asm volatile("s_waitcnt vmcnt(0)" ::: "memory");
    __syncthreads();
    if (threadIdx.x == 0) {
        unsigned* bar = b.bar;
        __builtin_amdgcn_s_waitcnt(0);
        unsigned nloc = b.st[0], nx = b.st[1];
        if (nloc == 0u) { xcd_barrier_complete(bar, b.x, nloc, nx); b.st[0] = nloc; b.st[1] = nx; }
        const unsigned old = xb_add(&bar[XB_XSUB(b.x)], 1u);
        const unsigned gen = old / nloc;
        if (old + 1u == (gen + 1u) * nloc) {
            __builtin_amdgcn_fence(__ATOMIC_RELEASE, "agent");
            asm volatile("s_waitcnt vmcnt(0)" ::: "memory");
            const unsigned og = xb_add(&bar[XB_TOP], 1u);
            const unsigned tg = og / nx;
            if (og + 1u == (tg + 1u) * nx) xb_add(&bar[XB_TOPGEN], 1u);
            else XB_SPIN(xb_ld(&bar[XB_TOPGEN]) == tg, bar);
            __builtin_amdgcn_fence(__ATOMIC_ACQUIRE, "agent");
            asm volatile("s_waitcnt vmcnt(0)" ::: "memory");
        } else {
            XB_SPIN(xb_ld(&bar[XB_TOPGEN]) == gen, bar);
            __builtin_amdgcn_fence(__ATOMIC_ACQUIRE, "agent");
            asm volatile("s_waitcnt vmcnt(0)" ::: "memory");
        }
    }
    __syncthreads();
}

struct Args { const float* in[30]; float* out; unsigned char* ws; int ph_lo, ph_hi; };
enum { I_X = 0, I_C, I_CTX, I_CCTX, I_ADAW, I_ADAB, I_N1W, I_N2W, I_AWQKV, I_AQN, I_AKN, I_AWO, I_BWDQ, I_BQNL, I_BWUQ, I_BWDKV, I_BKVNL, I_BWUKV, I_BQN, I_BKN, I_BWO,
       I_CWQKV, I_CQN, I_CKN, I_CRPB, I_CWO, I_ROUTER, I_WG, I_WU, I_WD };
struct Frame {
    LAS unsigned char* lds; char* ldsg;
    int wave, vcu, G, gw, NGW;
    const float* const* in; float* out; unsigned char* ws;
};
__device__ __forceinline__ unsigned opq32(unsigned o) { asm volatile("" : "+v"(o)); return (unsigned)__builtin_amdgcn_readfirstlane((int)o); }
#define FWS(off, T) ((T*)(F.ws + (size_t)opq32((unsigned)(off))))
#define XB_ROW(r) ((r) < RL ? (bf16*)F.out + (size_t)(r) * 2048 + 1024 : FWS(WS_XC, bf16) + (size_t)((r) - RL) * 1024)
__device__ __forceinline__ f32x4 bf4_to_f32(u32x2 q) { return (f32x4){__builtin_bit_cast(float, q.x << 16), __builtin_bit_cast(float, q.x & 0xffff0000u), __builtin_bit_cast(float, q.y << 16), __builtin_bit_cast(float, q.y & 0xffff0000u)}; }
#define PHASE_IDS() int tid_ = threadIdx.x; asm volatile("" : "+v"(tid_)); const int tid = tid_, lane = tid & 63; (void)lane

struct WSrc { const float* W; int ld; int col0; int perm; const float* ks; };
struct PrepJob { WSrc s; int K, G, kb; bf16* Bt; };
__device__ __forceinline__ PrepJob prep_decode(const float* const* in, unsigned char* ws, int it) {
    constexpr int J0 = 768, J1 = J0 + 768, J2 = J1 + 512, J3 = J2 + 512, J4 = J3 + 384, J5 = J4 + 288, J6 = J5 + 256, J7 = J6 + 512, J8 = J7 + 1536, J9 = J8 + 512;
    constexpr int NSMALL = J9;
    bf16* WSB = (bf16*)(ws + WS_WS);
    PrepJob j; WSrc& s = j.s; s.ks = nullptr; s.perm = 1; j.K = 1024; int G, kb; bf16* Bt;
    if (it >= NSMALL) {
        int r = it - NSMALL; const int l = r / 24576; r -= l * 24576;
        if (r < 16384) { G = r >> 4; kb = r & 15; const int e = G >> 6, g = G & 63, pn = g >> 3, bj = (g >> 2) & 1, wc = g & 3;
            s.W = (bj ? in[I_WU] : in[I_WG]) + (size_t)(l * 16 + e) * 1048576; s.ld = 1024; s.col0 = 128 * pn + 32 * wc; Bt = (bf16*)(ws + WS_WMOE + (size_t)l * 96 * MiB); }
        else { r -= 16384; G = r >> 4; kb = r & 15; const int e = G >> 5, g = G & 31;
            s.W = in[I_WD] + (size_t)(l * 16 + e) * 1048576; s.ld = 1024; s.col0 = 32 * g; Bt = (bf16*)(ws + WS_WMOE + (size_t)l * 96 * MiB + 64 * MiB); }
    } else if (it < J1) { const int inst = it >= J0; const int r = it - inst * J0; G = r >> 4; kb = r & 15; const int pn = G >> 3, bj = (G >> 2) & 1, wc = G & 3;
        s.W = in[I_AWQKV] + (size_t)inst * 1024 * 1536; s.ld = 1536; s.col0 = 64 * (4 * pn + wc) + 32 * bj; Bt = WSB + (inst ? WO_AQKV1 : WO_AQKV0) / 2; }
    else if (it < J3) { const int inst = it >= J2; const int r = it - (inst ? J2 : J1); G = r >> 4; kb = r & 15;
        s.W = in[I_AWO] + (size_t)inst * 1048576; s.ld = 1024; s.col0 = 32 * G; Bt = WSB + (inst ? WO_AWO1 : WO_AWO0) / 2; }
    else if (it < J4) { const int r = it - J3; G = r >> 4; kb = r & 15; Bt = WSB + WO_BDN / 2;
        if (G < 12) { s.W = in[I_BWDQ]; s.ld = 384; s.col0 = 32 * G; }
        else if (G == 12) { s.W = in[I_BWDKV]; s.ld = 288; s.col0 = 256; s.perm = 0; }
        else if (G < 16) { s.W = nullptr; s.ld = 0; s.col0 = 0; }
        else { s.W = in[I_BWDKV]; s.ld = 288; s.col0 = 32 * (G - 16); } }
    else if (it < J5) { const int r = it - J4; G = r / 6; kb = r % 6; j.K = 384; Bt = WSB + WO_BUQ / 2; s.W = in[I_BWUQ]; s.ld = 1536; s.ks = in[I_BQNL];
        if (G < 32) { const int pn = G >> 3, bj = (G >> 2) & 1, wc = G & 3; s.col0 = 96 * (4 * pn + wc) + 32 * bj; }
        else { const int g = G - 32, pn = g >> 3, bj = (g >> 2) & 1, wc = g & 3; s.col0 = 96 * (8 * pn + 4 * bj + wc) + 64; s.perm = 0; } }
    else if (it < J6) { const int r = it - J5; G = r >> 2; kb = r & 3; j.K = 256; Bt = WSB + WO_BUKV / 2; s.W = in[I_BWUKV]; s.ld = 2048; s.ks = in[I_BKVNL];
        if (G < 32) { const int pn = G >> 3, bj = (G >> 2) & 1, wc = G & 3; s.col0 = 128 * (4 * pn + wc) + 32 * bj; }
        else { const int g = G - 32, pn = g >> 3, bj = (g >> 2) & 1, wc = g & 3; s.col0 = 128 * (4 * pn + wc) + 64 + 32 * bj; } }
    else if (it < J7) { const int r = it - J6; G = r >> 4; kb = r & 15; s.W = in[I_BWO]; s.ld = 1024; s.col0 = 32 * G; Bt = WSB + WO_BWO / 2; }
    else if (it < J8) { const int r = it - J7; G = r >> 4; kb = r & 15; const int pn = G >> 3, bj = (G >> 2) & 1, wc = G & 3;
        s.W = in[I_CWQKV]; s.ld = 3072; s.col0 = 64 * (4 * pn + wc) + 32 * bj; Bt = WSB + WO_CQKV / 2; }
    else { const int r = it - J8; G = r >> 4; kb = r & 15; s.W = in[I_CWO]; s.ld = 1024; s.col0 = 32 * G; Bt = WSB + WO_CWO / 2; }
    j.G = G; j.kb = kb; j.Bt = Bt; return j;
}
__device__ __forceinline__ void prep_load(const PrepJob& j, f32x4 (&v)[8], int lane) {
    const int k0 = 64 * j.kb;
#pragma unroll
    for (int i = 0; i < 8; ++i) { const int kk = 8 * i + (lane >> 3);
        if (j.s.W) { f32x4 x = *(const f32x4*)(j.s.W + (size_t)(k0 + kk) * j.s.ld + j.s.col0 + 4 * (lane & 7)); if (j.s.ks) x = x * j.s.ks[k0 + kk]; v[i] = x; }
        else v[i] = (f32x4){0.f, 0.f, 0.f, 0.f}; }
}
__device__ __forceinline__ void prep_store(const PrepJob& j, const f32x4 (&v)[8], LAS float* scr, int lane) {
    const int k0 = 64 * j.kb;
#pragma unroll
    for (int i = 0; i < 8; ++i) { const int kk = 8 * i + (lane >> 3); LAS float* d = scr + kk * 33 + 4 * (lane & 7); d[0] = v[i][0]; d[1] = v[i][1]; d[2] = v[i][2]; d[3] = v[i][3]; }
    LDS_WAIT(); asm volatile("" ::: "memory");
    const int c = lane & 7;
#pragma unroll
    for (int q = 0; q < 4; ++q) { const int n = (lane >> 3) + 8 * q; const int sn = j.s.perm ? pg8::perm32(n) : n; const LAS float* sp = scr + (8 * c) * 33 + sn;
        u32x4 o; o.x = cvt_pk_bf16(sp[0 * 33], sp[1 * 33]); o.y = cvt_pk_bf16(sp[2 * 33], sp[3 * 33]); o.z = cvt_pk_bf16(sp[4 * 33], sp[5 * 33]); o.w = cvt_pk_bf16(sp[6 * 33], sp[7 * 33]);
        *(u32x4*)(j.Bt + (size_t)(32 * j.G + n) * j.K + k0 + 8 * c) = o; }
    LDS_WAIT(); asm volatile("" ::: "memory");
}
__device__ __forceinline__ void p0_prologue(Frame& F) {
    PHASE_IDS();
    const float* const* in = F.in;
    {
        LAS float* sv = (LAS float*)F.lds;
        float* MODP = FWS(WS_MODP, float);
        for (int it = blockIdx.x; it < 4 * 12 * 8; it += F.G) {
            const int kc = it & 7, nb = (it >> 3) % 12, l = it / 96;
            for (int u = tid; u < 17 * 128; u += NTHR) { const int bi = u >> 7, k = kc * 128 + (u & 127); const float cv = bi < 16 ? in[I_C][bi * 1024 + k] : in[I_CCTX][k]; sv[u] = cv / (1.f + expf(-cv)); }
            __syncthreads();
            const int n = nb * 512 + tid; const float* W = in[I_ADAW] + ((size_t)l * 1024 + kc * 128) * 6144 + n;
            float acc[17];
#pragma unroll
            for (int bi = 0; bi < 17; ++bi) acc[bi] = 0.f;
            for (int k8 = 0; k8 < 128; k8 += 16) {
                float w[16];
#pragma unroll
                for (int k = 0; k < 16; ++k) w[k] = W[(size_t)(k8 + k) * 6144];
#pragma unroll
                for (int k = 0; k < 16; ++k)
#pragma unroll
                    for (int bi = 0; bi < 17; ++bi) acc[bi] += sv[bi * 128 + k8 + k] * w[k];
            }
#pragma unroll
            for (int bi = 0; bi < 17; ++bi) MODP[((size_t)(kc * 4 + l) * 17 + bi) * 6144 + n] = acc[bi];
            __syncthreads();
        }
    }
    {
        LAS float* scr = (LAS float*)(F.lds + F.wave * 8448);
        constexpr int NITEMS = 6048;
        for (int base = F.gw; base < NITEMS; base += 4 * F.NGW) {
            PrepJob j0 = prep_decode(in, F.ws, base), j1, j2, j3; const int i1 = base + F.NGW, i2 = base + 2 * F.NGW, i3 = base + 3 * F.NGW;
            const bool h1 = i1 < NITEMS, h2 = i2 < NITEMS, h3 = i3 < NITEMS;
            f32x4 v0[8], v1[8], v2[8], v3[8];
            prep_load(j0, v0, lane);
            if (h1) { j1 = prep_decode(in, F.ws, i1); prep_load(j1, v1, lane); }
            if (h2) { j2 = prep_decode(in, F.ws, i2); prep_load(j2, v2, lane); }
            if (h3) { j3 = prep_decode(in, F.ws, i3); prep_load(j3, v3, lane); }
            prep_store(j0, v0, scr, lane);
            if (h1) prep_store(j1, v1, scr, lane);
            if (h2) prep_store(j2, v2, scr, lane);
            if (h3) prep_store(j3, v3, scr, lane);
        }
    }
    {
        float* RA = FWS(WS_ROPE, float); float* RB = RA + 2 * 2048 * 32;
        const int gt = F.gw * 64 + lane, NT_ = F.NGW * 64;
        for (int i = gt; i < 2048 * 32; i += NT_) { const int t = i >> 5, d = i & 31; const float inv = powf(10000.f, -(float)(d & 15) / 16.f); const float pos = (float)(d < 16 ? (t >> 6) : (t & 63));
            const float a = pos * inv; RA[i] = cosf(a); RA[2048 * 32 + i] = sinf(a); }
        for (int i = gt; i < 2048 * 16; i += NT_) { const int t = i >> 4, d = i & 15; const float inv = powf(10000.f, -(float)(d & 7) / 8.f); const float pos = (float)(d < 8 ? (t >> 6) : (t & 63));
            const float a = pos * inv; RB[i] = cosf(a); RB[2048 * 16 + i] = sinf(a); }
    }
}
__device__ __forceinline__ void p1_modreduce(Frame& F) {
    PHASE_IDS();
    const float* MODP = FWS(WS_MODP, float); float* MOD = FWS(WS_MOD, float);
    const int gt = F.gw * 64 + lane, NT_ = F.NGW * 64;
    for (int i = gt; i < 4 * 17 * 6144; i += NT_) {
        const int l = i / (17 * 6144), rem = i - l * 17 * 6144, bi = rem / 6144, n = rem - bi * 6144;
        float v = F.in[I_ADAB][l * 6144 + n];
#pragma unroll
        for (int kc = 0; kc < 8; ++kc) v += MODP[((size_t)(kc * 4 + l) * 17 + bi) * 6144 + n];
        const int ch = n >> 10, nn = n & 1023;
        if (ch == 1) v = F.in[I_N1W][l * 1024 + nn] * (1.f + v);
        if (ch == 4) v = F.in[I_N2W][l * 1024 + nn] * (1.f + v);
        MOD[i] = v;
    }
}

__device__ __forceinline__ int slot_of(int row, int e, int s) { return e * SLOTS_E + (row < RL ? (row >> 11) * 256 + s : 4096 + ((row - RL) >> 8) * 32 + s); }
__device__ __forceinline__ void gather_y2(const bf16* Y, int r0, int r1, int inv0, int inv1, bool ok1, int lane, f32x4 (&a0)[4], f32x4 (&a1)[4]) {
    unsigned m0 = (unsigned)__ballot(lane < 16 && inv0 >= 0) & 0xffffu, m1 = ok1 ? ((unsigned)__ballot(lane < 16 && inv1 >= 0) & 0xffffu) : 0u;
    while (m0 | m1) {
        const bool h0 = m0 != 0u, h1 = m1 != 0u;
        const int e0 = h0 ? __builtin_ctz(m0) : 0, e1 = h1 ? __builtin_ctz(m1) : 0;
        m0 &= m0 - 1u; m1 &= m1 - 1u;
        const int s0 = __builtin_amdgcn_readlane(inv0, e0), s1 = __builtin_amdgcn_readlane(inv1, e1);
        const int sl0 = h0 ? slot_of(r0, e0, s0) : 0, sl1 = h1 ? slot_of(r1, e1, s1) : 0;
        const float w0 = h0 ? 1.f : 0.f, w1 = h1 ? 1.f : 0.f;
        const bf16* y0 = Y + (size_t)sl0 * 1024 + 4 * lane; const bf16* y1 = Y + (size_t)sl1 * 1024 + 4 * lane;
        u32x2 q0[4], q1[4];
#pragma unroll
        for (int j = 0; j < 4; ++j) { q0[j] = *(const u32x2*)(y0 + 256 * j); q1[j] = *(const u32x2*)(y1 + 256 * j); }
#pragma unroll
        for (int j = 0; j < 4; ++j) {
            a0[j][0] += w0 * bf2f(q0[j].x & 0xffffu); a0[j][1] += w0 * bf2f(q0[j].x >> 16); a0[j][2] += w0 * bf2f(q0[j].y & 0xffffu); a0[j][3] += w0 * bf2f(q0[j].y >> 16);
            a1[j][0] += w1 * bf2f(q1[j].x & 0xffffu); a1[j][1] += w1 * bf2f(q1[j].x >> 16); a1[j][2] += w1 * bf2f(q1[j].y & 0xffffu); a1[j][3] += w1 * bf2f(q1[j].y >> 16);
        }
    }
}
template <int L> __device__ __forceinline__ void norm1_phase(Frame& F) {
    PHASE_IDS();
    const float* MOD = FWS(WS_MOD, float); bf16* H = FWS(WS_H, bf16); const int* INV = FWS(WS_INV, int); const bf16* Y = FWS(WS_ACT + AO_Y, bf16); float* XC = FWS(WS_XC, float);
    const bf16* WOUT = FWS(WS_WOUT, bf16);
    for (int rb = F.gw; rb < RT; rb += 2 * F.NGW) {
        const int r0 = rb, r1c = rb + F.NGW; const bool ok1 = r1c < RT; const int r1 = ok1 ? r1c : rb;
        const int bi0 = r0 < RL ? (r0 >> 11) : 16, bi1 = r1 < RL ? (r1 >> 11) : 16;
        f32x4 v0[4], v1[4];
        if (L <= 1) {
            const float* xs0 = r0 < RL ? F.in[I_X] + (size_t)r0 * D : F.in[I_CTX] + (size_t)(r0 - RL) * D;
            const float* xs1 = r1 < RL ? F.in[I_X] + (size_t)r1 * D : F.in[I_CTX] + (size_t)(r1 - RL) * D;
#pragma unroll
            for (int j = 0; j < 4; ++j) { v0[j] = *(const f32x4*)(xs0 + 4 * lane + 256 * j); v1[j] = *(const f32x4*)(xs1 + 4 * lane + 256 * j); }
        } else {
            const bf16* xs0 = XB_ROW(r0); const bf16* xs1 = XB_ROW(r1);
            u32x2 q0[4], q1[4];
#pragma unroll
            for (int j = 0; j < 4; ++j) { q0[j] = *(const u32x2*)(xs0 + 4 * lane + 256 * j); q1[j] = *(const u32x2*)(xs1 + 4 * lane + 256 * j); }
#pragma unroll
            for (int j = 0; j < 4; ++j) { v0[j] = bf4_to_f32(q0[j]); v1[j] = bf4_to_f32(q1[j]); }
        }
        if (L > 0) {
            const int inv0 = INV[(size_t)r0 * 16 + (lane & 15)], inv1 = INV[(size_t)r1 * 16 + (lane & 15)];
            f32x4 a0[4], a1[4];
#pragma unroll
            for (int j = 0; j < 4; ++j) { a0[j] = (f32x4){0.f, 0.f, 0.f, 0.f}; a1[j] = (f32x4){0.f, 0.f, 0.f, 0.f}; }
            u32x2 wq0[4], wq1[4];
#pragma unroll
            for (int j = 0; j < 4; ++j) { wq0[j] = *(const u32x2*)(WOUT + (size_t)r0 * D + 4 * lane + 256 * j); wq1[j] = *(const u32x2*)(WOUT + (size_t)r1 * D + 4 * lane + 256 * j); }
            gather_y2(Y, r0, r1, inv0, inv1, ok1, lane, a0, a1);
            const float* m50 = MOD + ((size_t)(L - 1) * 17 + bi0) * 6144 + 5 * 1024 + 4 * lane; const float* m51 = MOD + ((size_t)(L - 1) * 17 + bi1) * 6144 + 5 * 1024 + 4 * lane;
            bf16* xd0 = XB_ROW(r0); bf16* xd1 = XB_ROW(r1);
#pragma unroll
            for (int j = 0; j < 4; ++j) { const f32x4 w = (f32x4){bf2f(wq0[j].x & 0xffffu), bf2f(wq0[j].x >> 16), bf2f(wq0[j].y & 0xffffu), bf2f(wq0[j].y >> 16)};
                v0[j] += w + *(const f32x4*)(m50 + 256 * j) * a0[j]; u32x2 xw; xw.x = cvt_pk_bf16(v0[j][0], v0[j][1]); xw.y = cvt_pk_bf16(v0[j][2], v0[j][3]); *(u32x2*)(xd0 + 4 * lane + 256 * j) = xw; }
            if (ok1) {
#pragma unroll
                for (int j = 0; j < 4; ++j) { const f32x4 w = (f32x4){bf2f(wq1[j].x & 0xffffu), bf2f(wq1[j].x >> 16), bf2f(wq1[j].y & 0xffffu), bf2f(wq1[j].y >> 16)};
                    v1[j] += w + *(const f32x4*)(m51 + 256 * j) * a1[j]; u32x2 xw; xw.x = cvt_pk_bf16(v1[j][0], v1[j][1]); xw.y = cvt_pk_bf16(v1[j][2], v1[j][3]); *(u32x2*)(xd1 + 4 * lane + 256 * j) = xw; } }
        }
        const float ss0 = (sum4sq(v0[0]) + sum4sq(v0[1])) + (sum4sq(v0[2]) + sum4sq(v0[3])), ss1 = (sum4sq(v1[0]) + sum4sq(v1[1])) + (sum4sq(v1[2]) + sum4sq(v1[3]));
        const float rinv0 = rsqrtf(wave_sum(ss0) * (1.f / D) + EPS), rinv1 = rsqrtf(wave_sum(ss1) * (1.f / D) + EPS);
        const float* ml0 = MOD + ((size_t)L * 17 + bi0) * 6144 + 4 * lane; const float* ml1 = MOD + ((size_t)L * 17 + bi1) * 6144 + 4 * lane;
        bf16* hp0 = H + (size_t)r0 * D + 4 * lane; bf16* hp1 = H + (size_t)r1 * D + 4 * lane;
#pragma unroll
        for (int j = 0; j < 4; ++j) { const f32x4 sh = *(const f32x4*)(ml0 + 256 * j), a1_ = *(const f32x4*)(ml0 + 1024 + 256 * j); const f32x4 h = v0[j] * rinv0 * a1_ + sh;
            u32x2 w; w.x = cvt_pk_bf16(h[0], h[1]); w.y = cvt_pk_bf16(h[2], h[3]); *(u32x2*)(hp0 + 256 * j) = w; }
        if (ok1) {
#pragma unroll
            for (int j = 0; j < 4; ++j) { const f32x4 sh = *(const f32x4*)(ml1 + 256 * j), a1_ = *(const f32x4*)(ml1 + 1024 + 256 * j); const f32x4 h = v1[j] * rinv1 * a1_ + sh;
                u32x2 w; w.x = cvt_pk_bf16(h[0], h[1]); w.y = cvt_pk_bf16(h[2], h[3]); *(u32x2*)(hp1 + 256 * j) = w; } }
    }
}
__device__ __forceinline__ void final_phase(Frame& F) {
    PHASE_IDS();
    const float* MOD = FWS(WS_MOD, float); const int* INV = FWS(WS_INV, int); const bf16* Y = FWS(WS_ACT + AO_Y, bf16);
    for (int rb = F.gw; rb < RL; rb += 2 * F.NGW) {
        const int r0 = rb, r1c = rb + F.NGW; const bool ok1 = r1c < RL; const int r1 = ok1 ? r1c : rb;
        float* xs0 = F.out + (size_t)r0 * D; float* xs1 = F.out + (size_t)r1 * D;
        f32x4 v0[4], v1[4];
        { const bf16* xb0 = XB_ROW(r0); const bf16* xb1 = XB_ROW(r1); u32x2 q0[4], q1[4];
#pragma unroll
          for (int j = 0; j < 4; ++j) { q0[j] = *(const u32x2*)(xb0 + 4 * lane + 256 * j); q1[j] = *(const u32x2*)(xb1 + 4 * lane + 256 * j); }
#pragma unroll
          for (int j = 0; j < 4; ++j) { v0[j] = bf4_to_f32(q0[j]); v1[j] = bf4_to_f32(q1[j]); } }
        const int inv0 = INV[(size_t)r0 * 16 + (lane & 15)], inv1 = INV[(size_t)r1 * 16 + (lane & 15)];
        f32x4 a0[4], a1[4];
#pragma unroll
        for (int j = 0; j < 4; ++j) { a0[j] = (f32x4){0.f, 0.f, 0.f, 0.f}; a1[j] = (f32x4){0.f, 0.f, 0.f, 0.f}; }
        const bf16* WOUT = FWS(WS_WOUT, bf16);
        u32x2 wq0[4], wq1[4];
#pragma unroll
        for (int j = 0; j < 4; ++j) { wq0[j] = *(const u32x2*)(WOUT + (size_t)r0 * D + 4 * lane + 256 * j); wq1[j] = *(const u32x2*)(WOUT + (size_t)r1 * D + 4 * lane + 256 * j); }
        gather_y2(Y, r0, r1, inv0, inv1, ok1, lane, a0, a1);
        const float* m50 = MOD + ((size_t)3 * 17 + (r0 >> 11)) * 6144 + 5 * 1024 + 4 * lane; const float* m51 = MOD + ((size_t)3 * 17 + (r1 >> 11)) * 6144 + 5 * 1024 + 4 * lane;
        asm volatile("s_waitcnt vmcnt(0)" ::: "memory");
#pragma unroll
        for (int j = 0; j < 4; ++j) { const f32x4 w = (f32x4){bf2f(wq0[j].x & 0xffffu), bf2f(wq0[j].x >> 16), bf2f(wq0[j].y & 0xffffu), bf2f(wq0[j].y >> 16)};
            *(f32x4*)(xs0 + 4 * lane + 256 * j) = v0[j] + w + *(const f32x4*)(m50 + 256 * j) * a0[j]; }
        if (ok1) {
#pragma unroll
            for (int j = 0; j < 4; ++j) { const f32x4 w = (f32x4){bf2f(wq1[j].x & 0xffffu), bf2f(wq1[j].x >> 16), bf2f(wq1[j].y & 0xffffu), bf2f(wq1[j].y >> 16)};
                *(f32x4*)(xs1 + 4 * lane + 256 * j) = v1[j] + w + *(const f32x4*)(m51 + 256 * j) * a1[j]; } }
    }
}
__device__ __forceinline__ float red16(const float (&lg)[16], int lane) {
    const bool b5 = lane & 32, b4 = lane & 16, b3 = lane & 8, b2 = lane & 4;
    float t8[8], t4[4], t2[2];
#pragma unroll
    for (int j = 0; j < 8; ++j) { const float snd = b5 ? lg[j] : lg[j + 8], kp = b5 ? lg[j + 8] : lg[j]; t8[j] = kp + __shfl_xor(snd, 32); }
#pragma unroll
    for (int j = 0; j < 4; ++j) { const float snd = b4 ? t8[j] : t8[j + 4], kp = b4 ? t8[j + 4] : t8[j]; t4[j] = kp + __shfl_xor(snd, 16); }
#pragma unroll
    for (int j = 0; j < 2; ++j) { const float snd = b3 ? t4[j] : t4[j + 2], kp = b3 ? t4[j + 2] : t4[j]; t2[j] = kp + __shfl_xor(snd, 8); }
    float t1; { const float snd = b2 ? t2[0] : t2[1], kp = b2 ? t2[1] : t2[0]; t1 = kp + __shfl_xor(snd, 4); }
    t1 += __shfl_xor(t1, 2); t1 += __shfl_xor(t1, 1);
    return t1;
}
template <int L> __device__ __forceinline__ void norm2_phase(Frame& F, int NR, int R0 = 0, int w0_ = -1, int nw_ = 0) {
    const int N2W0 = R0 + (w0_ < 0 ? F.gw : w0_), N2NW = w0_ < 0 ? F.NGW : nw_;
    PHASE_IDS();
    const float* MOD = FWS(WS_MOD, float); bf16* H = FWS(WS_H, bf16); float* AFF = FWS(WS_AFF, float); const float* XC = FWS(WS_XC, float); const bf16* WOUT = FWS(WS_WOUT, bf16);
    LAS float* RL_ = (LAS float*)F.lds;
    const float* rt = F.in[I_ROUTER] + (size_t)L * 1024 * 16;
    unsigned xa[16], xb[16]; unsigned wa[16], wb[16];
#define N2_LOAD(rbase) do { const int q0_ = (rbase), q1c_ = (rbase) + N2NW; const int q1_ = q1c_ < NR ? q1c_ : q0_; \
        const bf16* w0_ = WOUT + (size_t)q0_ * D + lane; const bf16* w1_ = WOUT + (size_t)q1_ * D + lane; \
        if (L == 0) { \
            const float* s0_ = (q0_ < RL ? F.in[I_X] + (size_t)q0_ * D : F.in[I_CTX] + (size_t)(q0_ - RL) * D) + lane; \
            const float* s1_ = (q1_ < RL ? F.in[I_X] + (size_t)q1_ * D : F.in[I_CTX] + (size_t)(q1_ - RL) * D) + lane; \
            _Pragma("unroll") for (int i = 0; i < 16; ++i) { xa[i] = __float_as_uint(s0_[64 * i]); wa[i] = (unsigned)((const unsigned short*)w0_)[64 * i]; xb[i] = __float_as_uint(s1_[64 * i]); wb[i] = (unsigned)((const unsigned short*)w1_)[64 * i]; } \
        } else { \
            const unsigned short* s0_ = (const unsigned short*)XB_ROW(q0_) + lane; const unsigned short* s1_ = (const unsigned short*)XB_ROW(q1_) + lane; \
            _Pragma("unroll") for (int i = 0; i < 16; ++i) { xa[i] = (unsigned)s0_[64 * i]; wa[i] = (unsigned)((const unsigned short*)w0_)[64 * i]; xb[i] = (unsigned)s1_[64 * i]; wb[i] = (unsigned)((const unsigned short*)w1_)[64 * i]; } \
        } } while (0)
    if (N2W0 < NR) N2_LOAD(N2W0);
    for (int u = tid; u < 4096; u += NTHR) { const f32x4 w = *(const f32x4*)(rt + 4 * u); *(LAS f32x4*)(RL_ + (u >> 2) * 20 + (u & 3) * 4) = w; }
    __syncthreads();
    for (int rb = N2W0; rb < NR; rb += 2 * N2NW) {
        const int r0 = rb, r1c = rb + N2NW; const bool ok1 = r1c < NR; const int r1 = ok1 ? r1c : rb;
        const int bi0 = r0 < RL ? (r0 >> 11) : 16, bi1 = r1 < RL ? (r1 >> 11) : 16;
        const float* ml0 = MOD + ((size_t)L * 17 + bi0) * 6144 + 3 * 1024 + lane; const float* ml1 = MOD + ((size_t)L * 17 + bi1) * 6144 + 3 * 1024 + lane;
        float x0[16], x1[16];
        bf16* hp0 = H + (size_t)r0 * D + lane; bf16* hp1 = H + (size_t)r1 * D + lane;
#pragma unroll
        for (int i = 0; i < 16; ++i) { x0[i] = __uint_as_float(L == 0 ? xa[i] : xa[i] << 16) + __uint_as_float(wa[i] << 16); x1[i] = __uint_as_float(L == 0 ? xb[i] : xb[i] << 16) + __uint_as_float(wb[i] << 16); }
        __builtin_amdgcn_sched_barrier(0);
        {
            float sa[16], sh[16], ss = 0.f;
#pragma unroll
            for (int i = 0; i < 16; ++i) { sa[i] = ml0[1024 + 64 * i]; sh[i] = ml0[64 * i]; }
#pragma unroll
            for (int i = 0; i < 16; ++i) ss += x0[i] * x0[i];
            const float rinv = rsqrtf(wave_sum(ss) * (1.f / D) + EPS);
#pragma unroll
            for (int i = 0; i < 16; ++i) { x0[i] = x0[i] * rinv * sa[i] + sh[i]; hp0[64 * i] = (bf16)f2bf(x0[i]); }
        }
        __builtin_amdgcn_sched_barrier(0);
        {
            float sa[16], sh[16], ss = 0.f;
#pragma unroll
            for (int i = 0; i < 16; ++i) { sa[i] = ml1[1024 + 64 * i]; sh[i] = ml1[64 * i]; }
#pragma unroll
            for (int i = 0; i < 16; ++i) ss += x1[i] * x1[i];
            const float rinv = rsqrtf(wave_sum(ss) * (1.f / D) + EPS);
#pragma unroll
            for (int i = 0; i < 16; ++i) { x1[i] = x1[i] * rinv * sa[i] + sh[i]; if (ok1) hp1[64 * i] = (bf16)f2bf(x1[i]); }
        }
        __builtin_amdgcn_sched_barrier(0);
        if (rb + 2 * N2NW < NR) N2_LOAD(rb + 2 * N2NW);
        __builtin_amdgcn_sched_barrier(0);
        float lga[16], lgb[16];
#pragma unroll
        for (int e = 0; e < 16; ++e) { lga[e] = 0.f; lgb[e] = 0.f; }
#pragma unroll
        for (int i = 0; i < 16; ++i) {
            const LAS float* rr = RL_ + (lane + 64 * i) * 20; const float xa = x0[i], xb = x1[i];
#pragma unroll
            for (int q = 0; q < 4; ++q) { const f32x4 w = *(const LAS f32x4*)(rr + 4 * q);
#pragma unroll
                for (int c = 0; c < 4; ++c) { lga[4 * q + c] += xa * w[c]; lgb[4 * q + c] += xb * w[c]; } }
            asm volatile("" : "+v"(lga[0]), "+v"(lga[1]), "+v"(lga[2]), "+v"(lga[3]), "+v"(lga[4]), "+v"(lga[5]), "+v"(lga[6]), "+v"(lga[7]), "+v"(lga[8]), "+v"(lga[9]), "+v"(lga[10]), "+v"(lga[11]), "+v"(lga[12]), "+v"(lga[13]), "+v"(lga[14]), "+v"(lga[15]) :: "memory");
            asm volatile("" : "+v"(lgb[0]), "+v"(lgb[1]), "+v"(lgb[2]), "+v"(lgb[3]), "+v"(lgb[4]), "+v"(lgb[5]), "+v"(lgb[6]), "+v"(lgb[7]), "+v"(lgb[8]), "+v"(lgb[9]), "+v"(lgb[10]), "+v"(lgb[11]), "+v"(lgb[12]), "+v"(lgb[13]), "+v"(lgb[14]), "+v"(lgb[15]) :: "memory");
        }
#pragma unroll
        for (int rr_ = 0; rr_ < 2; ++rr_) {
            const float t = rr_ ? red16(lgb, lane) : red16(lga, lane);
            float mx = t;
#pragma unroll
            for (int o = 4; o < 64; o <<= 1) mx = fmaxf(mx, __shfl_xor(mx, o));
            const float p = expf(t - mx);
            float sm = p;
#pragma unroll
            for (int o = 4; o < 64; o <<= 1) sm += __shfl_xor(sm, o);
            if ((lane & 3) == 0 && (rr_ == 0 || ok1)) AFF[(size_t)(rr_ ? r1 : r0) * 16 + (lane >> 2)] = p / sm;
        }
    }
}
#undef N2_LOAD
__device__ __forceinline__ void topk_phase(Frame& F, bool with_ctx) {
    PHASE_IDS();
    const float* AFF = FWS(WS_AFF, float); int* INV = FWS(WS_INV, int); int* GIDX = FWS(WS_GIDX, int); float* GATE = FWS(WS_GATE, float);
    volatile LAS int* sm = (volatile LAS int*)F.lds;
    for (int q = blockIdx.x; q < 256; q += F.G) {
        const int b = q >> 4, e = q & 15;
        unsigned key[5];
#pragma unroll
        for (int j = 0; j < 4; ++j) key[j] = __float_as_uint(AFF[(size_t)(b * 2048 + 4 * tid + j) * 16 + e]);
        key[4] = (with_ctx && tid < 256) ? __float_as_uint(AFF[(size_t)(RL + b * 256 + tid) * 16 + e]) : 0u;
        unsigned prefix0 = 0u, prefix1 = 0u;
        for (int bit = 29; bit >= 0; --bit) {
            const unsigned cand0 = prefix0 | (1u << bit), cand1 = prefix1 | (1u << bit);
            int c0 = 0;
#pragma unroll
            for (int j = 0; j < 4; ++j) c0 += __builtin_popcountll(__ballot(key[j] >= cand0));
            const int c1 = __builtin_popcountll(__ballot(key[4] >= cand1));
            if (lane == 0) { sm[(bit & 1) * 16 + F.wave] = c0; sm[(bit & 1) * 16 + 8 + F.wave] = c1; }
            __syncthreads();
            int tot0 = 0, tot1 = 0;
#pragma unroll
            for (int w = 0; w < 8; ++w) { tot0 += sm[(bit & 1) * 16 + w]; tot1 += sm[(bit & 1) * 16 + 8 + w]; }
            if (tot0 >= 256) prefix0 = cand0;
            if (tot1 >= 32) prefix1 = cand1;
        }
#pragma unroll 1
        for (int part = 0; part < (with_ctx ? 2 : 1); ++part) {
            const bool lat = part == 0; const unsigned prefix = lat ? prefix0 : prefix1;
            const int cap = lat ? 256 : 32, rowbase = lat ? b * 2048 : RL + b * 256, slotbase = e * SLOTS_E + (lat ? b * 256 : 4096 + b * 32);
            int cg = 0, cq = 0;
#pragma unroll
            for (int j = 0; j < 4; ++j) { const unsigned k = lat ? key[j] : (j == 0 ? key[4] : 0u); const bool ok = lat || (j == 0 && tid < 256); cg += ok && k > prefix; cq += ok && k == prefix; }
            const int v = cg | (cq << 16);
            int x = v;
#pragma unroll
            for (int o = 1; o < 64; o <<= 1) { const int y = __shfl_up(x, o); if (lane >= o) x += y; }
            if (lane == 63) sm[64 + part * 8 + F.wave] = x;
            __syncthreads();
            int wp = 0, total = 0;
#pragma unroll
            for (int w = 0; w < 8; ++w) { const int tv = sm[64 + part * 8 + w]; total += tv; if (w < F.wave) wp += tv; }
            const int excl = x - v + wp, n_gt = total & 0xffff, need_eq = cap - n_gt;
            int eg = excl & 0xffff, eq = excl >> 16;
#pragma unroll
            for (int j = 0; j < 4; ++j) {
                const int t = lat ? 4 * tid + j : tid; const bool ok = lat || (j == 0 && tid < 256); const unsigned k = lat ? key[j] : key[4];
                if (ok) { int pos = -1;
                    if (k > prefix) pos = eg++;
                    else if (k == prefix) { if (eq < need_eq) pos = n_gt + eq; ++eq; }
                    INV[(size_t)(rowbase + t) * 16 + e] = pos;
                    if (pos >= 0) { GIDX[slotbase + pos] = rowbase + t; GATE[slotbase + pos] = __uint_as_float(k); } }
            }
        }
        __syncthreads();
    }
}

__device__ __forceinline__ void attn_map(int vcu, int i, int& bh, int& qb) { bh = (vcu & ~31) + 4 * i + ((vcu & 31) >> 3); qb = vcu & 7; }
constexpr int CONV_TAIL = 5, TAILW2 = 128 * 8, TAILN2 = CONV_TAIL * TAILW2;
__device__ __forceinline__ void conv_chunk(Frame& F, int first_item, int count, int wv = -1, int nwv = 0) {
    int tid_ = threadIdx.x; asm volatile("" : "+v"(tid_)); const int lane = tid_ & 63;
    LAS float* scr = (LAS float*)(F.lds + F.wave * 8448);
    const int first = 6048 + first_item;
    const int w0 = wv < 0 ? F.gw : wv, nw = wv < 0 ? F.NGW : nwv;
#pragma unroll 1
    for (int base = w0; base < count; base += 2 * nw) {
        const int i1 = base + nw; const bool h1 = i1 < count;
        PrepJob j0 = prep_decode(F.in, F.ws, first + base), j1 = prep_decode(F.in, F.ws, first + (h1 ? i1 : base));
        f32x4 v0[8], v1[8];
        prep_load(j0, v0, lane); prep_load(j1, v1, lane);
        prep_store(j0, v0, scr, lane);
        if (h1) prep_store(j1, v1, scr, lane);
    }
    asm volatile("s_waitcnt vmcnt(0) lgkmcnt(0)" ::: "memory");
    __syncthreads();
}
__device__ __forceinline__ void attn_mla_phase(Frame& F, bool need_ctx, int L) {
    typedef attn_body::bf16 abf;
    const bf16* Q = FWS(WS_ACT + AO_Q, bf16); const bf16* K = FWS(WS_ACT + AO_K, bf16); const bf16* V = FWS(WS_ACT + AO_V, bf16); bf16* O = FWS(WS_ACT + AO_O, bf16);
    if (F.G != 256) return;
    attn_body::bf16x8 qr[6]; int s0 = 0; bool pre = false; const int n = need_ctx ? 9 : 8;
    for (int i = 0; i < n; ++i) {
        int bh, qb; attn_map(F.vcu, i & 7, bh, qb); const bool lat = i < 8; if (!lat) bh = F.vcu;
        const int b = bh >> 4, h = bh & 15;
        int bhn, qbn; attn_map(F.vcu, (i + 1) & 7, bhn, qbn); const bool latn = i + 1 < 8; if (!latn) bhn = F.vcu;
        const int bn = bhn >> 4, hn = bhn & 15;
        const attn_body::NextU nx{i + 1 < n, (const abf*)(Q + hn * 96), (const abf*)(K + hn * 96), (const abf*)(V + hn * 64), latn ? bn * 2048 + 256 * qbn : RL + bn * 256, RL + bn * 256};
        s0 = attn_body::attn_unit<8, false, 96, false>((const abf*)(Q + h * 96), 1536, (const abf*)(K + h * 96), (const abf*)(V + h * 64), 1536, 1024, (abf*)(O + h * 64),
                                                lat ? b * 2048 + 256 * qb : RL + b * 256, RL + b * 256, 4, b * 2048, lat ? 36 : 4, F.ldsg, qr, pre, s0, nx);
        pre = nx.on;
    }
}
__device__ __forceinline__ void attn_dense64_phase(Frame& F, bool need_ctx, int L) {
    typedef attn_body::bf16 abf;
    const bf16* Q = FWS(WS_ACT + AO_Q, bf16); const bf16* K = FWS(WS_ACT + AO_K, bf16); const bf16* V = FWS(WS_ACT + AO_V, bf16); bf16* O = FWS(WS_ACT + AO_O, bf16);
    if (F.G != 256) return;
    attn_body::bf16x8 qr[6]; int s0 = 0; bool pre = false; const int n = need_ctx ? 9 : 8, cv = F.vcu & 7;
    for (int i = 0; i < n; ++i) {
        if (i == cv) {
            if (L == 0) { conv_chunk(F, 0, 24576); conv_chunk(F, 24576 + TAILN2, 24576 - TAILN2); conv_chunk(F, 2 * 24576 + TAILN2, 24576 - TAILN2); }
            else conv_chunk(F, 3 * 24576 + TAILN2, 24576 - TAILN2);
            _Pragma("unroll") for (int d = 0; d < 4; ++d) qr[d] = attn_body::bf16x8{}; }
        int bh, qb; attn_map(F.vcu, i & 7, bh, qb); const bool lat = i < 8; if (!lat) bh = F.vcu;
        const int b = bh >> 4, h = bh & 15, kh = h >> 2;
        int bhn, qbn; attn_map(F.vcu, (i + 1) & 7, bhn, qbn); const bool latn = i + 1 < 8; if (!latn) bhn = F.vcu;
        const int bn = bhn >> 4, hn = bhn & 15, khn = hn >> 2;
        const attn_body::NextU nx{i + 1 < n && i + 1 != cv, (const abf*)(Q + hn * 64), (const abf*)(K + khn * 64), (const abf*)(V + khn * 64), latn ? bn * 2048 + 256 * qbn : RL + bn * 256, RL + bn * 256};
        s0 = attn_body::attn_unit<8>((const abf*)(Q + h * 64), 1024, (const abf*)(K + kh * 64), (const abf*)(V + kh * 64), 256, 256, (abf*)(O + h * 64),
                                     lat ? b * 2048 + 256 * qb : RL + b * 256, RL + b * 256, 4, b * 2048, lat ? 36 : 4, F.ldsg, qr, pre, s0, nx);
        pre = nx.on;
    }
}
__device__ __forceinline__ void attn_na_phase(Frame& F, bool need_ctx, int L) {
    typedef attn_body::bf16 abf;
    const bf16* Q = FWS(WS_ACT + AO_Q, bf16); const bf16* K = FWS(WS_ACT + AO_K, bf16); const bf16* V = FWS(WS_ACT + AO_V, bf16); bf16* O = FWS(WS_ACT + AO_O, bf16);
    if (F.G != 256) return;
    const int s_ = (F.vcu & 31) >> 3, g = F.vcu & 7, h = 2 * (F.vcu >> 5) + (s_ & 1);
    {
        int tid_ = threadIdx.x; asm volatile("" : "+v"(tid_));
        LAS float* T = (LAS float*)(F.lds + 86016);
        const float* rp = F.in[I_CRPB] + h * 15 * 31;
        for (int e = tid_; e < 15 * (int)attn_body::NA_STRIP; e += NTHR) {
            const int dr = e / (int)attn_body::NA_STRIP, o = e - dr * (int)attn_body::NA_STRIP;
            int dc = 0; bool real = false;
            if (o < 112) { dc = o - 56; real = dc >= -8 && dc <= 7; }
            else { const int o2 = o - 112, p = o2 / 80, w = o2 - p * 80;
                   if (w < 16) { dc = w - p; real = true; } else if (w >= 64) { dc = w - 73 - p; real = true; } }
            T[e] = real ? rp[dr * 31 + dc + 15] * LOG2E : -INFINITY;
        }
        if (tid_ < 136) T[15 * (int)attn_body::NA_STRIP + tid_] = tid_ < 68 ? 0.f : -INFINITY;
        __syncthreads();
    }
    attn_body::bf16x8 qr[6]; int s0 = 0; bool pre = false;
    const int bc = F.vcu >> 4, hc = F.vcu & 15;
    for (int i = 0; i < 8; ++i) {
        const int b = 8 * (s_ >> 1) + i, gi = (g + i) & 7, gn = (g + i + 1) & 7;
        const int lo = min(max(4 * gi - 4, 0), 24), hiR = min(max(4 * gi - 1, 0), 24) + 8, nwin = hiR - lo;
        const bool last = i == 7; const int hn = last ? hc : h, bn = last ? bc : b + 1;
        const attn_body::NextU nx{!last || need_ctx, (const abf*)(Q + hn * 64), (const abf*)(K + hn * 64), (const abf*)(V + hn * 64), last ? RL + bn * 256 : bn * 2048 + 256 * gn, RL + bn * 256};
        s0 = attn_body::attn_unit<24, true>((const abf*)(Q + h * 64), 1024, (const abf*)(K + h * 64), (const abf*)(V + h * 64), 1024, 1024, (abf*)(O + h * 64),
                                           b * 2048 + 256 * gi, RL + b * 256, 4, b * 2048 + 64 * lo, (4 + nwin + 1) & ~1, F.ldsg, qr, pre, s0, nx, 4 * gi, lo, nwin);
        pre = nx.on;
    }
    if (need_ctx) { const attn_body::NextU nx{false, nullptr, nullptr, nullptr, 0, 0};
        attn_body::attn_unit<8>((const abf*)(Q + hc * 64), 1024, (const abf*)(K + hc * 64), (const abf*)(V + hc * 64), 1024, 1024, (abf*)(O + hc * 64),
                                RL + bc * 256, RL + bc * 256, 4, bc * 2048, 4, F.ldsg, qr, pre, s0, nx); }
}

constexpr int NPHASE = 39;
#define PH(l, s) (2 + 9 * (l) + (s))
#if MK_PER_PHASE
#define SEAM() do { } while (0)
#else
#define SEAM() xcd_barrier(bar)
#endif
#ifndef DBG_SLOT
#define DBG_SLOT -1
#endif
#ifndef DBG_LAYER
#define DBG_LAYER -1
#endif
#ifndef REP_MASK
#define REP_MASK 0
#endif
#define IDEMP(l, s) ((s) == 0 ? (l) == 0 : (s) == 4 ? (l) == 0 : (s) == 1 ? (l) != 1 : true)
#ifndef REP_LAYER
#define REP_LAYER -1
#endif
#define NREP(l, s) ((((REP_MASK) >> (s)) & 1) && IDEMP(l, s) && (REP_LAYER < 0 || REP_LAYER == (l)) ? 2 : 1)
#define SLOT_ON(l, s) ((DBG_SLOT < 0 || DBG_SLOT == (s)) && (DBG_LAYER < 0 || DBG_LAYER == (l)))
#define IN(k) (lo <= (k) && (k) < hi)

constexpr int N2S = 12288;
template <int L> __device__ __forceinline__ void layer_program(Frame& F, const XcdBarrier& bar, int lo, int hi) {
    constexpr int KIND = L % 3, J = L / 3;
    constexpr bool need_ctx = L < DEPTH - 1;
    constexpr int MROWS = need_ctx ? RT : RL;
    bf16* WSB = FWS(WS_WS, bf16);
    const float* MOD = FWS(WS_MOD, float);
    float* ropeA = FWS(WS_ROPE, float); float* ropeB = ropeA + 2 * 2048 * 32;
    bf16* H = FWS(WS_H, bf16);
    if (SLOT_ON(L, 0) && IN(PH(L, 0))) for (int rep_ = 0; rep_ < NREP(L, 0); ++rep_) { norm1_phase<L>(F); SEAM(); }
    if (SLOT_ON(L, 1) && IN(PH(L, 1))) for (int rep_ = 0; rep_ < NREP(L, 1); ++rep_) {
        if (KIND == 0) {
            pg8::Gemm g{H, WSB + (J ? WO_AQKV1 : WO_AQKV0) / 2, 1024, nullptr}; pg8::StaticOrder S; S.init(RT, 1536, F.G, (int)blockIdx.x);
            EpiQKV<0> E{FWS(WS_ACT, bf16), F.in[I_AQN] + J * 64, F.in[I_AKN] + J * 64, ropeA, ropeA + 2048 * 32};
            pg8::gemm_phase<EpiQKV<0>, pg8::StaticOrder, false>(F.lds, g, S, E);
        } else if (KIND == 1) {
            pg8::Gemm g{H, WSB + WO_BDN / 2, 1024, nullptr}; pg8::StaticOrder S; S.init(RT, 768, F.G, (int)blockIdx.x);
            EpiBdown E{FWS(WS_ACT + AO_CQ, bf16), FWS(WS_ACT + AO_CKV, bf16), FWS(WS_ACT + AO_K, bf16), FWS(WS_RSQP, float), F.in[I_BKN] + 64, ropeB, ropeB + 2048 * 16};
            pg8::gemm_phase<EpiBdown, pg8::StaticOrder, false>(F.lds, g, S, E);
        } else {
            pg8::Gemm g{H, WSB + WO_CQKV / 2, 1024, nullptr}; pg8::StaticOrder S; S.init(RT, 3072, F.G, (int)blockIdx.x);
            EpiQKV<2> E{FWS(WS_ACT, bf16), F.in[I_CQN], F.in[I_CKN], nullptr, nullptr};
            pg8::gemm_phase<EpiQKV<2>, pg8::StaticOrder, false>(F.lds, g, S, E);
        }
        SEAM();
    }
    if (KIND == 1) { if (SLOT_ON(L, 2) && IN(PH(L, 2))) for (int rep_ = 0; rep_ < NREP(L, 2); ++rep_) {
#ifndef DBG_NO_UQ
        { pg8::Gemm g{FWS(WS_ACT + AO_CQ, bf16), WSB + WO_BUQ / 2, 384, nullptr}; pg8::StaticOrder S; S.init(RT, 1536, F.G, (int)blockIdx.x);
          EpiBuq E{FWS(WS_ACT + AO_Q, bf16), FWS(WS_RSQP, float), F.in[I_BQN], ropeB, ropeB + 2048 * 16};
          pg8::gemm_phase<EpiBuq, pg8::StaticOrder, false>(F.lds, g, S, E); }
#endif
#ifndef DBG_NO_UKV
        { pg8::Gemm g{FWS(WS_ACT + AO_CKV, bf16), WSB + WO_BUKV / 2, 256, nullptr}; pg8::StaticOrder S; S.init(RT, 2048, F.G, (int)blockIdx.x);
          EpiBukv E{FWS(WS_ACT + AO_K, bf16), FWS(WS_ACT + AO_V, bf16), FWS(WS_RSQP, float), F.in[I_BKN]};
          pg8::gemm_phase<EpiBukv, pg8::StaticOrder, false>(F.lds, g, S, E); }
#endif
        SEAM();
    } }
    if (SLOT_ON(L, 3) && IN(PH(L, 3))) for (int rep_ = 0; rep_ < NREP(L, 3); ++rep_) {
        if (KIND == 0) attn_dense64_phase(F, need_ctx, L);
        else if (KIND == 1) attn_mla_phase(F, need_ctx, L);
        else attn_na_phase(F, need_ctx, L);
        SEAM();
    }
    if (SLOT_ON(L, 4) && IN(PH(L, 4))) for (int rep_ = 0; rep_ < NREP(L, 4); ++rep_) {
        const bf16* Wt = WSB + (KIND == 0 ? (J ? WO_AWO1 : WO_AWO0) : (KIND == 1 ? WO_BWO : WO_CWO)) / 2;
        pg8::Gemm g{FWS(WS_ACT + AO_O, bf16), Wt, 1024, nullptr}; pg8::StaticOrder S;
        EpiWo E{FWS(WS_WOUT, bf16), MOD + (size_t)L * 17 * 6144};
        if (need_ctx && !MK_PER_PHASE && F.G == 256) {
            S.init(RL, 1024, F.G, (int)blockIdx.x);
            pg8::gemm_phase<EpiWo, pg8::StaticOrder, false>(F.lds, g, S, E);
            SEAM();
            if ((int)blockIdx.x < 64) { S.init(RT - RL, 1024, F.G, (int)blockIdx.x, RL / 256); pg8::gemm_phase<EpiWo, pg8::StaticOrder, false>(F.lds, g, S, E); }
            else norm2_phase<L>(F, N2S, 0, ((int)blockIdx.x - 64) * NWAVES + F.wave, 192 * NWAVES);
        } else {
            S.init(MROWS, 1024, F.G, (int)blockIdx.x);
            pg8::gemm_phase<EpiWo, pg8::StaticOrder, false>(F.lds, g, S, E);
        }
        SEAM();
    }
    if (SLOT_ON(L, 5) && IN(PH(L, 5))) for (int rep_ = 0; rep_ < NREP(L, 5); ++rep_) { norm2_phase<L>(F, MROWS, (need_ctx && !MK_PER_PHASE && F.G == 256) ? N2S : 0); SEAM(); }
    if (SLOT_ON(L, 6) && IN(PH(L, 6))) for (int rep_ = 0; rep_ < NREP(L, 6); ++rep_) { topk_phase(F, need_ctx); SEAM(); }
    if (SLOT_ON(L, 7) && IN(PH(L, 7))) for (int rep_ = 0; rep_ < NREP(L, 7); ++rep_) {
        pg8::Gemm g{H, FWS(WS_WMOE + (size_t)L * 96 * MiB, bf16), 1024, FWS(WS_GIDX, int)}; pg8::MoeOrder S{need_ctx ? 18 : 16, 8, F.G, (int)blockIdx.x};
        EpiMoeGU E{FWS(WS_ACT + AO_HID, bf16)};
        pg8::gemm_phase<EpiMoeGU, pg8::MoeOrder, true>(F.lds, g, S, E);
        SEAM();
    }
    if (SLOT_ON(L, 8) && IN(PH(L, 8))) for (int rep_ = 0; rep_ < NREP(L, 8); ++rep_) {
        pg8::Gemm g{FWS(WS_ACT + AO_HID, bf16), FWS(WS_WMOE + (size_t)L * 96 * MiB + 64 * MiB, bf16), 1024, nullptr}; pg8::MoeOrder S{need_ctx ? 18 : 16, 4, F.G, (int)blockIdx.x};
        EpiMoeDown E{FWS(WS_ACT + AO_Y, bf16), FWS(WS_GATE, float)};
        pg8::gemm_phase<EpiMoeDown, pg8::MoeOrder, false>(F.lds, g, S, E);
        if (L < DEPTH - 1 && F.G == 256 && (int)blockIdx.x >= 128) conv_chunk(F, (L + 1) * 24576, TAILN2, ((int)blockIdx.x - 128) * NWAVES + F.wave, TAILW2);
        SEAM();
    }
}

__global__ void __launch_bounds__(NTHR, 2) fwd(Args args) {
    extern __shared__ __attribute__((aligned(16))) unsigned char lds_raw[];
    Frame F;
    F.lds = (LAS unsigned char*)lds_raw; F.ldsg = (char*)lds_raw;
    F.wave = __builtin_amdgcn_readfirstlane(threadIdx.x >> 6);
    F.G = gridDim.x; { const int bx = blockIdx.x; F.vcu = (F.G % 8 == 0) ? (bx % 8) * (F.G / 8) + bx / 8 : bx; }
    F.gw = F.vcu * NWAVES + F.wave; F.NGW = F.G * NWAVES;
    F.in = args.in; F.out = args.out; F.ws = args.ws;
    volatile LAS unsigned* MISC = (volatile LAS unsigned*)(F.lds + MISC_OFF);
    for (int u = threadIdx.x; u < (LDS_BYTES - 131072) / 4; u += NTHR) ((LAS unsigned*)(F.lds + 131072))[u] = 0u;
    __syncthreads();
    XcdBarrier bar; bar.bar = (unsigned*)(F.ws + WS_CTL) + CW_BAR; bar.x = 0; bar.st = nullptr;
#if !MK_PER_PHASE
    bar = xcd_barrier_post((unsigned*)(F.ws + WS_CTL) + CW_BAR, MISC + 8);
#else
    (void)MISC;
#endif
    const int lo = args.ph_lo, hi = args.ph_hi; (void)lo; (void)hi;
    if (SLOT_ON(-2, 10) && IN(0)) _Pragma("unroll 1") for (int rep_ = 0; rep_ < NREP(0, 10); ++rep_) { p0_prologue(F); SEAM(); }
    if (SLOT_ON(-2, 11) && IN(1)) { p1_modreduce(F); SEAM(); }
    layer_program<0>(F, bar, lo, hi);
    layer_program<1>(F, bar, lo, hi);
    layer_program<2>(F, bar, lo, hi);
    layer_program<3>(F, bar, lo, hi);
    if (SLOT_ON(-2, 12) && IN(38)) final_phase(F);
}

extern "C" void kernel_launch(void* const* d_in, const int* in_sizes, int n_in, void* d_out, int out_size, void* d_ws, size_t ws_size, hipStream_t stream) {
    static int grid = 0;
    if (grid == 0) {
        if (n_in != 30 || in_sizes[0] != RL * D || out_size != RL * D || ws_size < WS_END) { fprintf(stderr, "kernel_launch: unexpected shapes / workspace (%d inputs, ws %zu < %zu)\n", n_in, ws_size, (size_t)WS_END); grid = -1; return; }
        int dev = 0, cus = 0, per_cu = 0;
        if (hipGetDevice(&dev) != hipSuccess || hipDeviceGetAttribute(&cus, hipDeviceAttributeMultiprocessorCount, dev) != hipSuccess) { grid = -1; return; }
        if (hipFuncSetAttribute((const void*)fwd, hipFuncAttributeMaxDynamicSharedMemorySize, LDS_BYTES) != hipSuccess) { fprintf(stderr, "kernel_launch: hipFuncSetAttribute failed\n"); grid = -1; return; }
        if (hipOccupancyMaxActiveBlocksPerMultiprocessor(&per_cu, (const void*)fwd, NTHR, LDS_BYTES) != hipSuccess || per_cu < 1) fprintf(stderr, "kernel_launch: occupancy query reports %d\n", per_cu);
        (void)hipGetLastError();
        grid = cus;
    }
    if (grid < 0) return;
    (void)hipMemsetAsync((char*)d_ws + WS_CTL, 0, CTL_ZERO_BYTES, stream);
    Args a{};
    for (int i = 0; i < 30; ++i) a.in[i] = (const float*)d_in[i];
    a.out = (float*)d_out; a.ws = (unsigned char*)d_ws;
#if MK_PER_PHASE
    for (int ph = 0; ph < NPHASE; ++ph) {
        if (ph >= 2 && ph < 38 && ((ph - 2) % 9) == 2 && (((ph - 2) / 9) % 3) != 1) continue;
        a.ph_lo = ph; a.ph_hi = ph + 1;
        hipLaunchKernelGGL(fwd, dim3(grid), dim3(NTHR), LDS_BYTES, stream, a);
    }
#else
    a.ph_lo = 0; a.ph_hi = NPHASE;
    hipLaunchKernelGGL(fwd, dim3(grid), dim3(NTHR), LDS_BYTES, stream, a);
#endif
}
```

```cpp
#include <hip/hip_runtime.h>
#include <hip/hip_bf16.h>
#include <cstdio>
#include <cstdint>
#include <cmath>

#ifndef MK_PER_PHASE
#define MK_PER_PHASE 0
#endif

#define GAS __attribute__((address_space(1)))
#define LAS __attribute__((address_space(3)))
typedef unsigned short bf16;
typedef short bf16x8 __attribute__((ext_vector_type(8)));
typedef short s16x4 __attribute__((ext_vector_type(4)));
typedef float f32x4 __attribute__((ext_vector_type(4)));
typedef float f32x16 __attribute__((ext_vector_type(16)));
typedef unsigned u32x4 __attribute__((ext_vector_type(4)));
typedef unsigned u32x2 __attribute__((ext_vector_type(2)));
typedef GAS unsigned gu32;

constexpr int D = 1024, NB = 16, SEQ = 2048, CTXL = 256, DEPTH = 4;
constexpr int RL = NB * SEQ, RC = NB * CTXL, RT = RL + RC;
constexpr int NE = 16, SLOTS_E = 4608, NSLOT = NE * SLOTS_E;
constexpr float EPS = 1e-6f, LOG2E = 1.4426950408889634f;
constexpr int NWAVES = 8, NTHR = 512;

constexpr size_t MiB = 1u << 20;
constexpr size_t WS_CTL = 0, CTL_ZERO_BYTES = 64 * 1024;
constexpr size_t WS_MOD = 1 * MiB;
constexpr size_t WS_MODP = 3 * MiB;
constexpr size_t WS_ROPE = 17 * MiB;
constexpr size_t WS_AFF = 18 * MiB;
constexpr size_t WS_INV = 21 * MiB;
constexpr size_t WS_GIDX = 24 * MiB;
constexpr size_t WS_GATE = 24 * MiB + 512 * 1024;
constexpr size_t WS_RSQ = 25 * MiB;
constexpr size_t WS_RSQP = 34 * MiB;
constexpr size_t WS_XC = 26 * MiB;
constexpr size_t WS_WS = 42 * MiB;
constexpr size_t WO_AQKV0 = 0, WO_AQKV1 = 3 * MiB, WO_AWO0 = 6 * MiB, WO_AWO1 = 8 * MiB, WO_BDN = 10 * MiB, WO_BUQ = 11 * MiB + 512 * 1024,
                 WO_BUKV = 13 * MiB, WO_BWO = 14 * MiB, WO_CQKV = 16 * MiB, WO_CWO = 22 * MiB;
constexpr size_t WS_WMOE = 66 * MiB;
constexpr size_t WS_H = 450 * MiB;
constexpr size_t WS_ACT = 522 * MiB;
constexpr size_t AO_Q = 0, AO_K = 108 * MiB, AO_V = 216 * MiB, AO_O = 288 * MiB, AO_CQ = 360 * MiB, AO_CKV = 387 * MiB, AO_HID = 0, AO_Y = 144 * MiB;
constexpr size_t WS_WOUT = 927 * MiB;
constexpr size_t WS_END = 999 * MiB;

constexpr int CW_BAR = 4096;
constexpr int LDS_BYTES = 147456, MISC_OFF = 131072 + 320;

#define LDS_WAIT() asm volatile("s_waitcnt lgkmcnt(0)" ::: "memory")
#define VM_WAIT() asm volatile("s_waitcnt vmcnt(0)" ::: "memory")
__device__ __forceinline__ unsigned f2bf(float f) { unsigned u = __builtin_bit_cast(unsigned, f); return (u + 0x7fffu + ((u >> 16) & 1u)) >> 16; }
__device__ __forceinline__ unsigned pk2(float lo, float hi) { return f2bf(lo) | (f2bf(hi) << 16); }
__device__ __forceinline__ float bf2f(unsigned h) { return __builtin_bit_cast(float, h << 16); }
__device__ __forceinline__ unsigned cvt_pk_bf16(float lo, float hi) { unsigned r; asm volatile("v_cvt_pk_bf16_f32 %0, %1, %2" : "=v"(r) : "v"(lo), "v"(hi)); return r; }
__device__ __forceinline__ u32x4 pack8(const f32x4 a, const f32x4 b) { u32x4 w; w.x = cvt_pk_bf16(a[0], a[1]); w.y = cvt_pk_bf16(a[2], a[3]); w.z = cvt_pk_bf16(b[0], b[1]); w.w = cvt_pk_bf16(b[2], b[3]); return w; }
__device__ __forceinline__ float wave_sum(float v) {
#pragma unroll
    for (int o = 1; o < 64; o <<= 1) v += __shfl_xor(v, o);
    return v;
}
__device__ __forceinline__ float sum4sq(const f32x4 a) { return (a[0] * a[0] + a[1] * a[1]) + (a[2] * a[2] + a[3] * a[3]); }
__device__ __forceinline__ float red_fq(float s) { s += __shfl_xor(s, 16); s += __shfl_xor(s, 32); return s; }

namespace pg8 {
constexpr int BM = 256, BK = 64, HALF = 128, HTB = HALF * BK * 2, NXCD = 8, WGM = 8;
__host__ __device__ __forceinline__ int lds_byte(int r, int c) { const int st = (r >> 4) * 2 + (c >> 5), rr = r & 15, cc = c & 31, ob = rr * 64 + cc * 2; return st * 1024 + (ob ^ (((ob >> 9) & 1) << 5)); }
__host__ __device__ __forceinline__ void stage_rc(int b, int& R, int& C) { const int st = b / 1024, sb = b % 1024, swz = sb ^ (((sb >> 9) & 1) << 5); R = (st >> 1) * 16 + swz / 64; C = (st & 1) * 32 + (swz % 64) / 2; }
__host__ __device__ __forceinline__ int perm32(int rho) { const int n = rho >> 4, i = rho & 15; return 8 * (i >> 2) + 4 * n + (i & 3); }
struct Unit { int pm, pn; };
struct Gemm { const bf16* A; const bf16* Bt; int K; const int* gidx; };
struct StaticOrder {
    int nM, nN, nwg, G, c;
    __device__ void init(int M, int N, int G_, int c_) { nM = M / BM; nN = N / BM; nwg = nM * nN; G = G_; c = c_; }
    __device__ bool next(int i, Unit& u) const {
        const long L = (long)i * G + c; if (L >= nwg) return false;
        int wgid = (int)L; { const int q = nwg / NXCD, r = nwg % NXCD, xcd = wgid % NXCD, off = wgid / NXCD; wgid = (xcd < r ? xcd * (q + 1) : r * (q + 1) + (xcd - r) * q) + off; }
        const int nig = WGM * nN, gid = wgid / nig, fm = gid * WGM, gsz = (nM - fm) < WGM ? (nM - fm) : WGM;
        u.pm = fm + ((wgid % nig) % gsz); u.pn = (wgid % nig) / gsz; return true;
    }
};
struct MoeOrder {
    int njt, npn, G, c;
    __device__ bool next(int i, Unit& u) const {
        const int x = c & 7, w = c >> 3, per = 2 * njt * npn;
        const int q = i * (G >> 3) + w; if (q >= per) return false;
        const int pe = njt * npn, el = q / pe, qq = q - el * pe, e = 2 * x + el, gsz = (njt % 8 == 0) ? 8 : 6, pg = gsz * npn, gi = qq / pg, r = qq - gi * pg;
        const int j = gi * gsz + r % gsz, pn = r / gsz;
        u.pm = e * 18 + j; u.pn = e * npn + pn; return true;
    }
};
template <class Epi, class Sched, bool GATHER>
__device__ __forceinline__ void gemm_phase(LAS unsigned char* lds, const Gemm g, const Sched& S, const Epi& E) {
    int tid_ = threadIdx.x; asm volatile("" : "+v"(tid_));
    const int tid = tid_, wid = __builtin_amdgcn_readfirstlane(tid >> 6), lane = tid & 63, wr = wid >> 2, wc = wid & 3, fr = lane & 15, fq = lane >> 4;
    const int K = g.K, nt = K / BK;
    unsigned voffB[2]; int RA[2]; unsigned CA[2];
#pragma unroll
    for (int i = 0; i < 2; ++i) { int R, C; stage_rc(tid * 16 + i * 8192, R, C); voffB[i] = (unsigned)(R * K + C) * 2u; RA[i] = R; CA[i] = (unsigned)C * 2u; }
    const size_t kstep = (size_t)(BK * 2);
    const unsigned hstep = (unsigned)HALF * (unsigned)K * 2u;
    const size_t tstep = 2 * (size_t)hstep;
    const unsigned ldsw = (unsigned)wid * 1024u;
    const int aoff = lds_byte(wr * 64 + fr, fq * 8), boff = lds_byte(wc * 32 + fr, fq * 8);
#define PG8_SA(b, h) (((b) * 2 + (h)) * HTB)
#define PG8_SB(b, h) ((4 + (b) * 2 + (h)) * HTB)
#define PG8_STAGE(bufoff, gbase, voff) do { _Pragma("unroll") for (int _i = 0; _i < 2; ++_i) \
        __builtin_amdgcn_global_load_lds((const unsigned*)((const char*)(gbase) + (voff)[_i]), (LAS unsigned*)(lds + (bufoff) + ldsw + _i * 8192), 16, 0, 0); } while (0)
#define PG8_LDA(dst, b, h) do { _Pragma("unroll") for (int m = 0; m < 4; ++m) _Pragma("unroll") for (int k = 0; k < 2; ++k) dst[m][k] = *(const LAS bf16x8*)(lds + PG8_SA(b, h) + aoff + m * 2048 + k * 1024); } while (0)
#define PG8_LDB(dst, b, h) do { _Pragma("unroll") for (int n = 0; n < 2; ++n) _Pragma("unroll") for (int k = 0; k < 2; ++k) dst[n][k] = *(const LAS bf16x8*)(lds + PG8_SB(b, h) + boff + n * 2048 + k * 1024); } while (0)
#define PG8_MMA(ai, bj, At, Bt) do { __builtin_amdgcn_s_setprio(1); _Pragma("unroll") for (int m = 0; m < 4; ++m) _Pragma("unroll") for (int n = 0; n < 2; ++n) _Pragma("unroll") for (int k = 0; k < 2; ++k) \
        acc[ai][bj][m][n] = __builtin_amdgcn_mfma_f32_16x16x32_bf16(Bt[n][k], At[m][k], acc[ai][bj][m][n], 0, 0, 0); __builtin_amdgcn_s_setprio(0); } while (0)
#define PG8_WAIT_V(n) asm volatile("s_waitcnt vmcnt(" #n ")" ::: "memory")
#define PG8_WAIT_L(n) asm volatile("s_waitcnt lgkmcnt(" #n ")" ::: "memory")
#define PG8_BAR __builtin_amdgcn_s_barrier()
#define PG8_SCHED __builtin_amdgcn_sched_barrier(0)
#define PG8_MKOFF(o, u) do { _Pragma("unroll") for (int _h = 0; _h < 2; ++_h) _Pragma("unroll") for (int _i = 0; _i < 2; ++_i) \
        o[_h][_i] = GATHER ? (unsigned)g.gidx[(u).pm * 256 + _h * 128 + RA[_i]] * (unsigned)(K * 2) + CA[_i] : (unsigned)(RA[_i] * K * 2) + CA[_i] + (unsigned)_h * hstep; } while (0)
    Unit cur, nxt; int ui = 0;
    if (!S.next(0, cur)) return;
    f32x4 acc[2][2][4][2];
#pragma unroll
    for (int a = 0; a < 2; ++a)
#pragma unroll
        for (int b = 0; b < 2; ++b)
#pragma unroll
            for (int m = 0; m < 4; ++m)
#pragma unroll
                for (int n = 0; n < 2; ++n) acc[a][b][m][n] = (f32x4){0.f, 0.f, 0.f, 0.f};
    bf16x8 At[4][2], B0[2][2], B1[2][2];
    unsigned cO[2][2], nO[2][2];
    const char* cA = GATHER ? (const char*)g.A : (const char*)g.A + (size_t)cur.pm * tstep; const char* cB = (const char*)g.Bt + (size_t)cur.pn * tstep;
    PG8_STAGE(PG8_SB(0, 0), cB, voffB); PG8_STAGE(PG8_SB(0, 1), cB + hstep, voffB);
    PG8_MKOFF(cO, cur);
    PG8_STAGE(PG8_SA(0, 0), cA, cO[0]); PG8_STAGE(PG8_SA(0, 1), cA, cO[1]);
    if (wr == 1) PG8_BAR;
    PG8_WAIT_V(2); PG8_BAR;
    PG8_STAGE(PG8_SB(1, 0), cB + kstep, voffB); PG8_STAGE(PG8_SA(1, 0), cA + kstep, cO[0]); PG8_STAGE(PG8_SB(1, 1), cB + hstep + kstep, voffB);
    PG8_WAIT_V(6); PG8_BAR;
    for (;;) {
        const bool has_next = S.next(ui + 1, nxt);
        const char* nA = has_next ? (GATHER ? (const char*)g.A : (const char*)g.A + (size_t)nxt.pm * tstep) : cA; const char* nB = has_next ? (const char*)g.Bt + (size_t)nxt.pn * tstep : cB;
        if (has_next) {
            if (GATHER) {
#pragma unroll
                for (int h = 0; h < 2; ++h)
#pragma unroll
                    for (int i = 0; i < 2; ++i) nO[h][i] = (unsigned)g.gidx[nxt.pm * 256 + h * 128 + RA[i]];
            } else { PG8_MKOFF(nO, nxt); }
        } else {
#pragma unroll
            for (int h = 0; h < 2; ++h)
#pragma unroll
                for (int i = 0; i < 2; ++i) nO[h][i] = cO[h][i]; }
#pragma unroll 1
        for (int t = 0; t < nt; t += 2) {
            const bool last = (t == nt - 2);
            const char* a1 = cA + (size_t)(t + 1) * kstep;
            const char* a2 = last ? nA : cA + (size_t)(t + 2) * kstep; const char* b2 = last ? nB : cB + (size_t)(t + 2) * kstep;
            const char* a3 = a2 + kstep; const char* b3 = b2 + kstep;
            unsigned o2[2][2];
#pragma unroll
            for (int h = 0; h < 2; ++h)
#pragma unroll
                for (int i = 0; i < 2; ++i) o2[h][i] = cO[h][i];
            if (last) {
                asm volatile("" : "+v"(nO[0][0]), "+v"(nO[0][1]), "+v"(nO[1][0]), "+v"(nO[1][1]));
                if (GATHER && has_next) {
#pragma unroll
                    for (int h = 0; h < 2; ++h)
#pragma unroll
                        for (int i = 0; i < 2; ++i) nO[h][i] = nO[h][i] * (unsigned)(K * 2) + CA[i];
                }
#pragma unroll
                for (int h = 0; h < 2; ++h)
#pragma unroll
                    for (int i = 0; i < 2; ++i) o2[h][i] = nO[h][i];
            }
            PG8_LDB(B0, 0, 0); PG8_LDB(B1, 0, 1); PG8_SCHED; PG8_LDA(At, 0, 0); PG8_STAGE(PG8_SA(1, 1), a1, cO[1]);
            PG8_WAIT_V(8); PG8_WAIT_L(0); PG8_BAR; PG8_MMA(0, 0, At, B0); PG8_MMA(0, 1, At, B1); PG8_BAR; PG8_SCHED;
            PG8_LDA(At, 0, 1); PG8_STAGE(PG8_SB(0, 0), b2, voffB); PG8_STAGE(PG8_SB(0, 1), b2 + hstep, voffB); PG8_STAGE(PG8_SA(0, 0), a2, o2[0]);
            PG8_WAIT_V(8); PG8_WAIT_L(0); PG8_BAR; PG8_MMA(1, 0, At, B0); PG8_MMA(1, 1, At, B1); PG8_BAR; PG8_SCHED;
            PG8_LDB(B0, 1, 0); PG8_LDB(B1, 1, 1); PG8_SCHED; PG8_LDA(At, 1, 0); PG8_STAGE(PG8_SA(0, 1), a2, o2[1]);
            PG8_WAIT_V(8); PG8_WAIT_L(0); PG8_BAR; PG8_MMA(0, 0, At, B0); PG8_MMA(0, 1, At, B1); PG8_BAR; PG8_SCHED;
            PG8_LDA(At, 1, 1); PG8_STAGE(PG8_SB(1, 0), b3, voffB); PG8_STAGE(PG8_SB(1, 1), b3 + hstep, voffB); PG8_STAGE(PG8_SA(1, 0), a3, o2[0]);
            PG8_WAIT_V(8); PG8_WAIT_L(0); PG8_BAR; PG8_MMA(1, 0, At, B0); PG8_MMA(1, 1, At, B1); PG8_BAR; PG8_SCHED;
        }
        if (wr == 0) PG8_BAR;
        { int fr_ = fr, fq_ = fq; asm volatile("" : "+v"(fr_), "+v"(fq_)); E(acc, cur, wr, wc, fr_, fq_); }
        if (!has_next) break;
#pragma unroll
        for (int a = 0; a < 2; ++a)
#pragma unroll
            for (int b = 0; b < 2; ++b)
#pragma unroll
                for (int m = 0; m < 4; ++m)
#pragma unroll
                    for (int n = 0; n < 2; ++n) acc[a][b][m][n] = (f32x4){0.f, 0.f, 0.f, 0.f};
        cur = nxt; cA = nA; cB = nB; ++ui;
#pragma unroll
        for (int h = 0; h < 2; ++h)
#pragma unroll
            for (int i = 0; i < 2; ++i) cO[h][i] = nO[h][i];
        if (wr == 1) PG8_BAR;
    }
    PG8_WAIT_V(0);
    PG8_BAR;
#undef PG8_SA
#undef PG8_SB
#undef PG8_STAGE
#undef PG8_LDA
#undef PG8_LDB
#undef PG8_MMA
#undef PG8_WAIT_V
#undef PG8_WAIT_L
#undef PG8_BAR
#undef PG8_SCHED
#undef PG8_MKOFF
}
}

template <int KIND> struct EpiQKV {
    bf16* act; const float *qg, *kg, *cosT, *sinT;
    __device__ __forceinline__ void operator()(const f32x4 (&acc)[2][2][4][2], const pg8::Unit& u, int wr, int wc, int fr, int fq) const {
        constexpr int NQ = 16, NK = (KIND == 0) ? 4 : 16, KVP = (KIND == 0) ? 256 : 1024;
        const int hs = 4 * u.pn + wc;
        const int type = hs < NQ ? 0 : (hs < NQ + NK ? 1 : 2);
        const int hh = type == 0 ? hs : (type == 1 ? hs - NQ : hs - NQ - NK);
        bf16* dst = act + (type == 0 ? AO_Q / 2 : (type == 1 ? AO_K / 2 : AO_V / 2)); const int pitch = type == 0 ? 1024 : KVP;
        const int dbase = 8 * fq;
        f32x4 g[2][2];
#pragma unroll
        for (int bj = 0; bj < 2; ++bj)
#pragma unroll
            for (int n = 0; n < 2; ++n) { const f32x4 a = *(const f32x4*)(qg + dbase + 32 * bj + 4 * n), b = *(const f32x4*)(kg + dbase + 32 * bj + 4 * n); g[bj][n] = (type == 0) ? a : b; }
        const float qs = type == 0 ? 0.125f * LOG2E : 1.f;
#pragma unroll
        for (int ai = 0; ai < 2; ++ai)
#pragma unroll
            for (int m = 0; m < 4; ++m) {
                const int row = u.pm * 256 + ai * 128 + wr * 64 + m * 16 + fr;
                f32x4 v[2][2];
#pragma unroll
                for (int bj = 0; bj < 2; ++bj)
#pragma unroll
                    for (int n = 0; n < 2; ++n) v[bj][n] = acc[ai][bj][m][n];
                if (type != 2) {
                    float ss = (sum4sq(v[0][0]) + sum4sq(v[0][1])) + (sum4sq(v[1][0]) + sum4sq(v[1][1]));
                    ss = red_fq(ss);
                    const float rinv = rsqrtf(ss * (1.f / 64.f) + EPS) * qs;
#pragma unroll
                    for (int bj = 0; bj < 2; ++bj)
#pragma unroll
                        for (int n = 0; n < 2; ++n) v[bj][n] = v[bj][n] * rinv * g[bj][n];
                    if (KIND == 0 && row < RL) {
                        const int pos = row & (SEQ - 1);
#pragma unroll
                        for (int n = 0; n < 2; ++n) {
                            const f32x4 c = *(const f32x4*)(cosT + pos * 32 + dbase + 4 * n), s = *(const f32x4*)(sinT + pos * 32 + dbase + 4 * n);
                            const f32x4 x1 = v[0][n], x2 = v[1][n];
                            v[0][n] = x1 * c - x2 * s; v[1][n] = x1 * s + x2 * c;
                        }
                    }
                }
                bf16* rp = dst + (size_t)row * pitch + hh * 64 + dbase;
#pragma unroll
                for (int bj = 0; bj < 2; ++bj) *(u32x4*)(rp + 32 * bj) = pack8(v[bj][0], v[bj][1]);
            }
    }
};
struct EpiWo {
    bf16* wout; const float* mod;
    __device__ __forceinline__ void operator()(const f32x4 (&acc)[2][2][4][2], const pg8::Unit& u, int wr, int wc, int fr, int fq) const {
        const int bi = u.pm < 128 ? (u.pm >> 3) : 16;
        const int col0 = u.pn * 256 + 32 * wc + 8 * fq;
        const float* m2 = mod + bi * 6144 + 2 * 1024 + col0;
        f32x4 mv[2][2];
#pragma unroll
        for (int bj = 0; bj < 2; ++bj)
#pragma unroll
            for (int n = 0; n < 2; ++n) mv[bj][n] = *(const f32x4*)(m2 + 128 * bj + 4 * n);
#pragma unroll
        for (int ai = 0; ai < 2; ++ai)
#pragma unroll
            for (int m = 0; m < 4; ++m) {
                const int row = u.pm * 256 + ai * 128 + wr * 64 + m * 16 + fr;
                bf16* wp = wout + (size_t)row * D + col0;
#pragma unroll
                for (int bj = 0; bj < 2; ++bj) *(u32x4*)(wp + 128 * bj) = pack8(mv[bj][0] * acc[ai][bj][m][0], mv[bj][1] * acc[ai][bj][m][1]);
            }
    }
};
struct EpiMoeGU {
    bf16* HID;
    __device__ __forceinline__ void operator()(const f32x4 (&acc)[2][2][4][2], const pg8::Unit& u, int wr, int wc, int fr, int fq) const {
        const int f0 = 128 * (u.pn & 7) + 32 * wc + 8 * fq;
#pragma unroll
        for (int ai = 0; ai < 2; ++ai)
#pragma unroll
            for (int m = 0; m < 4; ++m) {
                const int row = u.pm * 256 + ai * 128 + wr * 64 + m * 16 + fr;
                f32x4 h[2];
#pragma unroll
                for (int n = 0; n < 2; ++n) { const f32x4 gt = acc[ai][0][m][n], up = acc[ai][1][m][n];
#pragma unroll
                    for (int j = 0; j < 4; ++j) h[n][j] = gt[j] * __builtin_amdgcn_rcpf(1.f + __expf(-gt[j])) * up[j]; }
                *(u32x4*)(HID + (size_t)row * 1024 + f0) = pack8(h[0], h[1]);
            }
    }
};
struct EpiMoeDown {
    bf16* Y; const float* GATE;
    __device__ __forceinline__ void operator()(const f32x4 (&acc)[2][2][4][2], const pg8::Unit& u, int wr, int wc, int fr, int fq) const {
        const int col0 = 256 * (u.pn & 3) + 32 * wc + 8 * fq;
#pragma unroll
        for (int ai = 0; ai < 2; ++ai)
#pragma unroll
            for (int m = 0; m < 4; ++m) {
                const int row = u.pm * 256 + ai * 128 + wr * 64 + m * 16 + fr;
                const float gt = GATE[row];
#pragma unroll
                for (int bj = 0; bj < 2; ++bj) *(u32x4*)(Y + (size_t)row * 1024 + col0 + 128 * bj) = pack8(acc[ai][bj][m][0] * gt, acc[ai][bj][m][1] * gt);
            }
    }
};
struct EpiBdown {
    bf16 *CQ, *CKV, *Km; float *rsqp; const float *kg, *cosT, *sinT;
    __device__ __forceinline__ void operator()(const f32x4 (&acc)[2][2][4][2], const pg8::Unit& u, int wr, int wc, int fr, int fq) const {
        const int pn = u.pn;
#pragma unroll
        for (int ai = 0; ai < 2; ++ai)
#pragma unroll
            for (int m = 0; m < 4; ++m) {
                const int row = u.pm * 256 + ai * 128 + wr * 64 + m * 16 + fr;
                if (pn != 1) {
                    bf16* dst = (pn == 0 ? CQ + (size_t)row * 384 : CKV + (size_t)row * 256) + 32 * wc + 8 * fq;
                    float ss = 0.f;
#pragma unroll
                    for (int bj = 0; bj < 2; ++bj) { ss += sum4sq(acc[ai][bj][m][0]) + sum4sq(acc[ai][bj][m][1]); *(u32x4*)(dst + 128 * bj) = pack8(acc[ai][bj][m][0], acc[ai][bj][m][1]); }
                    ss = red_fq(ss);
                    if (fq == 0) rsqp[(size_t)row * 12 + (pn == 0 ? 0 : 8) + wc] = ss;
                } else {
                    float ss = sum4sq(acc[ai][0][m][0]) + sum4sq(acc[ai][0][m][1]);
                    *(u32x4*)(CQ + (size_t)row * 384 + 256 + 32 * wc + 8 * fq) = pack8(acc[ai][0][m][0], acc[ai][0][m][1]);
                    ss = red_fq(ss);
                    if (fq == 0) rsqp[(size_t)row * 12 + 4 + wc] = ss;
                    if (wc == 0) {
                        f32x4 a = acc[ai][1][m][0], b = acc[ai][1][m][1];
                        float s2 = red_fq(sum4sq(a) + sum4sq(b));
                        const float rinv = rsqrtf(s2 * (1.f / 32.f) + EPS);
                        a = a * rinv * *(const f32x4*)(kg + 4 * fq); b = b * rinv * *(const f32x4*)(kg + 16 + 4 * fq);
                        if (row < RL) { const int pos = row & (SEQ - 1); const f32x4 c = *(const f32x4*)(cosT + pos * 16 + 4 * fq), s = *(const f32x4*)(sinT + pos * 16 + 4 * fq);
                            const f32x4 x1 = a, x2 = b; a = x1 * c - x2 * s; b = x1 * s + x2 * c; }
                        u32x2 wa, wb; wa.x = cvt_pk_bf16(a[0], a[1]); wa.y = cvt_pk_bf16(a[2], a[3]); wb.x = cvt_pk_bf16(b[0], b[1]); wb.y = cvt_pk_bf16(b[2], b[3]);
                        bf16* kp = Km + (size_t)row * 1536 + 64 + 4 * fq;
#pragma unroll
                        for (int h = 0; h < 16; ++h) { *(u32x2*)(kp + 96 * h) = wa; *(u32x2*)(kp + 96 * h + 16) = wb; }
                    }
                }
            }
    }
};
struct EpiBuq {
    bf16* Qm; const float *rsqp, *qg, *cosT, *sinT;
    __device__ __forceinline__ void operator()(const f32x4 (&acc)[2][2][4][2], const pg8::Unit& u, int wr, int wc, int fr, int fq) const {
        const float C2 = 0.10206207261596575f * LOG2E;
        const int pn = u.pn;
#pragma unroll
        for (int ai = 0; ai < 2; ++ai)
#pragma unroll
            for (int m = 0; m < 4; ++m) {
                const int row = u.pm * 256 + ai * 128 + wr * 64 + m * 16 + fr;
                const f32x4 p0_ = *(const f32x4*)(rsqp + (size_t)row * 12), p1_ = *(const f32x4*)(rsqp + (size_t)row * 12 + 4);
                const float al = rsqrtf((((p0_[0] + p0_[1]) + (p0_[2] + p0_[3])) + ((p1_[0] + p1_[1]) + (p1_[2] + p1_[3]))) * (1.f / 384.f) + EPS);
                if (pn < 4) {
                    const int head = 4 * pn + wc;
                    f32x4 v[2][2]; float ss = 0.f;
#pragma unroll
                    for (int bj = 0; bj < 2; ++bj)
#pragma unroll
                        for (int n = 0; n < 2; ++n) { v[bj][n] = acc[ai][bj][m][n] * al; ss += sum4sq(v[bj][n]); }
                    ss = red_fq(ss);
                    const float rinv = rsqrtf(ss * (1.f / 64.f) + EPS) * C2;
                    bf16* rp = Qm + (size_t)row * 1536 + head * 96 + 8 * fq;
#pragma unroll
                    for (int bj = 0; bj < 2; ++bj) { const f32x4 g0 = *(const f32x4*)(qg + 32 * bj + 8 * fq), g1 = *(const f32x4*)(qg + 32 * bj + 8 * fq + 4);
                        *(u32x4*)(rp + 32 * bj) = pack8(v[bj][0] * rinv * g0, v[bj][1] * rinv * g1); }
                } else {
#pragma unroll
                    for (int bj = 0; bj < 2; ++bj) {
                        const int head = 8 * (pn - 4) + 4 * bj + wc;
                        f32x4 a = acc[ai][bj][m][0] * al, b = acc[ai][bj][m][1] * al;
                        const float ss = red_fq(sum4sq(a) + sum4sq(b));
                        const float rinv = rsqrtf(ss * (1.f / 32.f) + EPS) * C2;
                        a = a * rinv * *(const f32x4*)(qg + 64 + 4 * fq); b = b * rinv * *(const f32x4*)(qg + 80 + 4 * fq);
                        if (row < RL) { const int pos = row & (SEQ - 1); const f32x4 c = *(const f32x4*)(cosT + pos * 16 + 4 * fq), s = *(const f32x4*)(sinT + pos * 16 + 4 * fq);
                            const f32x4 x1 = a, x2 = b; a = x1 * c - x2 * s; b = x1 * s + x2 * c; }
                        u32x2 wa, wb; wa.x = cvt_pk_bf16(a[0], a[1]); wa.y = cvt_pk_bf16(a[2], a[3]); wb.x = cvt_pk_bf16(b[0], b[1]); wb.y = cvt_pk_bf16(b[2], b[3]);
                        bf16* rp = Qm + (size_t)row * 1536 + head * 96 + 64 + 4 * fq;
                        *(u32x2*)rp = wa; *(u32x2*)(rp + 16) = wb;
                    }
                }
                asm volatile("" ::: "memory");
            }
    }
};
struct EpiBukv {
    bf16 *Km, *Vm; const float *rsqp, *kg;
    __device__ __forceinline__ void operator()(const f32x4 (&acc)[2][2][4][2], const pg8::Unit& u, int wr, int wc, int fr, int fq) const {
        const int pn = u.pn;
#pragma unroll
        for (int ai = 0; ai < 2; ++ai)
#pragma unroll
            for (int m = 0; m < 4; ++m) {
                const int row = u.pm * 256 + ai * 128 + wr * 64 + m * 16 + fr;
                const f32x4 p2_ = *(const f32x4*)(rsqp + (size_t)row * 12 + 8);
                const float al = rsqrtf(((p2_[0] + p2_[1]) + (p2_[2] + p2_[3])) * (1.f / 256.f) + EPS);
                f32x4 v[2][2]; float ss = 0.f;
#pragma unroll
                for (int bj = 0; bj < 2; ++bj)
#pragma unroll
                    for (int n = 0; n < 2; ++n) { v[bj][n] = acc[ai][bj][m][n] * al; ss += sum4sq(v[bj][n]); }
                if (pn < 4) {
                    ss = red_fq(ss);
                    const float rinv = rsqrtf(ss * (1.f / 64.f) + EPS);
                    bf16* rp = Km + (size_t)row * 1536 + (4 * pn + wc) * 96 + 8 * fq;
#pragma unroll
                    for (int bj = 0; bj < 2; ++bj) { const f32x4 g0 = *(const f32x4*)(kg + 32 * bj + 8 * fq), g1 = *(const f32x4*)(kg + 32 * bj + 8 * fq + 4);
                        *(u32x4*)(rp + 32 * bj) = pack8(v[bj][0] * rinv * g0, v[bj][1] * rinv * g1); }
                } else {
                    bf16* rp = Vm + (size_t)row * 1024 + (4 * (pn - 4) + wc) * 64 + 8 * fq;
#pragma unroll
                    for (int bj = 0; bj < 2; ++bj) *(u32x4*)(rp + 32 * bj) = pack8(v[bj][0], v[bj][1]);
                }
                asm volatile("" ::: "memory");
            }
    }
};

__device__ __forceinline__ int crow(int r, int hi) { return (r & 3) + 8 * (r >> 2) + 4 * hi; }
template <int DK, int MODE>
__device__ __forceinline__ void attn_unit(LAS unsigned char* lds, const bf16* Qp, int qpitch, const bf16* Kp, int kpitch, const bf16* Vp, int vpitch, bf16* Op,
                                          int qrow0, int base0, int n0, int base1, int NT, int g4, int lo, const float* rpbh) {
    constexpr int KSTR = DK * 2 + 16, KSZ = 64 * KSTR, CPR = DK / 8, NCH = 64 * CPR;
    int tid_ = threadIdx.x; asm volatile("" : "+v"(tid_));
    const int tid = tid_, lane = tid & 63, r32 = lane & 31, hi = lane >> 5; const int wid = __builtin_amdgcn_readfirstlane(tid >> 6);
    LAS unsigned char* Kl = lds; LAS unsigned char* Vl = lds + 2 * KSZ; LAS float* rpbL = (LAS float*)(lds + 2 * KSZ + 16384);
    const int kr0 = tid / CPR, kc0 = tid % CPR, kr1 = (tid + 512) / CPR, kc1 = (tid + 512) % CPR; const bool k2 = (tid + 512) < NCH;
    const int vr = tid >> 3, vc = tid & 7;
    const unsigned kdst0 = kr0 * KSTR + kc0 * 16, kdst1 = kr1 * KSTR + kc1 * 16, vdst = (vc >> 2) * 4096 + vr * 64 + (vc & 3) * 16;
    if (MODE == 2) { if (tid < 15 * 32) { const int dr = tid >> 5, dc = tid & 31; rpbL[tid] = dc < 31 ? rpbh[dr * 31 + dc] * LOG2E : 0.f; } }
    bf16x8 qf[DK / 16];
    { const bf16* qp = Qp + (size_t)(qrow0 + wid * 32 + r32) * qpitch + hi * 8;
#pragma unroll
      for (int d0 = 0; d0 < DK / 16; ++d0) qf[d0] = *(const bf16x8*)(qp + 16 * d0); }
    f32x16 o0, o1;
#pragma unroll
    for (int i = 0; i < 16; ++i) { o0[i] = 0.f; o1[i] = 0.f; }
    float mrun = -1e30f, lrun = 0.f;
    const int rq = g4 + (wid >> 1), rs = min(max(rq - 4, 0), 24), cq = 32 * (wid & 1) + r32, cs = min(max(cq - 8, 0), 48);
    const unsigned vb = (4 * hi + ((lane & 15) >> 2)) * 64 + ((lane >> 4) & 1) * 32 + (lane & 3) * 8;
    u32x4 kreg0, kreg1, vreg;
#define ATT_TROW(t) ((t) < n0 ? base0 + 64 * (t) : base1 + 64 * ((t) - n0))
#define ATT_LOAD(t) do { const int tr_ = ATT_TROW(t); kreg0 = *(const u32x4*)(Kp + (size_t)(tr_ + kr0) * kpitch + kc0 * 8); \
        if (k2) kreg1 = *(const u32x4*)(Kp + (size_t)(tr_ + kr1) * kpitch + kc1 * 8); vreg = *(const u32x4*)(Vp + (size_t)(tr_ + vr) * vpitch + vc * 8); } while (0)
#define ATT_WRITE(b) do { *(LAS u32x4*)(Kl + (b) * KSZ + kdst0) = kreg0; if (k2) *(LAS u32x4*)(Kl + (b) * KSZ + kdst1) = kreg1; *(LAS u32x4*)(Vl + (b) * 8192 + vdst) = vreg; } while (0)
    ATT_LOAD(0); ATT_WRITE(0);
    __syncthreads();
    for (int t = 0; t < NT; ++t) {
        const int b = t & 1;
        if (t + 1 < NT) ATT_LOAD(t + 1);
        bool active = true;
        if (MODE == 2) { if (t < n0) { const int kr = lo + t; active = (kr >= rs) && (kr < rs + 8); } }
        if (active) {
            f32x16 p0, p1;
#pragma unroll
            for (int i = 0; i < 16; ++i) { p0[i] = 0.f; p1[i] = 0.f; }
            const LAS unsigned char* kb = Kl + b * KSZ + r32 * KSTR + hi * 16;
#pragma unroll
            for (int d0 = 0; d0 < DK / 16; ++d0) {
                const bf16x8 ka = *(const LAS bf16x8*)(kb + d0 * 32), kc = *(const LAS bf16x8*)(kb + 32 * KSTR + d0 * 32);
                p0 = __builtin_amdgcn_mfma_f32_32x32x16_bf16(ka, qf[d0], p0, 0, 0, 0);
                p1 = __builtin_amdgcn_mfma_f32_32x32x16_bf16(kc, qf[d0], p1, 0, 0, 0);
            }
            if (MODE == 2) { if (t < n0) {
                const LAS float* brow = rpbL + (lo + t - rq + 7) * 32;
                int cq_ = cq, cs_ = cs; asm volatile("" : "+v"(cq_), "+v"(cs_));
#pragma unroll
                for (int i = 0; i < 16; ++i) {
                    const int kc_ = crow(i, hi);
                    { const int rel = kc_ - cs_; const int bi = min(max(kc_ - cq_ + 15, 0), 30); p0[i] = ((unsigned)rel < 16u) ? p0[i] + brow[bi] : -1e30f; }
                    { const int rel = kc_ + 32 - cs_; const int bi = min(max(kc_ + 32 - cq_ + 15, 0), 30); p1[i] = ((unsigned)rel < 16u) ? p1[i] + brow[bi] : -1e30f; }
                    if ((i & 3) == 3) asm volatile("" ::: "memory");
                } } }
            float mx = fmaxf(p0[0], p1[0]);
#pragma unroll
            for (int i = 1; i < 16; ++i) mx = fmaxf(mx, fmaxf(p0[i], p1[i]));
            mx = fmaxf(mx, __shfl_xor(mx, 32));
            const float mnew = fmaxf(mrun, mx), alpha = __builtin_amdgcn_exp2f(mrun - mnew);
            mrun = mnew; lrun *= alpha;
            float rsum = 0.f;
#pragma unroll
            for (int i = 0; i < 16; ++i) { o0[i] *= alpha; o1[i] *= alpha; p0[i] = __builtin_amdgcn_exp2f(p0[i] - mnew); p1[i] = __builtin_amdgcn_exp2f(p1[i] - mnew); rsum += p0[i] + p1[i]; }
            lrun += rsum;
            bf16x8 pf[4];
#pragma unroll
            for (int ks = 0; ks < 4; ++ks) { u32x4 w;
                if (ks < 2) { const int s8 = 8 * ks; w.x = cvt_pk_bf16(p0[s8], p0[s8 + 1]); w.y = cvt_pk_bf16(p0[s8 + 2], p0[s8 + 3]); w.z = cvt_pk_bf16(p0[s8 + 4], p0[s8 + 5]); w.w = cvt_pk_bf16(p0[s8 + 6], p0[s8 + 7]); }
                else { const int s8 = 8 * (ks - 2); w.x = cvt_pk_bf16(p1[s8], p1[s8 + 1]); w.y = cvt_pk_bf16(p1[s8 + 2], p1[s8 + 3]); w.z = cvt_pk_bf16(p1[s8 + 4], p1[s8 + 5]); w.w = cvt_pk_bf16(p1[s8 + 6], p1[s8 + 7]); }
                pf[ks] = __builtin_bit_cast(bf16x8, w); }
            const LAS unsigned char* vbase = Vl + b * 8192 + vb;
#pragma unroll
            for (int ks = 0; ks < 4; ++ks) {
                const s16x4 a0 = __builtin_bit_cast(s16x4, __builtin_amdgcn_ds_read_tr16_b64_v4i16((LAS s16x4*)(vbase + ks * 1024)));
                const s16x4 a1 = __builtin_bit_cast(s16x4, __builtin_amdgcn_ds_read_tr16_b64_v4i16((LAS s16x4*)(vbase + ks * 1024 + 512)));
                const s16x4 c0 = __builtin_bit_cast(s16x4, __builtin_amdgcn_ds_read_tr16_b64_v4i16((LAS s16x4*)(vbase + 4096 + ks * 1024)));
                const s16x4 c1 = __builtin_bit_cast(s16x4, __builtin_amdgcn_ds_read_tr16_b64_v4i16((LAS s16x4*)(vbase + 4096 + ks * 1024 + 512)));
                const bf16x8 v0 = (bf16x8){a0[0], a0[1], a0[2], a0[3], a1[0], a1[1], a1[2], a1[3]}, v1 = (bf16x8){c0[0], c0[1], c0[2], c0[3], c1[0], c1[1], c1[2], c1[3]};
                o0 = __builtin_amdgcn_mfma_f32_32x32x16_bf16(v0, pf[ks], o0, 0, 0, 0);
                o1 = __builtin_amdgcn_mfma_f32_32x32x16_bf16(v1, pf[ks], o1, 0, 0, 0);
            }
        }
        if (t + 1 < NT) ATT_WRITE(b ^ 1);
        __syncthreads();
    }
#undef ATT_TROW
#undef ATT_LOAD
#undef ATT_WRITE
    lrun += __shfl_xor(lrun, 32);
    const float il = 1.f / lrun;
    bf16* op = Op + (size_t)(qrow0 + wid * 32 + r32) * 1024 + 4 * hi;
#pragma unroll
    for (int g = 0; g < 4; ++g) {
        u32x2 w0, w1; w0.x = cvt_pk_bf16(o0[4 * g] * il, o0[4 * g + 1] * il); w0.y = cvt_pk_bf16(o0[4 * g + 2] * il, o0[4 * g + 3] * il);
        w1.x = cvt_pk_bf16(o1[4 * g] * il, o1[4 * g + 1] * il); w1.y = cvt_pk_bf16(o1[4 * g + 2] * il, o1[4 * g + 3] * il);
        *(u32x2*)(op + 8 * g) = w0; *(u32x2*)(op + 32 + 8 * g) = w1;
    }
}

template <int DK>
__device__ __forceinline__ void attn_unit_pipe(LAS unsigned char* lds, const bf16* Qp, int qpitch, const bf16* Kp, int kpitch, const bf16* Vp, int vpitch, bf16* Op,
                                               int qrow0, int base0, int n0, int base1, int NT) {
    constexpr int KSTR = DK * 2 + 16, KSZ = 64 * KSTR, CPR = DK / 8, NCH = 64 * CPR;
    int tid_ = threadIdx.x; asm volatile("" : "+v"(tid_));
    const int tid = tid_, lane = tid & 63, r32 = lane & 31, hi = lane >> 5; const int wid = __builtin_amdgcn_readfirstlane(tid >> 6);
    LAS unsigned char* Kl = lds; LAS unsigned char* Vl = lds + 2 * KSZ;
    const int kr0 = tid / CPR, kc0 = tid % CPR, kr1 = (tid + 512) / CPR, kc1 = (tid + 512) % CPR; const bool k2 = (tid + 512) < NCH;
    const int vr = tid >> 3, vc = tid & 7;
    const unsigned kdst0 = kr0 * KSTR + kc0 * 16, kdst1 = kr1 * KSTR + kc1 * 16, vdst = (vc >> 2) * 4096 + vr * 64 + (vc & 3) * 16;
    bf16x8 qf[DK / 16];
    { const bf16* qp = Qp + (size_t)(qrow0 + wid * 32 + r32) * qpitch + hi * 8;
#pragma unroll
      for (int d0 = 0; d0 < DK / 16; ++d0) qf[d0] = *(const bf16x8*)(qp + 16 * d0); }
    f32x16 o0, o1, pc0, pc1, pn0, pn1;
#pragma unroll
    for (int i = 0; i < 16; ++i) { o0[i] = 0.f; o1[i] = 0.f; }
    float mrun = -1e30f, lrun = 0.f;
    const unsigned vb = (4 * hi + ((lane & 15) >> 2)) * 64 + ((lane >> 4) & 1) * 32 + (lane & 3) * 8;
    const unsigned kbo = r32 * KSTR + hi * 16;
    u32x4 kreg0, kreg1, vreg;
#define AP_TROW(t) ((t) < n0 ? base0 + 64 * (t) : base1 + 64 * ((t) - n0))
#define AP_LOADK(t) do { const int tr_ = AP_TROW(t); kreg0 = *(const u32x4*)(Kp + (size_t)(tr_ + kr0) * kpitch + kc0 * 8); if (k2) kreg1 = *(const u32x4*)(Kp + (size_t)(tr_ + kr1) * kpitch + kc1 * 8); } while (0)
#define AP_LOADV(t) do { const int tr_ = AP_TROW(t); vreg = *(const u32x4*)(Vp + (size_t)(tr_ + vr) * vpitch + vc * 8); } while (0)
#define AP_WRITEK(b) do { *(LAS u32x4*)(Kl + (b) * KSZ + kdst0) = kreg0; if (k2) *(LAS u32x4*)(Kl + (b) * KSZ + kdst1) = kreg1; } while (0)
#define AP_WRITEV(b) do { *(LAS u32x4*)(Vl + (b) * 8192 + vdst) = vreg; } while (0)
#define AP_QK(P0, P1, b) do { const LAS unsigned char* kb_ = Kl + (b) * KSZ + kbo; \
        _Pragma("unroll") for (int i_ = 0; i_ < 16; ++i_) { P0[i_] = 0.f; P1[i_] = 0.f; } \
        _Pragma("unroll") for (int d0 = 0; d0 < DK / 16; ++d0) { \
            const bf16x8 ka_ = *(const LAS bf16x8*)(kb_ + d0 * 32), kc_ = *(const LAS bf16x8*)(kb_ + 32 * KSTR + d0 * 32); \
            P0 = __builtin_amdgcn_mfma_f32_32x32x16_bf16(ka_, qf[d0], P0, 0, 0, 0); P1 = __builtin_amdgcn_mfma_f32_32x32x16_bf16(kc_, qf[d0], P1, 0, 0, 0); } } while (0)
#define AP_SMPV(P0, P1, b) do { \
        float mx_ = fmaxf(P0[0], P1[0]); \
        _Pragma("unroll") for (int i_ = 1; i_ < 16; ++i_) mx_ = fmaxf(mx_, fmaxf(P0[i_], P1[i_])); \
        mx_ = fmaxf(mx_, __shfl_xor(mx_, 32)); \
        if (__any(mx_ > mrun)) { const float mnew_ = fmaxf(mrun, mx_), alpha_ = __builtin_amdgcn_exp2f(mrun - mnew_); mrun = mnew_; lrun *= alpha_; \
            _Pragma("unroll") for (int i_ = 0; i_ < 16; ++i_) { o0[i_] *= alpha_; o1[i_] *= alpha_; } } \
        float rsum_ = 0.f; \
        _Pragma("unroll") for (int i_ = 0; i_ < 16; ++i_) { P0[i_] = __builtin_amdgcn_exp2f(P0[i_] - mrun); P1[i_] = __builtin_amdgcn_exp2f(P1[i_] - mrun); rsum_ += P0[i_] + P1[i_]; } \
        lrun += rsum_; \
        bf16x8 pf_[4]; \
        _Pragma("unroll") for (int ks = 0; ks < 4; ++ks) { u32x4 w_; \
            if (ks < 2) { const int s8 = 8 * ks; w_.x = cvt_pk_bf16(P0[s8], P0[s8 + 1]); w_.y = cvt_pk_bf16(P0[s8 + 2], P0[s8 + 3]); w_.z = cvt_pk_bf16(P0[s8 + 4], P0[s8 + 5]); w_.w = cvt_pk_bf16(P0[s8 + 6], P0[s8 + 7]); } \
            else { const int s8 = 8 * (ks - 2); w_.x = cvt_pk_bf16(P1[s8], P1[s8 + 1]); w_.y = cvt_pk_bf16(P1[s8 + 2], P1[s8 + 3]); w_.z = cvt_pk_bf16(P1[s8 + 4], P1[s8 + 5]); w_.w = cvt_pk_bf16(P1[s8 + 6], P1[s8 + 7]); } \
            pf_[ks] = __builtin_bit_cast(bf16x8, w_); } \
        const LAS unsigned char* vbase_ = Vl + (b) * 8192 + vb; \
        _Pragma("unroll") for (int ks = 0; ks < 4; ++ks) { \
            const s16x4 a0_ = __builtin_bit_cast(s16x4, __builtin_amdgcn_ds_read_tr16_b64_v4i16((LAS s16x4*)(vbase_ + ks * 1024))); \
            const s16x4 a1_ = __builtin_bit_cast(s16x4, __builtin_amdgcn_ds_read_tr16_b64_v4i16((LAS s16x4*)(vbase_ + ks * 1024 + 512))); \
            const s16x4 c0_ = __builtin_bit_cast(s16x4, __builtin_amdgcn_ds_read_tr16_b64_v4i16((LAS s16x4*)(vbase_ + 4096 + ks * 1024))); \
            const s16x4 c1_ = __builtin_bit_cast(s16x4, __builtin_amdgcn_ds_read_tr16_b64_v4i16((LAS s16x4*)(vbase_ + 4096 + ks * 1024 + 512))); \
            const bf16x8 v0_ = (bf16x8){a0_[0], a0_[1], a0_[2], a0_[3], a1_[0], a1_[1], a1_[2], a1_[3]}, v1_ = (bf16x8){c0_[0], c0_[1], c0_[2], c0_[3], c1_[0], c1_[1], c1_[2], c1_[3]}; \
            o0 = __builtin_amdgcn_mfma_f32_32x32x16_bf16(v0_, pf_[ks], o0, 0, 0, 0); o1 = __builtin_amdgcn_mfma_f32_32x32x16_bf16(v1_, pf_[ks], o1, 0, 0, 0); } } while (0)
    AP_LOADK(0); AP_LOADV(0); AP_WRITEK(0); AP_WRITEV(0);
    AP_LOADK(1); AP_WRITEK(1);
    __syncthreads();
    AP_QK(pc0, pc1, 0);
    __syncthreads();
    for (int t = 0; t < NT; ++t) {
        const int b = t & 1;
        const bool more1 = t + 1 < NT, more2 = t + 2 < NT;
        if (more2) AP_LOADK(t + 2);
        if (more1) AP_LOADV(t + 1);
        if (wid < 4) {
            if (more1) AP_QK(pn0, pn1, b ^ 1);
            AP_SMPV(pc0, pc1, b);
        } else {
            AP_SMPV(pc0, pc1, b);
            if (more1) AP_QK(pn0, pn1, b ^ 1);
        }
        if (more2) AP_WRITEK(b);
        if (more1) AP_WRITEV(b ^ 1);
        pc0 = pn0; pc1 = pn1;
        __syncthreads();
    }
#undef AP_TROW
#undef AP_LOADK
#undef AP_LOADV
#undef AP_WRITEK
#undef AP_WRITEV
#undef AP_QK
#undef AP_SMPV
    lrun += __shfl_xor(lrun, 32);
    const float il = 1.f / lrun;
    bf16* op = Op + (size_t)(qrow0 + wid * 32 + r32) * 1024 + 4 * hi;
#pragma unroll
    for (int g = 0; g < 4; ++g) {
        u32x2 w0, w1; w0.x = cvt_pk_bf16(o0[4 * g] * il, o0[4 * g + 1] * il); w0.y = cvt_pk_bf16(o0[4 * g + 2] * il, o0[4 * g + 3] * il);
        w1.x = cvt_pk_bf16(o1[4 * g] * il, o1[4 * g + 1] * il); w1.y = cvt_pk_bf16(o1[4 * g + 2] * il, o1[4 * g + 3] * il);
        *(u32x2*)(op + 8 * g) = w0; *(u32x2*)(op + 32 + 8 * g) = w1;
    }
}

namespace attn_body {
using bf16=__hip_bfloat16;
using bf16x8=__attribute__((ext_vector_type(8)))short;
using s16x4=__attribute__((ext_vector_type(4)))short;
using f32x16=__attribute__((ext_vector_type(16)))float;
using u32x4=__attribute__((ext_vector_type(4)))unsigned;
constexpr int D=64;
constexpr int NW=8,QBLK=32,QB=QBLK*NW,KVBLK=64;
constexpr int ATTN_UNIT_ROWS=QB;
__device__ __forceinline__ int crow(int r,int hi){return (r&3)+8*(r>>2)+4*hi;}
#define SBAR() __builtin_amdgcn_sched_barrier(0)
__device__ __forceinline__ void cmask(f32x16&p0,f32x16&p1,int jb,int qrel,int hi){
  const float NEG=-INFINITY; int kb=64*jb+4*hi;
  #pragma unroll
  for(int r=0;r<16;++r){int kv=kb+(r&3)+8*(r>>2); if(kv>qrel)p0[r]=NEG; if(kv+32>qrel)p1[r]=NEG;}
}

constexpr int NSLOT=3, SLOTB=8192;
constexpr int LDS_K=0, LDS_V=NSLOT*SLOTB, LDS_WS=2*NSLOT*SLOTB, LDS_OST=LDS_WS+NW*64*4, LDS_BYTES=LDS_OST+NW*4096;
constexpr float C2=0.125f*1.4426950408889634f;
__device__ __forceinline__ void glds16(const void*gsrc,unsigned lds_dst){unsigned keep;
  asm volatile("s_mov_b32 %0, m0\n\ts_mov_b32 m0, %2\n\ts_nop 0\n\tglobal_load_lds_dwordx4 %1, off\n\ts_mov_b32 m0, %0":"=&s"(keep):"v"(gsrc),"s"(lds_dst):"memory");}
__device__ __forceinline__ float max3f(float a,float b,float c){float r;asm("v_max3_f32 %0, %1, %2, %3":"=v"(r):"v"(a),"v"(b),"v"(c));return r;}
__device__ __forceinline__ float max2f(float a,float b){float r;asm("v_max_f32_e32 %0, %1, %2":"=v"(r):"v"(a),"v"(b));return r;}
__device__ __forceinline__ float fadd_s(float a,float b){float r;asm("v_add_f32_e32 %0, %1, %2":"=v"(r):"v"(a),"v"(b));return r;}
__device__ __forceinline__ float fsub_s(float a,float b){float r;asm("v_sub_f32_e32 %0, %1, %2":"=v"(r):"v"(a),"v"(b));return r;}
constexpr unsigned NA_STRIP=736u;
typedef float f32x2_t __attribute__((ext_vector_type(2))); typedef __bf16 bf16x2_t __attribute__((ext_vector_type(2)));
__device__ __forceinline__ unsigned cvtpk_s(float lo,float hi){f32x2_t v={lo,hi};bf16x2_t b=__builtin_convertvector(v,bf16x2_t);return __builtin_bit_cast(unsigned,b);}
#define WAIT_BAR(N) asm volatile("s_waitcnt vmcnt(" #N ") lgkmcnt(0)\n\ts_barrier":::"memory")

template<int ND> __device__ __forceinline__ void qkt(f32x16&p0,f32x16&p1,const char*Kslot,const bf16x8*qr,const f32x16&negm,int r32,int hi){
  const char*kb=Kslot+hi*1024+r32*16;
  #pragma unroll
  for(int d0=0;d0<ND;++d0){
    const bf16x8 b0=*reinterpret_cast<const bf16x8*>(kb+d0*2048);
    const bf16x8 b1=*reinterpret_cast<const bf16x8*>(kb+d0*2048+512);
    if(d0==0){p0=__builtin_amdgcn_mfma_f32_32x32x16_bf16(b0,qr[0],negm,0,0,0);p1=__builtin_amdgcn_mfma_f32_32x32x16_bf16(b1,qr[0],negm,0,0,0);}
    else{p0=__builtin_amdgcn_mfma_f32_32x32x16_bf16(b0,qr[d0],p0,0,0,0);p1=__builtin_amdgcn_mfma_f32_32x32x16_bf16(b1,qr[d0],p1,0,0,0);}}
}
typedef __attribute__((address_space(3))) const char* lds_cptr;
typedef short v4i16_t __attribute__((ext_vector_type(4)));
__device__ __forceinline__ void kload8(bf16x8*kf,lds_cptr kp){
  kf[0]=*(const __attribute__((address_space(3))) bf16x8*)(kp);      kf[1]=*(const __attribute__((address_space(3))) bf16x8*)(kp+512);
  kf[2]=*(const __attribute__((address_space(3))) bf16x8*)(kp+2048); kf[3]=*(const __attribute__((address_space(3))) bf16x8*)(kp+2560);
  kf[4]=*(const __attribute__((address_space(3))) bf16x8*)(kp+4096); kf[5]=*(const __attribute__((address_space(3))) bf16x8*)(kp+4608);
  kf[6]=*(const __attribute__((address_space(3))) bf16x8*)(kp+6144); kf[7]=*(const __attribute__((address_space(3))) bf16x8*)(kp+6656);
}
__device__ __forceinline__ void kload2(bf16x8*kf,lds_cptr kp,int j){ kf[2*j]=*(const __attribute__((address_space(3))) bf16x8*)(kp+j*2048); kf[2*j+1]=*(const __attribute__((address_space(3))) bf16x8*)(kp+j*2048+512); }
__device__ __forceinline__ s16x4 vtr(lds_cptr p){ return __builtin_bit_cast(s16x4,__builtin_amdgcn_ds_read_tr16_b64_v4i16((__attribute__((address_space(3))) v4i16_t*)p)); }
__device__ __forceinline__ float rowmax(const f32x16&p0,const f32x16&p1){
  float a=max3f(p0[0],p0[1],p1[0]),b=max3f(p0[2],p0[3],p1[1]);a=max3f(a,p1[2],p1[3]);
  #pragma unroll
  for(int r=4;r<16;r+=4){a=max3f(a,p0[r],p0[r+1]);b=max3f(b,p0[r+2],p0[r+3]);a=max3f(a,p1[r],p1[r+1]);b=max3f(b,p1[r+2],p1[r+3]);}
  const float m=max2f(a,b);
  auto rr=__builtin_amdgcn_permlane32_swap(__float_as_uint(m),__float_as_uint(m),false,false);
  return max2f(__uint_as_float(rr[0]),__uint_as_float(rr[1]));
}
__device__ __forceinline__ void pv(f32x16*o,int vb,bf16x8 pa0,bf16x8 pa1,bf16x8 pa2,bf16x8 pa3){
  #pragma unroll
  for(int d0=0;d0<2;++d0){s16x4 lo[4],hi[4];
    #pragma unroll
    for(int ks=0;ks<4;++ks){
      asm volatile("ds_read_b64_tr_b16 %0,%1 offset:%c2":"=&v"(lo[ks]):"v"(vb),"i"(d0*4096+ks*1024):"memory");
      asm volatile("ds_read_b64_tr_b16 %0,%1 offset:%c2":"=&v"(hi[ks]):"v"(vb),"i"(d0*4096+ks*1024+512):"memory");}
    asm volatile("s_waitcnt lgkmcnt(0)":::"memory");SBAR();
    #define PK(k) (bf16x8){lo[k][0],lo[k][1],lo[k][2],lo[k][3],hi[k][0],hi[k][1],hi[k][2],hi[k][3]}
    o[d0]=__builtin_amdgcn_mfma_f32_32x32x16_bf16(pa0,PK(0),o[d0],0,0,0);
    o[d0]=__builtin_amdgcn_mfma_f32_32x32x16_bf16(pa1,PK(1),o[d0],0,0,0);
    o[d0]=__builtin_amdgcn_mfma_f32_32x32x16_bf16(pa2,PK(2),o[d0],0,0,0);
    o[d0]=__builtin_amdgcn_mfma_f32_32x32x16_bf16(pa3,PK(3),o[d0],0,0,0);
    #undef PK
  }
}

#ifndef ATTN_STORE16
#define ATTN_STORE16(p,v) (*(u32x4*)(p)=(v))
#endif
struct NextU { bool on; const bf16*Q; const bf16*K; const bf16*V; int qrow0, base0; };
template<int THRL,bool NA=false,int DK=64,bool PFQ=true> __device__ __forceinline__ int attn_unit(const bf16*Qw0,int QP,const bf16*__restrict__ Kh,const bf16*__restrict__ Vh,int KP,int VP,bf16*Ow0,int qrow0,int base0,int n0,int base1,int NT,char*shm,
                                                                bf16x8 (&qr)[6],bool pre,int s0,const NextU&nx,int g4=0,int lo=0,int nwin=0){
  int tid_=threadIdx.x; asm volatile("":"+v"(tid_));
  const int tid=tid_,lane=tid&63,r32=lane&31,hi=lane>>5; const int wid=__builtin_amdgcn_readfirstlane(tid>>6);
  constexpr int ND=DK/16, KSLOT=64*DK*2, L_K=0, L_V=NSLOT*KSLOT, L_WS=L_V+NSLOT*SLOTB, L_OST=L_WS+NW*64*4;
  #define KO(sl) ((DK==64)?(sl):((sl)+((sl)>>1)))
  #define WAIT_BARK(a_,b_) do{ if(DK==64){WAIT_BAR(a_);}else{WAIT_BAR(b_);} }while(0)
  const bf16*Qw=Qw0+(long)(qrow0+wid*QBLK)*QP;
  const unsigned lds0=(unsigned)(uintptr_t)shm;
  float*wsf=(float*)(shm+L_WS)+wid*64;
  const __attribute__((address_space(3))) float*rpbL=(const __attribute__((address_space(3))) float*)((__attribute__((address_space(3))) const char*)shm+86016);
  const int na_rq=g4+(wid>>1), na_rs=min(max(na_rq-4,0),24), na_cq=32*(wid&1)+r32;
  const unsigned na_base=(unsigned)(uintptr_t)rpbL+16u*(unsigned)hi+4u*(unsigned)(na_cq<8?112+80*na_cq:(na_cq>56?128+80*(na_cq-57):56-na_cq));
  const unsigned na_flat=(unsigned)(uintptr_t)rpbL+15u*4u*NA_STRIP+16u*(unsigned)hi;
  const bf16*ksrc=Kh+(long)lane*KP+wid*8;
  const bf16*vsrc=Vh+(long)(16*(wid&3)+(lane>>2))*VP+(wid>>2)*32+(lane&3)*8;
  const bf16*ksrc2=Kh+(long)lane*KP+(8+(wid&3))*8;
  const unsigned kdst=lds0+L_K+wid*1024, kdst2=lds0+L_K+(8+(wid&3))*1024, vdst=lds0+L_V+wid*1024;
  #define TROW(t) ((t)<n0?base0+64*(t):base1+64*((t)-n0))
  #define DMA_K(t,slot) do{ glds16(ksrc+(long)TROW(t)*KP,(unsigned)__builtin_amdgcn_readfirstlane(kdst+KO(slot))); if(DK==96) glds16(ksrc2+(long)TROW(t)*KP,(unsigned)__builtin_amdgcn_readfirstlane(kdst2+KO(slot))); }while(0)
  #define DMA_V(t,slot) glds16(vsrc+(long)TROW(t)*VP,(unsigned)__builtin_amdgcn_readfirstlane(vdst+(slot)))
  #define DMA_KN(t,slot) do{ glds16(ksrc+dKn_+(long)(b0n_+64*(t))*KP,(unsigned)__builtin_amdgcn_readfirstlane(kdst+KO(slot))); if(DK==96) glds16(ksrc2+dKn_+(long)(b0n_+64*(t))*KP,(unsigned)__builtin_amdgcn_readfirstlane(kdst2+KO(slot))); }while(0)
  #define DMA_VN(t,slot) glds16(vsrc+dVn_+(long)(b0n_+64*(t))*VP,(unsigned)__builtin_amdgcn_readfirstlane(vdst+(slot)))
  const int vb0=(int)(lds0+L_V)+((lane>>4)&1)*32+(lane&3)*8+(4*hi+((lane&15)>>2))*64;
  const char*Kbase=shm+L_K; bf16x8 kf[12];
  const lds_cptr shm3=(lds_cptr)shm; const lds_cptr kp0=shm3+L_K+hi*1024+r32*16; const lds_cptr vp0=shm3+L_V+((lane>>4)&1)*32+(lane&3)*8+(4*hi+((lane&15)>>2))*64;
  const int s1=(s0==(NSLOT-1)*SLOTB)?0:s0+SLOTB, s2=(s1==(NSLOT-1)*SLOTB)?0:s1+SLOTB;
  if(!pre){ DMA_K(0,s0);DMA_V(0,s0);DMA_K(1,s1); }
  if(!pre||!PFQ){
    #pragma unroll
    for(int d0=0;d0<ND;++d0)qr[d0]=*reinterpret_cast<const bf16x8*>(&Qw[(long)r32*QP+d0*16+hi*8]);
  }
  float z_; asm volatile("v_mov_b32 %0, 0":"=v"(z_));
  float mhat=0.f,l_reg=0.f;f32x16 o[2],negm,zero16;
  #pragma unroll
  for(int r=0;r<16;++r){o[0][r]=z_;o[1][r]=z_;negm[r]=z_;zero16[r]=z_;}
  if(!NA){asm volatile("":"+v"(negm));}
  #define CMASK(P0,P1,t) do{}while(0)
  bool resc=false, na_m0=true;
  #define START(P0,P1) do{ const float rm=rowmax(P0,P1); resc=false; \
    { float dl=rm; if(NA){ if(__builtin_expect(__any(__builtin_fabsf(rm)>(float)THRL),0)){ na_m0=false; } else { dl=0.f; } } mhat=fadd_s(mhat,dl); \
      _Pragma("unroll") for(int r=0;r<16;++r){P0[r]=fsub_s(P0[r],dl);P1[r]=fsub_s(P1[r],dl);} \
      if(!NA){ _Pragma("unroll") for(int r=0;r<16;++r)negm[r]=-mhat; asm volatile("":"+v"(negm)); } } \
    _Pragma("unroll") for(int r=0;r<16;++r)P0[r]=__builtin_amdgcn_exp2f(P0[r]); }while(0)
  #define RESC() do{ if(resc){ asm volatile("s_waitcnt lgkmcnt(0)":::"memory"); \
      _Pragma("unroll") for(int d_=0;d_<2;++d_) _Pragma("unroll") for(int r=0;r<16;++r)o[d_][r]*=wsf[crow(r,hi)]; } }while(0)
  f32x16 pA0,pA1,pB0,pB1;
  int sl_prev=s0,sl_cur=s0,sl_next=s1;
  #define ROT() do{sl_prev=sl_cur;sl_cur=sl_next;sl_next=(sl_next==(NSLOT-1)*SLOTB)?0:sl_next+SLOTB;}while(0)
  if(!pre){
    DMA_K(2,s2);
    WAIT_BARK(3,5);
  } else { if(PFQ){ WAIT_BAR(4); } else { WAIT_BAR(0); } }
  DMA_V(1,s1);
  qkt<ND>(pA0,pA1,Kbase+KO(s0),qr,zero16,r32,hi);asm volatile("s_nop 15\n\ts_nop 7":"+v"(pA0),"+v"(pA1));CMASK(pA0,pA1,0);
  START(pA0,pA1);
  _Pragma("unroll") for(int r=0;r<16;++r)pA1[r]=__builtin_amdgcn_exp2f(pA1[r]);
  if(NA){ _Pragma("unroll") for(int r=0;r<16;++r){pB0[r]=z_;pB1[r]=z_;} }
  WAIT_BAR(1);
  DMA_K(3,s0);
  ROT();
  _Pragma("unroll") for(int j_=0;j_<ND;++j_) kload2(kf,kp0+KO(sl_cur),j_);
  WAIT_BARK(2,3);
  s16x4 vlo[8],vhi[8]; u32x4 pw0,pw1,pw2,pw3;
  #define PKW(P,B) cvtpk_s(P[B],P[B+1])
  #define PAF(k) __builtin_bit_cast(bf16x8,pw##k)
  #define VFR(i) (bf16x8){vlo[i][0],vlo[i][1],vlo[i][2],vlo[i][3],vhi[i][0],vhi[i][1],vhi[i][2],vhi[i][3]}
  #define PIN(x) asm volatile("":"+v"(x))
  #define MX3(a,b,c) __builtin_fmaxf(__builtin_fmaxf((a),(b)),(c))
  #define GAPA(MF,A0,A1,A2,A3,W0,W1,PW) do{ MF; sacc+=A0; sacc+=A1; sacc+=A2; sacc+=A3; PIN(sacc); W0; W1; PIN(PW); SBAR(); }while(0)
  #define EX(v) __builtin_amdgcn_exp2f(v)
  #define GAPB(MF,X,B,FILL) do{ MF; X[B]=EX(X[B]); X[B+1]=EX(X[B+1]); X[B+2]=EX(X[B+2]); X[B+3]=EX(X[B+3]); PIN(X); FILL; SBAR(); }while(0)
  #define LDSF(x) (*(const __attribute__((address_space(3))) float*)(x))
  #define NAC(r) (4u*(unsigned)(((r)&3)+8*((r)>>2)))
  #define NAF_LD(F0,F1,g) do{ F0[2*(g)]=LDSF(na_a+NAC(2*(g))); F0[2*(g)+1]=LDSF(na_a+NAC(2*(g)+1)); F1[2*(g)]=LDSF(na_a+NAC(2*(g))+128u); F1[2*(g)+1]=LDSF(na_a+NAC(2*(g)+1)+128u); }while(0)
  #define NAF_FIN(F0,F1,g) do{ F0[2*(g)]-=mhat; F0[2*(g)+1]-=mhat; F1[2*(g)]-=mhat; F1[2*(g)+1]-=mhat; }while(0)
  #define NAF(F0,F1,g) do{ if(NA){ NAF_LD(F0,F1,g); } }while(0)
  #define VRD(i) do{ vlo[i]=vtr(vp_+(((i)>>2)*4096+((i)&3)*1024)); vhi[i]=vtr(vp_+(((i)>>2)*4096+((i)&3)*1024+512)); }while(0)
  #define KRD(G,j) do{ if(G){ kload2(kf,kp0+KO(sl_next),j); SBAR(); } }while(0)
  #define STEP(C0,C1,P0,P1,t,GK,GV,GL,NX) do{ \
    if(NA){ if(__builtin_expect(!na_m0,0)){ _Pragma("unroll") for(int r=0;r<16;++r){C0[r]-=mhat;C1[r]-=mhat;} } } \
    SBAR(); \
    const lds_cptr vp_=vp0+sl_prev; \
    VRD(0); SBAR(); float sacc=(P0[0]+P0[1]); \
    GAPA(C0=__builtin_amdgcn_mfma_f32_32x32x16_bf16(kf[0],qr[0],(NA?C0:negm),0,0,0), P0[2],P0[3],P0[4],P0[5],     pw0[0]=PKW(P0,0), pw0[1]=PKW(P0,2), pw0); \
    VRD(4); SBAR(); GAPA(C1=__builtin_amdgcn_mfma_f32_32x32x16_bf16(kf[1],qr[0],(NA?C1:negm),0,0,0), P0[6],P0[7],P0[8],P0[9],     pw0[2]=PKW(P0,4), pw0[3]=PKW(P0,6), pw0); \
    VRD(1); SBAR(); GAPA(C0=__builtin_amdgcn_mfma_f32_32x32x16_bf16(kf[2],qr[1],C0,0,0,0),   P0[10],P0[11],P0[12],P0[13], pw1[0]=PKW(P0,8), pw1[1]=PKW(P0,10), pw1); \
    VRD(5); SBAR(); GAPA(C1=__builtin_amdgcn_mfma_f32_32x32x16_bf16(kf[3],qr[1],C1,0,0,0),   P0[14],P0[15],P1[0],P1[1],   pw1[2]=PKW(P0,12),pw1[3]=PKW(P0,14), pw1); \
    VRD(2); SBAR(); GAPA(C0=__builtin_amdgcn_mfma_f32_32x32x16_bf16(kf[4],qr[2],C0,0,0,0),   P1[2],P1[3],P1[4],P1[5],     pw2[0]=PKW(P1,0), pw2[1]=PKW(P1,2), pw2); \
    VRD(6); SBAR(); GAPA(C1=__builtin_amdgcn_mfma_f32_32x32x16_bf16(kf[5],qr[2],C1,0,0,0),   P1[6],P1[7],P1[8],P1[9],     pw2[2]=PKW(P1,4), pw2[3]=PKW(P1,6), pw2); \
    VRD(3); SBAR(); GAPA(C0=__builtin_amdgcn_mfma_f32_32x32x16_bf16(kf[6],qr[3],C0,0,0,0),   P1[10],P1[11],P1[12],P1[13], pw3[0]=PKW(P1,8), pw3[1]=PKW(P1,10), pw3); \
    VRD(7); SBAR(); GAPA(C1=__builtin_amdgcn_mfma_f32_32x32x16_bf16(kf[7],qr[3],C1,0,0,0),   P1[14],P1[15],0.f,0.f,       pw3[2]=PKW(P1,12),pw3[3]=PKW(P1,14), pw3); \
    if(DK==96){ C0=__builtin_amdgcn_mfma_f32_32x32x16_bf16(kf[8],qr[4],C0,0,0,0); SBAR(); C1=__builtin_amdgcn_mfma_f32_32x32x16_bf16(kf[9],qr[4],C1,0,0,0); SBAR(); \
      C0=__builtin_amdgcn_mfma_f32_32x32x16_bf16(kf[10],qr[5],C0,0,0,0); SBAR(); C1=__builtin_amdgcn_mfma_f32_32x32x16_bf16(kf[11],qr[5],C1,0,0,0); SBAR(); } \
    l_reg+=sacc; \
    if(GK){DMA_K((t)+3,sl_cur);} if(GV){DMA_V((t)+1,sl_next);} \
    if(NX){ const long dKn_=nx.K-Kh,dVn_=nx.V-Vh; const int b0n_=nx.base0; DMA_KN(0,sl_next); DMA_VN(0,sl_next); DMA_KN(1,sl_prev); DMA_KN(2,sl_cur); } \
    CMASK(C0,C1,t); \
    { float a=MX3(C0[0],C0[1],C1[0]),b=MX3(C0[2],C0[3],C1[1]); a=MX3(a,C1[2],C1[3]); \
      _Pragma("unroll") for(int r=4;r<16;r+=4){a=MX3(a,C0[r],C0[r+1]);b=MX3(b,C0[r+2],C0[r+3]);a=MX3(a,C1[r],C1[r+1]);b=MX3(b,C1[r+2],C1[r+3]);} \
      float rm=__builtin_fmaxf(a,b); { auto rr=__builtin_amdgcn_permlane32_swap(__float_as_uint(rm),__float_as_uint(rm),false,false); rm=__builtin_fmaxf(__uint_as_float(rr[0]),__uint_as_float(rr[1])); } \
      resc=false; \
      if(__builtin_expect(__any(rm>(float)THRL),0)){ const float dl=__builtin_fmaxf(rm,0.f); mhat+=dl; \
        _Pragma("unroll") for(int r=0;r<16;++r){C0[r]-=dl;C1[r]-=dl;} \
        if(!NA){ _Pragma("unroll") for(int r=0;r<16;++r)negm[r]=-mhat; asm volatile("":"+v"(negm)); } \
        const float f=__builtin_amdgcn_exp2f(-dl); l_reg*=f; if(hi==0)wsf[r32]=f; resc=true; if(NA){na_m0=false;} } } \
    unsigned na_a=0u; if(NA){ const int tn_=(t)+1,tw_=tn_-4,kr_=lo+tw_; const bool cx_=tn_<4; \
      const bool win_=!cx_&&tw_<nwin&&kr_>=na_rs&&kr_<na_rs+8;     \
      na_a=win_?na_base+(4u*NA_STRIP)*(unsigned)(kr_-na_rq+7):na_flat+(cx_?0u:272u); asm volatile("":"+v"(na_a)); } \
    SBAR(); \
    GAPB(o[0]=__builtin_amdgcn_mfma_f32_32x32x16_bf16(PAF(0),VFR(0),o[0],0,0,0), C0,0,NAF(P0,P1,0)); \
    GAPB(o[1]=__builtin_amdgcn_mfma_f32_32x32x16_bf16(PAF(0),VFR(4),o[1],0,0,0), C0,4,NAF(P0,P1,1)); \
    KRD(GL,0); GAPB(o[0]=__builtin_amdgcn_mfma_f32_32x32x16_bf16(PAF(1),VFR(1),o[0],0,0,0), C0,8,NAF(P0,P1,2)); \
    KRD(GL,1); GAPB(o[1]=__builtin_amdgcn_mfma_f32_32x32x16_bf16(PAF(1),VFR(5),o[1],0,0,0), C0,12,NAF(P0,P1,3)); \
    KRD(GL,2); GAPB(o[0]=__builtin_amdgcn_mfma_f32_32x32x16_bf16(PAF(2),VFR(2),o[0],0,0,0), C1,0,NAF(P0,P1,4)); \
    KRD(GL,3); GAPB(o[1]=__builtin_amdgcn_mfma_f32_32x32x16_bf16(PAF(2),VFR(6),o[1],0,0,0), C1,4,NAF(P0,P1,5)); \
    if(DK==96){KRD(GL,4);} GAPB(o[0]=__builtin_amdgcn_mfma_f32_32x32x16_bf16(PAF(3),VFR(3),o[0],0,0,0), C1,8,NAF(P0,P1,6)); \
    if(DK==96){KRD(GL,5);} GAPB(o[1]=__builtin_amdgcn_mfma_f32_32x32x16_bf16(PAF(3),VFR(7),o[1],0,0,0), C1,12,NAF(P0,P1,7)); \
    }while(0)
  int t=1;
  if constexpr(DK==64){
    for(;t+3<NT;t+=2){
      STEP(pB0,pB1,pA0,pA1,t,true,true,true,false);     WAIT_BARK(2,3); RESC(); ROT();
      STEP(pA0,pA1,pB0,pB1,t+1,true,true,true,false);   WAIT_BARK(2,3); RESC(); ROT();
    }
    STEP(pB0,pB1,pA0,pA1,t,false,true,true,false);      WAIT_BAR(1); RESC(); ROT();
    STEP(pA0,pA1,pB0,pB1,t+1,false,true,true,false);    WAIT_BAR(1); RESC(); ROT();
  } else {
    for(;t+5<NT;t+=2){
      STEP(pB0,pB1,pA0,pA1,t,true,true,true,false);     WAIT_BARK(2,3); RESC(); ROT();
      STEP(pA0,pA1,pB0,pB1,t+1,true,true,true,false);   WAIT_BARK(2,3); RESC(); ROT();
    }
    #define ENDW(tt) do{ if((tt)+3<NT){WAIT_BARK(2,3);} else {WAIT_BAR(1);} }while(0)
    for(;t+1<NT;t+=2){
      STEP(pB0,pB1,pA0,pA1,t,(t+3<NT),(t+1<NT),(t+1<NT),false);       ENDW(t);   RESC(); ROT();
      STEP(pA0,pA1,pB0,pB1,t+1,(t+4<NT),(t+2<NT),(t+2<NT),false);     ENDW(t+1); RESC(); ROT();
    }
    #undef ENDW
  }
  STEP(pB0,pB1,pA0,pA1,NT-1,false,false,false,nx.on);
  if(nx.on){ WAIT_BARK(4,7); } else { WAIT_BAR(0); }
  RESC();
  { float sacc=pB0[0]+pB0[1]; _Pragma("unroll") for(int r=2;r<16;++r)sacc+=pB0[r]; _Pragma("unroll") for(int r=0;r<16;++r)sacc+=pB1[r]; l_reg+=sacc;
    pw0=(u32x4){PKW(pB0,0),PKW(pB0,2),PKW(pB0,4),PKW(pB0,6)};pw1=(u32x4){PKW(pB0,8),PKW(pB0,10),PKW(pB0,12),PKW(pB0,14)};pw2=(u32x4){PKW(pB1,0),PKW(pB1,2),PKW(pB1,4),PKW(pB1,6)};pw3=(u32x4){PKW(pB1,8),PKW(pB1,10),PKW(pB1,12),PKW(pB1,14)};
    SBAR(); pv(o,vb0+sl_cur,PAF(0),PAF(1),PAF(2),PAF(3)); }
  if(PFQ&&nx.on){ const bf16*Qn=nx.Q+(long)(nx.qrow0+wid*QBLK)*QP;
    #pragma unroll
    for(int d0=0;d0<ND;++d0)qr[d0]=*reinterpret_cast<const bf16x8*>(&Qn[(long)r32*QP+d0*16+hi*8]); }
  #undef PKW
  #undef PAF
  #undef VFR
  #undef PIN
  #undef MX3
  #undef GAPA
  #undef GAPB
  #undef NAF
  #undef NAF_LD
  #undef NAF_FIN
  #undef NAC
  #undef LDSF
  #undef EX
  #undef VRD
  #undef KRD
  #undef STEP
  {auto rr=__builtin_amdgcn_permlane32_swap(__float_as_uint(l_reg),__float_as_uint(l_reg),false,false);l_reg=__uint_as_float(rr[0])+__uint_as_float(rr[1]);}
  if(hi==0)wsf[32+r32]=l_reg;asm volatile("s_waitcnt lgkmcnt(0)":::"memory");
  float rli[16];
  #pragma unroll
  for(int r=0;r<16;++r)rli[r]=__builtin_amdgcn_rcpf(wsf[32+crow(r,hi)]);
  bf16*Ow=Ow0+(long)(qrow0+wid*QBLK)*1024;
  { bf16*stg=(bf16*)(shm+L_OST)+wid*2048;
    #pragma unroll
    for(int r=0;r<16;++r){const int orow=crow(r,hi);
      #pragma unroll
      for(int d0=0;d0<2;++d0)stg[orow*64+d0*32+r32]=__float2bfloat16(o[d0][r]*rli[r]);}
    asm volatile("s_waitcnt lgkmcnt(0)":::"memory");
    #pragma unroll
    for(int i=0;i<4;++i){const int row=i*8+(lane>>3),ch=lane&7; const u32x4 v=*(const u32x4*)(stg+row*64+ch*8); ATTN_STORE16(Ow+(long)row*1024+ch*8,v);} }
  asm volatile("s_waitcnt lgkmcnt(0)\n\ts_barrier":::"memory");
  #undef DMA_K
  #undef DMA_KN
  #undef DMA_VN
  #undef KO
  #undef WAIT_BARK
  #undef TROW
  #undef DMA_V
  #undef CMASK
  #undef START
  #undef RESC
  #undef ROT
  return sl_next;
}
constexpr int ATTN_LDS_BYTES=LDS_BYTES;
#undef SBAR
#undef WAIT_BAR
}
#define XB_TMO      128
#define XB_XCNT(j)  (256  + 64 * (j))
#define XB_XSUB(j)  (1280 + 64 * (j))
#define XB_XGEN(j)  (2304 + 64 * (j))
#define XB_TOP      3328
#define XB_TOPGEN   3392
#define XCD_BAR_WORDS 3456
#define XB_SPIN_CAP (1u << 18)
__device__ __forceinline__ unsigned xb_ld(unsigned* p)              { return __hip_atomic_load(p, __ATOMIC_RELAXED, __HIP_MEMORY_SCOPE_AGENT); }
__device__ __forceinline__ unsigned xb_add(unsigned* p, unsigned v) { return __hip_atomic_fetch_add(p, v, __ATOMIC_RELAXED, __HIP_MEMORY_SCOPE_AGENT); }
__device__ __forceinline__ unsigned xb_xcc_id() { return (unsigned)__builtin_amdgcn_s_getreg((3 << 11) | 20) & 0xFu; }
#define XB_SPIN(cond, bar) do { unsigned _sp = 0; while (cond) { __builtin_amdgcn_s_sleep(1); \
    if ((++_sp & 255u) == 0u) { if (xb_ld(&(bar)[XB_TMO])) break; if (_sp > XB_SPIN_CAP) { atomicAdd(&(bar)[XB_TMO], 1u); break; } } } } while (0)
struct XcdBarrier { unsigned* bar; unsigned x; volatile LAS unsigned* st; };
__device__ __forceinline__ XcdBarrier xcd_barrier_post(unsigned* bar, volatile LAS unsigned* st) {
    XcdBarrier b; b.bar = bar; b.x = xb_xcc_id(); b.st = st;
    if (threadIdx.x == 0) (void)xb_add(&bar[XB_XCNT(b.x)], 1u);
    return b;
}
__device__ __forceinline__ void xcd_barrier_complete(unsigned* bar, unsigned x, unsigned& nloc, unsigned& nx) {
    const unsigned G = gridDim.x * gridDim.y * gridDim.z;
    unsigned sum, cnt, mine, sp = 0u;
    for (;;) {
        sum = 0u; cnt = 0u; mine = 0u;
#pragma unroll
        for (unsigned j = 0; j < 16; ++j) { const unsigned c = xb_ld(&bar[XB_XCNT(j)]); sum += c; cnt += (c > 0u) ? 1u : 0u; mine = (j == x) ? c : mine; }
        if (sum == G) break;
        __builtin_amdgcn_s_sleep(1);
        if ((++sp & 255u) == 0u) { if (xb_ld(&bar[XB_TMO])) break; if (sp > XB_SPIN_CAP) { atomicAdd(&bar[XB_TMO], 1u); break; } }
    }
    nloc = mine > 0u ? mine : 1u; nx = cnt > 0u ? cnt : 1u;
}
__device__ __forceinline__ void xcd_barrier(const XcdBarrier& b) {
    asm volatile("s_waitcnt vmcnt(0)" ::: "memory");
    __syncthreads();
    if (threadIdx.x == 0) {
        unsigned* bar = b.bar;
        __builtin_amdgcn_s_waitcnt(0);
        unsigned nloc = b.st[0], nx = b.st[1];
        if (nloc == 0u) { xcd_barrier_complete(bar, b.x, nloc, nx); b.st[0] = nloc; b.st[1] = nx; }
        const unsigned old = xb_add(&bar[XB_XSUB(b.x)], 1u);
        const unsigned gen = old / nloc;
        if (old + 1u == (gen + 1u) * nloc) {
            __builtin_amdgcn_fence(__ATOMIC_RELEASE, "agent");
            asm volatile("s_waitcnt vmcnt(0)" ::: "memory");
            const unsigned og = xb_add(&bar[XB_TOP], 1u);
            const unsigned tg = og / nx;
            if (og + 1u == (tg + 1u) * nx) xb_add(&bar[XB_TOPGEN], 1u);
            else XB_SPIN(xb_ld(&bar[XB_TOPGEN]) == tg, bar);
            __builtin_amdgcn_fence(__ATOMIC_ACQUIRE, "agent");
            asm volatile("s_waitcnt vmcnt(0)" ::: "memory");
        } else {
            XB_SPIN(xb_ld(&bar[XB_TOPGEN]) == gen, bar);
            __builtin_amdgcn_fence(__ATOMIC_ACQUIRE, "agent");
            asm volatile("s_waitcnt vmcnt(0)" ::: "memory");
        }
    }
    __syncthreads();
}

struct Args { const float* in[30]; float* out; unsigned char* ws; int ph_lo, ph_hi; };
enum { I_X = 0, I_C, I_CTX, I_CCTX, I_ADAW, I_ADAB, I_N1W, I_N2W, I_AWQKV, I_AQN, I_AKN, I_AWO, I_BWDQ, I_BQNL, I_BWUQ, I_BWDKV, I_BKVNL, I_BWUKV, I_BQN, I_BKN, I_BWO,
       I_CWQKV, I_CQN, I_CKN, I_CRPB, I_CWO, I_ROUTER, I_WG, I_WU, I_WD };
struct Frame {
    LAS unsigned char* lds; char* ldsg;
    int wave, vcu, G, gw, NGW;
    const float* const* in; float* out; unsigned char* ws;
};
__device__ __forceinline__ unsigned opq32(unsigned o) { asm volatile("" : "+v"(o)); return (unsigned)__builtin_amdgcn_readfirstlane((int)o); }
#define FWS(off, T) ((T*)(F.ws + (size_t)opq32((unsigned)(off))))
#define XB_ROW(r) ((r) < RL ? (bf16*)F.out + (size_t)(r) * 2048 + 1024 : FWS(WS_XC, bf16) + (size_t)((r) - RL) * 1024)
__device__ __forceinline__ f32x4 bf4_to_f32(u32x2 q) { return (f32x4){__builtin_bit_cast(float, q.x << 16), __builtin_bit_cast(float, q.x & 0xffff0000u), __builtin_bit_cast(float, q.y << 16), __builtin_bit_cast(float, q.y & 0xffff0000u)}; }
#define PHASE_IDS() int tid_ = threadIdx.x; asm volatile("" : "+v"(tid_)); const int tid = tid_, lane = tid & 63; (void)lane

struct WSrc { const float* W; int ld; int col0; int perm; const float* ks; };
struct PrepJob { WSrc s; int K, G, kb; bf16* Bt; };
__device__ __forceinline__ PrepJob prep_decode(const float* const* in, unsigned char* ws, int it) {
    constexpr int J0 = 768, J1 = J0 + 768, J2 = J1 + 512, J3 = J2 + 512, J4 = J3 + 384, J5 = J4 + 288, J6 = J5 + 256, J7 = J6 + 512, J8 = J7 + 1536, J9 = J8 + 512;
    constexpr int NSMALL = J9;
    bf16* WSB = (bf16*)(ws + WS_WS);
    PrepJob j; WSrc& s = j.s; s.ks = nullptr; s.perm = 1; j.K = 1024; int G, kb; bf16* Bt;
    if (it >= NSMALL) {
        int r = it - NSMALL; const int l = r / 24576; r -= l * 24576;
        if (r < 16384) { G = r >> 4; kb = r & 15; const int e = G >> 6, g = G & 63, pn = g >> 3, bj = (g >> 2) & 1, wc = g & 3;
            s.W = (bj ? in[I_WU] : in[I_WG]) + (size_t)(l * 16 + e) * 1048576; s.ld = 1024; s.col0 = 128 * pn + 32 * wc; Bt = (bf16*)(ws + WS_WMOE + (size_t)l * 96 * MiB); }
        else { r -= 16384; G = r >> 4; kb = r & 15; const int e = G >> 5, g = G & 31;
            s.W = in[I_WD] + (size_t)(l * 16 + e) * 1048576; s.ld = 1024; s.col0 = 32 * g; Bt = (bf16*)(ws + WS_WMOE + (size_t)l * 96 * MiB + 64 * MiB); }
    } else if (it < J1) { const int inst = it >= J0; const int r = it - inst * J0; G = r >> 4; kb = r & 15; const int pn = G >> 3, bj = (G >> 2) & 1, wc = G & 3;
        s.W = in[I_AWQKV] + (size_t)inst * 1024 * 1536; s.ld = 1536; s.col0 = 64 * (4 * pn + wc) + 32 * bj; Bt = WSB + (inst ? WO_AQKV1 : WO_AQKV0) / 2; }
    else if (it < J3) { const int inst = it >= J2; const int r = it - (inst ? J2 : J1); G = r >> 4; kb = r & 15;
        s.W = in[I_AWO] + (size_t)inst * 1048576; s.ld = 1024; s.col0 = 32 * G; Bt = WSB + (inst ? WO_AWO1 : WO_AWO0) / 2; }
    else if (it < J4) { const int r = it - J3; G = r >> 4; kb = r & 15; Bt = WSB + WO_BDN / 2;
        if (G < 12) { s.W = in[I_BWDQ]; s.ld = 384; s.col0 = 32 * G; }
        else if (G == 12) { s.W = in[I_BWDKV]; s.ld = 288; s.col0 = 256; s.perm = 0; }
        else if (G < 16) { s.W = nullptr; s.ld = 0; s.col0 = 0; }
        else { s.W = in[I_BWDKV]; s.ld = 288; s.col0 = 32 * (G - 16); } }
    else if (it < J5) { const int r = it - J4; G = r / 6; kb = r % 6; j.K = 384; Bt = WSB + WO_BUQ / 2; s.W = in[I_BWUQ]; s.ld = 1536; s.ks = in[I_BQNL];
        if (G < 32) { const int pn = G >> 3, bj = (G >> 2) & 1, wc = G & 3; s.col0 = 96 * (4 * pn + wc) + 32 * bj; }
        else { const int g = G - 32, pn = g >> 3, bj = (g >> 2) & 1, wc = g & 3; s.col0 = 96 * (8 * pn + 4 * bj + wc) + 64; s.perm = 0; } }
    else if (it < J6) { const int r = it - J5; G = r >> 2; kb = r & 3; j.K = 256; Bt = WSB + WO_BUKV / 2; s.W = in[I_BWUKV]; s.ld = 2048; s.ks = in[I_BKVNL];
        if (G < 32) { const int pn = G >> 3, bj = (G >> 2) & 1, wc = G & 3; s.col0 = 128 * (4 * pn + wc) + 32 * bj; }
        else { const int g = G - 32, pn = g >> 3, bj = (g >> 2) & 1, wc = g & 3; s.col0 = 128 * (4 * pn + wc) + 64 + 32 * bj; } }
    else if (it < J7) { const int r = it - J6; G = r >> 4; kb = r & 15; s.W = in[I_BWO]; s.ld = 1024; s.col0 = 32 * G; Bt = WSB + WO_BWO / 2; }
    else if (it < J8) { const int r = it - J7; G = r >> 4; kb = r & 15; const int pn = G >> 3, bj = (G >> 2) & 1, wc = G & 3;
        s.W = in[I_CWQKV]; s.ld = 3072; s.col0 = 64 * (4 * pn + wc) + 32 * bj; Bt = WSB + WO_CQKV / 2; }
    else { const int r = it - J8; G = r >> 4; kb = r & 15; s.W = in[I_CWO]; s.ld = 1024; s.col0 = 32 * G; Bt = WSB + WO_CWO / 2; }
    j.G = G; j.kb = kb; j.Bt = Bt; return j;
}
__device__ __forceinline__ void prep_load(const PrepJob& j, f32x4 (&v)[8], int lane) {
    const int k0 = 64 * j.kb;
#pragma unroll
    for (int i = 0; i < 8; ++i) { const int kk = 8 * i + (lane >> 3);
        if (j.s.W) { f32x4 x = *(const f32x4*)(j.s.W + (size_t)(k0 + kk) * j.s.ld + j.s.col0 + 4 * (lane & 7)); if (j.s.ks) x = x * j.s.ks[k0 + kk]; v[i] = x; }
        else v[i] = (f32x4){0.f, 0.f, 0.f, 0.f}; }
}
__device__ __forceinline__ void prep_store(const PrepJob& j, const f32x4 (&v)[8], LAS float* scr, int lane) {
    const int k0 = 64 * j.kb;
#pragma unroll
    for (int i = 0; i < 8; ++i) { const int kk = 8 * i + (lane >> 3); LAS float* d = scr + kk * 33 + 4 * (lane & 7); d[0] = v[i][0]; d[1] = v[i][1]; d[2] = v[i][2]; d[3] = v[i][3]; }
    LDS_WAIT(); asm volatile("" ::: "memory");
    const int c = lane & 7;
#pragma unroll
    for (int q = 0; q < 4; ++q) { const int n = (lane >> 3) + 8 * q; const int sn = j.s.perm ? pg8::perm32(n) : n; const LAS float* sp = scr + (8 * c) * 33 + sn;
        u32x4 o; o.x = cvt_pk_bf16(sp[0 * 33], sp[1 * 33]); o.y = cvt_pk_bf16(sp[2 * 33], sp[3 * 33]); o.z = cvt_pk_bf16(sp[4 * 33], sp[5 * 33]); o.w = cvt_pk_bf16(sp[6 * 33], sp[7 * 33]);
        *(u32x4*)(j.Bt + (size_t)(32 * j.G + n) * j.K + k0 + 8 * c) = o; }
    LDS_WAIT(); asm volatile("" ::: "memory");
}
__device__ __forceinline__ void p0_prologue(Frame& F) {
    PHASE_IDS();
    const float* const* in = F.in;
    {
        LAS float* sv = (LAS float*)F.lds;
        float* MODP = FWS(WS_MODP, float);
        for (int it = blockIdx.x; it < 4 * 12 * 8; it += F.G) {
            const int kc = it & 7, nb = (it >> 3) % 12, l = it / 96;
            for (int u = tid; u < 17 * 128; u += NTHR) { const int bi = u >> 7, k = kc * 128 + (u & 127); const float cv = bi < 16 ? in[I_C][bi * 1024 + k] : in[I_CCTX][k]; sv[u] = cv / (1.f + expf(-cv)); }
            __syncthreads();
            const int n = nb * 512 + tid; const float* W = in[I_ADAW] + ((size_t)l * 1024 + kc * 128) * 6144 + n;
            float acc[17];
#pragma unroll
            for (int bi = 0; bi < 17; ++bi) acc[bi] = 0.f;
            for (int k8 = 0; k8 < 128; k8 += 16) {
                float w[16];
#pragma unroll
                for (int k = 0; k < 16; ++k) w[k] = W[(size_t)(k8 + k) * 6144];
#pragma unroll
                for (int k = 0; k < 16; ++k)
#pragma unroll
                    for (int bi = 0; bi < 17; ++bi) acc[bi] += sv[bi * 128 + k8 + k] * w[k];
            }
#pragma unroll
            for (int bi = 0; bi < 17; ++bi) MODP[((size_t)(kc * 4 + l) * 17 + bi) * 6144 + n] = acc[bi];
            __syncthreads();
        }
    }
    {
        LAS float* scr = (LAS float*)(F.lds + F.wave * 8448);
        constexpr int NITEMS = 6048;
        for (int base = F.gw; base < NITEMS; base += 4 * F.NGW) {
            PrepJob j0 = prep_decode(in, F.ws, base), j1, j2, j3; const int i1 = base + F.NGW, i2 = base + 2 * F.NGW, i3 = base + 3 * F.NGW;
            const bool h1 = i1 < NITEMS, h2 = i2 < NITEMS, h3 = i3 < NITEMS;
            f32x4 v0[8], v1[8], v2[8], v3[8];
            prep_load(j0, v0, lane);
            if (h1) { j1 = prep_decode(in, F.ws, i1); prep_load(j1, v1, lane); }
            if (h2) { j2 = prep_decode(in, F.ws, i2); prep_load(j2, v2, lane); }
            if (h3) { j3 = prep_decode(in, F.ws, i3); prep_load(j3, v3, lane); }
            prep_store(j0, v0, scr, lane);
            if (h1) prep_store(j1, v1, scr, lane);
            if (h2) prep_store(j2, v2, scr, lane);
            if (h3) prep_store(j3, v3, scr, lane);
        }
    }
    {
        float* RA = FWS(WS_ROPE, float); float* RB = RA + 2 * 2048 * 32;
        const int gt = F.gw * 64 + lane, NT_ = F.NGW * 64;
        for (int i = gt; i < 2048 * 32; i += NT_) { const int t = i >> 5, d = i & 31; const float inv = powf(10000.f, -(float)(d & 15) / 16.f); const float pos = (float)(d < 16 ? (t >> 6) : (t & 63));
            const float a = pos * inv; RA[i] = cosf(a); RA[2048 * 32 + i] = sinf(a); }
        for (int i = gt; i < 2048 * 16; i += NT_) { const int t = i >> 4, d = i & 15; const float inv = powf(10000.f, -(float)(d & 7) / 8.f); const float pos = (float)(d < 8 ? (t >> 6) : (t & 63));
            const float a = pos * inv; RB[i] = cosf(a); RB[2048 * 16 + i] = sinf(a); }
    }
}
__device__ __forceinline__ void p1_modreduce(Frame& F) {
    PHASE_IDS();
    const float* MODP = FWS(WS_MODP, float); float* MOD = FWS(WS_MOD, float);
    const int gt = F.gw * 64 + lane, NT_ = F.NGW * 64;
    for (int i = gt; i < 4 * 17 * 6144; i += NT_) {
        const int l = i / (17 * 6144), rem = i - l * 17 * 6144, bi = rem / 6144, n = rem - bi * 6144;
        float v = F.in[I_ADAB][l * 6144 + n];
#pragma unroll
        for (int kc = 0; kc < 8; ++kc) v += MODP[((size_t)(kc * 4 + l) * 17 + bi) * 6144 + n];
        const int ch = n >> 10, nn = n & 1023;
        if (ch == 1) v = F.in[I_N1W][l * 1024 + nn] * (1.f + v);
        if (ch == 4) v = F.in[I_N2W][l * 1024 + nn] * (1.f + v);
        MOD[i] = v;
    }
}

__device__ __forceinline__ int slot_of(int row, int e, int s) { return e * SLOTS_E + (row < RL ? (row >> 11) * 256 + s : 4096 + ((row - RL) >> 8) * 32 + s); }
__device__ __forceinline__ void gather_y2(const bf16* Y, int r0, int r1, int inv0, int inv1, bool ok1, int lane, f32x4 (&a0)[4], f32x4 (&a1)[4]) {
    unsigned m0 = (unsigned)__ballot(lane < 16 && inv0 >= 0) & 0xffffu, m1 = ok1 ? ((unsigned)__ballot(lane < 16 && inv1 >= 0) & 0xffffu) : 0u;
    while (m0 | m1) {
        const bool h0 = m0 != 0u, h1 = m1 != 0u;
        const int e0 = h0 ? __builtin_ctz(m0) : 0, e1 = h1 ? __builtin_ctz(m1) : 0;
        m0 &= m0 - 1u; m1 &= m1 - 1u;
        const int s0 = __builtin_amdgcn_readlane(inv0, e0), s1 = __builtin_amdgcn_readlane(inv1, e1);
        const int sl0 = h0 ? slot_of(r0, e0, s0) : 0, sl1 = h1 ? slot_of(r1, e1, s1) : 0;
        const float w0 = h0 ? 1.f : 0.f, w1 = h1 ? 1.f : 0.f;
        const bf16* y0 = Y + (size_t)sl0 * 1024 + 4 * lane; const bf16* y1 = Y + (size_t)sl1 * 1024 + 4 * lane;
        u32x2 q0[4], q1[4];
#pragma unroll
        for (int j = 0; j < 4; ++j) { q0[j] = *(const u32x2*)(y0 + 256 * j); q1[j] = *(const u32x2*)(y1 + 256 * j); }
#pragma unroll
        for (int j = 0; j < 4; ++j) {
            a0[j][0] += w0 * bf2f(q0[j].x & 0xffffu); a0[j][1] += w0 * bf2f(q0[j].x >> 16); a0[j][2] += w0 * bf2f(q0[j].y & 0xffffu); a0[j][3] += w0 * bf2f(q0[j].y >> 16);
            a1[j][0] += w1 * bf2f(q1[j].x & 0xffffu); a1[j][1] += w1 * bf2f(q1[j].x >> 16); a1[j][2] += w1 * bf2f(q1[j].y & 0xffffu); a1[j][3] += w1 * bf2f(q1[j].y >> 16);
        }
    }
}
template <int L> __device__ __forceinline__ void norm1_phase(Frame& F) {
    PHASE_IDS();
    const float* MOD = FWS(WS_MOD, float); bf16* H = FWS(WS_H, bf16); const int* INV = FWS(WS_INV, int); const bf16* Y = FWS(WS_ACT + AO_Y, bf16); float* XC = FWS(WS_XC, float);
    const bf16* WOUT = FWS(WS_WOUT, bf16);
    for (int rb = F.gw; rb < RT; rb += 2 * F.NGW) {
        const int r0 = rb, r1c = rb + F.NGW; const bool ok1 = r1c < RT; const int r1 = ok1 ? r1c : rb;
        const int bi0 = r0 < RL ? (r0 >> 11) : 16, bi1 = r1 < RL ? (r1 >> 11) : 16;
        f32x4 v0[4], v1[4];
        if (L <= 1) {
            const float* xs0 = r0 < RL ? F.in[I_X] + (size_t)r0 * D : F.in[I_CTX] + (size_t)(r0 - RL) * D;
            const float* xs1 = r1 < RL ? F.in[I_X] + (size_t)r1 * D : F.in[I_CTX] + (size_t)(r1 - RL) * D;
#pragma unroll
            for (int j = 0; j < 4; ++j) { v0[j] = *(const f32x4*)(xs0 + 4 * lane + 256 * j); v1[j] = *(const f32x4*)(xs1 + 4 * lane + 256 * j); }
        } else {
            const bf16* xs0 = XB_ROW(r0); const bf16* xs1 = XB_ROW(r1);
            u32x2 q0[4], q1[4];
#pragma unroll
            for (int j = 0; j < 4; ++j) { q0[j] = *(const u32x2*)(xs0 + 4 * lane + 256 * j); q1[j] = *(const u32x2*)(xs1 + 4 * lane + 256 * j); }
#pragma unroll
            for (int j = 0; j < 4; ++j) { v0[j] = bf4_to_f32(q0[j]); v1[j] = bf4_to_f32(q1[j]); }
        }
        if (L > 0) {
            const int inv0 = INV[(size_t)r0 * 16 + (lane & 15)], inv1 = INV[(size_t)r1 * 16 + (lane & 15)];
            f32x4 a0[4], a1[4];
#pragma unroll
            for (int j = 0; j < 4; ++j) { a0[j] = (f32x4){0.f, 0.f, 0.f, 0.f}; a1[j] = (f32x4){0.f, 0.f, 0.f, 0.f}; }
            u32x2 wq0[4], wq1[4];
#pragma unroll
            for (int j = 0; j < 4; ++j) { wq0[j] = *(const u32x2*)(WOUT + (size_t)r0 * D + 4 * lane + 256 * j); wq1[j] = *(const u32x2*)(WOUT + (size_t)r1 * D + 4 * lane + 256 * j); }
            gather_y2(Y, r0, r1, inv0, inv1, ok1, lane, a0, a1);
            const float* m50 = MOD + ((size_t)(L - 1) * 17 + bi0) * 6144 + 5 * 1024 + 4 * lane; const float* m51 = MOD + ((size_t)(L - 1) * 17 + bi1) * 6144 + 5 * 1024 + 4 * lane;
            bf16* xd0 = XB_ROW(r0); bf16* xd1 = XB_ROW(r1);
#pragma unroll
            for (int j = 0; j < 4; ++j) { const f32x4 w = (f32x4){bf2f(wq0[j].x & 0xffffu), bf2f(wq0[j].x >> 16), bf2f(wq0[j].y & 0xffffu), bf2f(wq0[j].y >> 16)};
                v0[j] += w + *(const f32x4*)(m50 + 256 * j) * a0[j]; u32x2 xw; xw.x = cvt_pk_bf16(v0[j][0], v0[j][1]); xw.y = cvt_pk_bf16(v0[j][2], v0[j][3]); *(u32x2*)(xd0 + 4 * lane + 256 * j) = xw; }
            if (ok1) {
#pragma unroll
                for (int j = 0; j < 4; ++j) { const f32x4 w = (f32x4){bf2f(wq1[j].x & 0xffffu), bf2f(wq1[j].x >> 16), bf2f(wq1[j].y & 0xffffu), bf2f(wq1[j].y >> 16)};
                    v1[j] += w + *(const f32x4*)(m51 + 256 * j) * a1[j]; u32x2 xw; xw.x = cvt_pk_bf16(v1[j][0], v1[j][1]); xw.y = cvt_pk_bf16(v1[j][2], v1[j][3]); *(u32x2*)(xd1 + 4 * lane + 256 * j) = xw; } }
        }
        const float ss0 = (sum4sq(v0[0]) + sum4sq(v0[1])) + (sum4sq(v0[2]) + sum4sq(v0[3])), ss1 = (sum4sq(v1[0]) + sum4sq(v1[1])) + (sum4sq(v1[2]) + sum4sq(v1[3]));
        const float rinv0 = rsqrtf(wave_sum(ss0) * (1.f / D) + EPS), rinv1 = rsqrtf(wave_sum(ss1) * (1.f / D) + EPS);
        const float* ml0 = MOD + ((size_t)L * 17 + bi0) * 6144 + 4 * lane; const float* ml1 = MOD + ((size_t)L * 17 + bi1) * 6144 + 4 * lane;
        bf16* hp0 = H + (size_t)r0 * D + 4 * lane; bf16* hp1 = H + (size_t)r1 * D + 4 * lane;
#pragma unroll
        for (int j = 0; j < 4; ++j) { const f32x4 sh = *(const f32x4*)(ml0 + 256 * j), a1_ = *(const f32x4*)(ml0 + 1024 + 256 * j); const f32x4 h = v0[j] * rinv0 * a1_ + sh;
            u32x2 w; w.x = cvt_pk_bf16(h[0], h[1]); w.y = cvt_pk_bf16(h[2], h[3]); *(u32x2*)(hp0 + 256 * j) = w; }
        if (ok1) {
#pragma unroll
            for (int j = 0; j < 4; ++j) { const f32x4 sh = *(const f32x4*)(ml1 + 256 * j), a1_ = *(const f32x4*)(ml1 + 1024 + 256 * j); const f32x4 h = v1[j] * rinv1 * a1_ + sh;
                u32x2 w; w.x = cvt_pk_bf16(h[0], h[1]); w.y = cvt_pk_bf16(h[2], h[3]); *(u32x2*)(hp1 + 256 * j) = w; } }
    }
}
__device__ __forceinline__ void final_phase(Frame& F) {
    PHASE_IDS();
    const float* MOD = FWS(WS_MOD, float); const int* INV = FWS(WS_INV, int); const bf16* Y = FWS(WS_ACT + AO_Y, bf16);
    for (int rb = F.gw; rb < RL; rb += 2 * F.NGW) {
        const int r0 = rb, r1c = rb + F.NGW; const bool ok1 = r1c < RL; const int r1 = ok1 ? r1c : rb;
        float* xs0 = F.out + (size_t)r0 * D; float* xs1 = F.out + (size_t)r1 * D;
        f32x4 v0[4], v1[4];
        { const bf16* xb0 = XB_ROW(r0); const bf16* xb1 = XB_ROW(r1); u32x2 q0[4], q1[4];
#pragma unroll
          for (int j = 0; j < 4; ++j) { q0[j] = *(const u32x2*)(xb0 + 4 * lane + 256 * j); q1[j] = *(const u32x2*)(xb1 + 4 * lane + 256 * j); }
#pragma unroll
          for (int j = 0; j < 4; ++j) { v0[j] = bf4_to_f32(q0[j]); v1[j] = bf4_to_f32(q1[j]); } }
        const int inv0 = INV[(size_t)r0 * 16 + (lane & 15)], inv1 = INV[(size_t)r1 * 16 + (lane & 15)];
        f32x4 a0[4], a1[4];
#pragma unroll
        for (int j = 0; j < 4; ++j) { a0[j] = (f32x4){0.f, 0.f, 0.f, 0.f}; a1[j] = (f32x4){0.f, 0.f, 0.f, 0.f}; }
        const bf16* WOUT = FWS(WS_WOUT, bf16);
        u32x2 wq0[4], wq1[4];
#pragma unroll
        for (int j = 0; j < 4; ++j) { wq0[j] = *(const u32x2*)(WOUT + (size_t)r0 * D + 4 * lane + 256 * j); wq1[j] = *(const u32x2*)(WOUT + (size_t)r1 * D + 4 * lane + 256 * j); }
        gather_y2(Y, r0, r1, inv0, inv1, ok1, lane, a0, a1);
        const float* m50 = MOD + ((size_t)3 * 17 + (r0 >> 11)) * 6144 + 5 * 1024 + 4 * lane; const float* m51 = MOD + ((size_t)3 * 17 + (r1 >> 11)) * 6144 + 5 * 1024 + 4 * lane;
        asm volatile("s_waitcnt vmcnt(0)" ::: "memory");
#pragma unroll
        for (int j = 0; j < 4; ++j) { const f32x4 w = (f32x4){bf2f(wq0[j].x & 0xffffu), bf2f(wq0[j].x >> 16), bf2f(wq0[j].y & 0xffffu), bf2f(wq0[j].y >> 16)};
            *(f32x4*)(xs0 + 4 * lane + 256 * j) = v0[j] + w + *(const f32x4*)(m50 + 256 * j) * a0[j]; }
        if (ok1) {
#pragma unroll
            for (int j = 0; j < 4; ++j) { const f32x4 w = (f32x4){bf2f(wq1[j].x & 0xffffu), bf2f(wq1[j].x >> 16), bf2f(wq1[j].y & 0xffffu), bf2f(wq1[j].y >> 16)};
                *(f32x4*)(xs1 + 4 * lane + 256 * j) = v1[j] + w + *(const f32x4*)(m51 + 256 * j) * a1[j]; } }
    }
}
__device__ __forceinline__ float red16(const float (&lg)[16], int lane) {
    const bool b5 = lane & 32, b4 = lane & 16, b3 = lane & 8, b2 = lane & 4;
    float t8[8], t4[4], t2[2];
#pragma unroll
    for (int j = 0; j < 8; ++j) { const float snd = b5 ? lg[j] : lg[j + 8], kp = b5 ? lg[j + 8] : lg[j]; t8[j] = kp + __shfl_xor(snd, 32); }
#pragma unroll
    for (int j = 0; j < 4; ++j) { const float snd = b4 ? t8[j] : t8[j + 4], kp = b4 ? t8[j + 4] : t8[j]; t4[j] = kp + __shfl_xor(snd, 16); }
#pragma unroll
    for (int j = 0; j < 2; ++j) { const float snd = b3 ? t4[j] : t4[j + 2], kp = b3 ? t4[j + 2] : t4[j]; t2[j] = kp + __shfl_xor(snd, 8); }
    float t1; { const float snd = b2 ? t2[0] : t2[1], kp = b2 ? t2[1] : t2[0]; t1 = kp + __shfl_xor(snd, 4); }
    t1 += __shfl_xor(t1, 2); t1 += __shfl_xor(t1, 1);
    return t1;
}
template <int L> __device__ __forceinline__ void norm2_phase(Frame& F, int NR) {
    PHASE_IDS();
    const float* MOD = FWS(WS_MOD, float); bf16* H = FWS(WS_H, bf16); float* AFF = FWS(WS_AFF, float); const float* XC = FWS(WS_XC, float); const bf16* WOUT = FWS(WS_WOUT, bf16);
    LAS float* RL_ = (LAS float*)F.lds;
    const float* rt = F.in[I_ROUTER] + (size_t)L * 1024 * 16;
    unsigned xa[16], xb[16]; unsigned wa[16], wb[16];
#define N2_LOAD(rbase) do { const int q0_ = (rbase), q1c_ = (rbase) + F.NGW; const int q1_ = q1c_ < NR ? q1c_ : q0_; \
        const bf16* w0_ = WOUT + (size_t)q0_ * D + lane; const bf16* w1_ = WOUT + (size_t)q1_ * D + lane; \
        if (L == 0) { \
            const float* s0_ = (q0_ < RL ? F.in[I_X] + (size_t)q0_ * D : F.in[I_CTX] + (size_t)(q0_ - RL) * D) + lane; \
            const float* s1_ = (q1_ < RL ? F.in[I_X] + (size_t)q1_ * D : F.in[I_CTX] + (size_t)(q1_ - RL) * D) + lane; \
            _Pragma("unroll") for (int i = 0; i < 16; ++i) { xa[i] = __float_as_uint(s0_[64 * i]); wa[i] = (unsigned)((const unsigned short*)w0_)[64 * i]; xb[i] = __float_as_uint(s1_[64 * i]); wb[i] = (unsigned)((const unsigned short*)w1_)[64 * i]; } \
        } else { \
            const unsigned short* s0_ = (const unsigned short*)XB_ROW(q0_) + lane; const unsigned short* s1_ = (const unsigned short*)XB_ROW(q1_) + lane; \
            _Pragma("unroll") for (int i = 0; i < 16; ++i) { xa[i] = (unsigned)s0_[64 * i]; wa[i] = (unsigned)((const unsigned short*)w0_)[64 * i]; xb[i] = (unsigned)s1_[64 * i]; wb[i] = (unsigned)((const unsigned short*)w1_)[64 * i]; } \
        } } while (0)
    if (F.gw < NR) N2_LOAD(F.gw);
    for (int u = tid; u < 4096; u += NTHR) { const f32x4 w = *(const f32x4*)(rt + 4 * u); *(LAS f32x4*)(RL_ + (u >> 2) * 20 + (u & 3) * 4) = w; }
    __syncthreads();
    for (int rb = F.gw; rb < NR; rb += 2 * F.NGW) {
        const int r0 = rb, r1c = rb + F.NGW; const bool ok1 = r1c < NR; const int r1 = ok1 ? r1c : rb;
        const int bi0 = r0 < RL ? (r0 >> 11) : 16, bi1 = r1 < RL ? (r1 >> 11) : 16;
        const float* ml0 = MOD + ((size_t)L * 17 + bi0) * 6144 + 3 * 1024 + lane; const float* ml1 = MOD + ((size_t)L * 17 + bi1) * 6144 + 3 * 1024 + lane;
        float x0[16], x1[16];
        bf16* hp0 = H + (size_t)r0 * D + lane; bf16* hp1 = H + (size_t)r1 * D + lane;
#pragma unroll
        for (int i = 0; i < 16; ++i) { x0[i] = __uint_as_float(L == 0 ? xa[i] : xa[i] << 16) + __uint_as_float(wa[i] << 16); x1[i] = __uint_as_float(L == 0 ? xb[i] : xb[i] << 16) + __uint_as_float(wb[i] << 16); }
        __builtin_amdgcn_sched_barrier(0);
        {
            float sa[16], sh[16], ss = 0.f;
#pragma unroll
            for (int i = 0; i < 16; ++i) { sa[i] = ml0[1024 + 64 * i]; sh[i] = ml0[64 * i]; }
#pragma unroll
            for (int i = 0; i < 16; ++i) ss += x0[i] * x0[i];
            const float rinv = rsqrtf(wave_sum(ss) * (1.f / D) + EPS);
#pragma unroll
            for (int i = 0; i < 16; ++i) { x0[i] = x0[i] * rinv * sa[i] + sh[i]; hp0[64 * i] = (bf16)f2bf(x0[i]); }
        }
        __builtin_amdgcn_sched_barrier(0);
        {
            float sa[16], sh[16], ss = 0.f;
#pragma unroll
            for (int i = 0; i < 16; ++i) { sa[i] = ml1[1024 + 64 * i]; sh[i] = ml1[64 * i]; }
#pragma unroll
            for (int i = 0; i < 16; ++i) ss += x1[i] * x1[i];
            const float rinv = rsqrtf(wave_sum(ss) * (1.f / D) + EPS);
#pragma unroll
            for (int i = 0; i < 16; ++i) { x1[i] = x1[i] * rinv * sa[i] + sh[i]; if (ok1) hp1[64 * i] = (bf16)f2bf(x1[i]); }
        }
        __builtin_amdgcn_sched_barrier(0);
        if (rb + 2 * F.NGW < NR) N2_LOAD(rb + 2 * F.NGW);
        __builtin_amdgcn_sched_barrier(0);
        float lga[16], lgb[16];
#pragma unroll
        for (int e = 0; e < 16; ++e) { lga[e] = 0.f; lgb[e] = 0.f; }
#pragma unroll
        for (int i = 0; i < 16; ++i) {
            const LAS float* rr = RL_ + (lane + 64 * i) * 20; const float xa = x0[i], xb = x1[i];
#pragma unroll
            for (int q = 0; q < 4; ++q) { const f32x4 w = *(const LAS f32x4*)(rr + 4 * q);
#pragma unroll
                for (int c = 0; c < 4; ++c) { lga[4 * q + c] += xa * w[c]; lgb[4 * q + c] += xb * w[c]; } }
            asm volatile("" : "+v"(lga[0]), "+v"(lga[1]), "+v"(lga[2]), "+v"(lga[3]), "+v"(lga[4]), "+v"(lga[5]), "+v"(lga[6]), "+v"(lga[7]), "+v"(lga[8]), "+v"(lga[9]), "+v"(lga[10]), "+v"(lga[11]), "+v"(lga[12]), "+v"(lga[13]), "+v"(lga[14]), "+v"(lga[15]) :: "memory");
            asm volatile("" : "+v"(lgb[0]), "+v"(lgb[1]), "+v"(lgb[2]), "+v"(lgb[3]), "+v"(lgb[4]), "+v"(lgb[5]), "+v"(lgb[6]), "+v"(lgb[7]), "+v"(lgb[8]), "+v"(lgb[9]), "+v"(lgb[10]), "+v"(lgb[11]), "+v"(lgb[12]), "+v"(lgb[13]), "+v"(lgb[14]), "+v"(lgb[15]) :: "memory");
        }
#pragma unroll
        for (int rr_ = 0; rr_ < 2; ++rr_) {
            const float t = rr_ ? red16(lgb, lane) : red16(lga, lane);
            float mx = t;
#pragma unroll
            for (int o = 4; o < 64; o <<= 1) mx = fmaxf(mx, __shfl_xor(mx, o));
            const float p = expf(t - mx);
            float sm = p;
#pragma unroll
            for (int o = 4; o < 64; o <<= 1) sm += __shfl_xor(sm, o);
            if ((lane & 3) == 0 && (rr_ == 0 || ok1)) AFF[(size_t)(rr_ ? r1 : r0) * 16 + (lane >> 2)] = p / sm;
        }
    }
}
#undef N2_LOAD
__device__ __forceinline__ void topk_phase(Frame& F, bool with_ctx) {
    PHASE_IDS();
    const float* AFF = FWS(WS_AFF, float); int* INV = FWS(WS_INV, int); int* GIDX = FWS(WS_GIDX, int); float* GATE = FWS(WS_GATE, float);
    volatile LAS int* sm = (volatile LAS int*)F.lds;
    for (int q = blockIdx.x; q < 256; q += F.G) {
        const int b = q >> 4, e = q & 15;
        unsigned key[5];
#pragma unroll
        for (int j = 0; j < 4; ++j) key[j] = __float_as_uint(AFF[(size_t)(b * 2048 + 4 * tid + j) * 16 + e]);
        key[4] = (with_ctx && tid < 256) ? __float_as_uint(AFF[(size_t)(RL + b * 256 + tid) * 16 + e]) : 0u;
        unsigned prefix0 = 0u, prefix1 = 0u;
        for (int bit = 29; bit >= 0; --bit) {
            const unsigned cand0 = prefix0 | (1u << bit), cand1 = prefix1 | (1u << bit);
            int c0 = 0;
#pragma unroll
            for (int j = 0; j < 4; ++j) c0 += __builtin_popcountll(__ballot(key[j] >= cand0));
            const int c1 = __builtin_popcountll(__ballot(key[4] >= cand1));
            if (lane == 0) { sm[(bit & 1) * 16 + F.wave] = c0; sm[(bit & 1) * 16 + 8 + F.wave] = c1; }
            __syncthreads();
            typedef int i32x4_t __attribute__((ext_vector_type(4)));
            const LAS i32x4_t* cv_ = (const LAS i32x4_t*)(F.lds + ((bit & 1) * 16) * 4);
            const i32x4_t a0_ = cv_[0], a1_ = cv_[1], b0_ = cv_[2], b1_ = cv_[3];
            const int tot0 = ((a0_[0] + a0_[1]) + (a0_[2] + a0_[3])) + ((a1_[0] + a1_[1]) + (a1_[2] + a1_[3]));
            const int tot1 = ((b0_[0] + b0_[1]) + (b0_[2] + b0_[3])) + ((b1_[0] + b1_[1]) + (b1_[2] + b1_[3]));
            if (tot0 >= 256) prefix0 = cand0;
            if (tot1 >= 32) prefix1 = cand1;
        }
#pragma unroll 1
        for (int part = 0; part < (with_ctx ? 2 : 1); ++part) {
            const bool lat = part == 0; const unsigned prefix = lat ? prefix0 : prefix1;
            const int cap = lat ? 256 : 32, rowbase = lat ? b * 2048 : RL + b * 256, slotbase = e * SLOTS_E + (lat ? b * 256 : 4096 + b * 32);
            int cg = 0, cq = 0;
#pragma unroll
            for (int j = 0; j < 4; ++j) { const unsigned k = lat ? key[j] : (j == 0 ? key[4] : 0u); const bool ok = lat || (j == 0 && tid < 256); cg += ok && k > prefix; cq += ok && k == prefix; }
            const int v = cg | (cq << 16);
            int x = v;
#pragma unroll
            for (int o = 1; o < 64; o <<= 1) { const int y = __shfl_up(x, o); if (lane >= o) x += y; }
            if (lane == 63) sm[64 + part * 8 + F.wave] = x;
            __syncthreads();
            int wp = 0, total = 0;
#pragma unroll
            for (int w = 0; w < 8; ++w) { const int tv = sm[64 + part * 8 + w]; total += tv; if (w < F.wave) wp += tv; }
            const int excl = x - v + wp, n_gt = total & 0xffff, need_eq = cap - n_gt;
            int eg = excl & 0xffff, eq = excl >> 16;
#pragma unroll
            for (int j = 0; j < 4; ++j) {
                const int t = lat ? 4 * tid + j : tid; const bool ok = lat || (j == 0 && tid < 256); const unsigned k = lat ? key[j] : key[4];
                if (ok) { int pos = -1;
                    if (k > prefix) pos = eg++;
                    else if (k == prefix) { if (eq < need_eq) pos = n_gt + eq; ++eq; }
                    INV[(size_t)(rowbase + t) * 16 + e] = pos;
                    if (pos >= 0) { GIDX[slotbase + pos] = rowbase + t; GATE[slotbase + pos] = __uint_as_float(k); } }
            }
        }
        __syncthreads();
    }
}

__device__ __forceinline__ void attn_map(int vcu, int i, int& bh, int& qb) { bh = (vcu & ~31) + 4 * i + ((vcu & 31) >> 3); qb = vcu & 7; }
__device__ __forceinline__ void conv_chunk(Frame& F, int first_item, int count) {
    int tid_ = threadIdx.x; asm volatile("" : "+v"(tid_)); const int lane = tid_ & 63;
    LAS float* scr = (LAS float*)(F.lds + F.wave * 8448);
    const int first = 6048 + first_item;
#pragma unroll 1
    for (int base = F.gw; base < count; base += 2 * F.NGW) {
        const int i1 = base + F.NGW; const bool h1 = i1 < count;
        PrepJob j0 = prep_decode(F.in, F.ws, first + base), j1 = prep_decode(F.in, F.ws, first + (h1 ? i1 : base));
        f32x4 v0[8], v1[8];
        prep_load(j0, v0, lane); prep_load(j1, v1, lane);
        prep_store(j0, v0, scr, lane);
        if (h1) prep_store(j1, v1, scr, lane);
    }
    asm volatile("s_waitcnt vmcnt(0) lgkmcnt(0)" ::: "memory");
    __syncthreads();
}
__device__ __forceinline__ void attn_mla_phase(Frame& F, bool need_ctx, int L) {
    typedef attn_body::bf16 abf;
    const bf16* Q = FWS(WS_ACT + AO_Q, bf16); const bf16* K = FWS(WS_ACT + AO_K, bf16); const bf16* V = FWS(WS_ACT + AO_V, bf16); bf16* O = FWS(WS_ACT + AO_O, bf16);
    if (F.G != 256) return;
    attn_body::bf16x8 qr[6]; int s0 = 0; bool pre = false; const int n = need_ctx ? 9 : 8;
    for (int i = 0; i < n; ++i) {
        int bh, qb; attn_map(F.vcu, i & 7, bh, qb); const bool lat = i < 8; if (!lat) bh = F.vcu;
        const int b = bh >> 4, h = bh & 15;
        int bhn, qbn; attn_map(F.vcu, (i + 1) & 7, bhn, qbn); const bool latn = i + 1 < 8; if (!latn) bhn = F.vcu;
        const int bn = bhn >> 4, hn = bhn & 15;
        const attn_body::NextU nx{i + 1 < n, (const abf*)(Q + hn * 96), (const abf*)(K + hn * 96), (const abf*)(V + hn * 64), latn ? bn * 2048 + 256 * qbn : RL + bn * 256, RL + bn * 256};
        s0 = attn_body::attn_unit<8, false, 96, false>((const abf*)(Q + h * 96), 1536, (const abf*)(K + h * 96), (const abf*)(V + h * 64), 1536, 1024, (abf*)(O + h * 64),
                                                lat ? b * 2048 + 256 * qb : RL + b * 256, RL + b * 256, 4, b * 2048, lat ? 36 : 4, F.ldsg, qr, pre, s0, nx);
        pre = nx.on;
    }
}
__device__ __forceinline__ void attn_dense64_phase(Frame& F, bool need_ctx, int L) {
    typedef attn_body::bf16 abf;
    const bf16* Q = FWS(WS_ACT + AO_Q, bf16); const bf16* K = FWS(WS_ACT + AO_K, bf16); const bf16* V = FWS(WS_ACT + AO_V, bf16); bf16* O = FWS(WS_ACT + AO_O, bf16);
    if (F.G != 256) return;
    attn_body::bf16x8 qr[6]; int s0 = 0; bool pre = false; const int n = need_ctx ? 9 : 8, cv = F.vcu & 7;
    for (int i = 0; i < n; ++i) {
        if (i == cv) { conv_chunk(F, L == 0 ? 0 : 3 * 24576, L == 0 ? 3 * 24576 : 24576); _Pragma("unroll") for (int d = 0; d < 4; ++d) qr[d] = attn_body::bf16x8{}; }
        int bh, qb; attn_map(F.vcu, i & 7, bh, qb); const bool lat = i < 8; if (!lat) bh = F.vcu;
        const int b = bh >> 4, h = bh & 15, kh = h >> 2;
        int bhn, qbn; attn_map(F.vcu, (i + 1) & 7, bhn, qbn); const bool latn = i + 1 < 8; if (!latn) bhn = F.vcu;
        const int bn = bhn >> 4, hn = bhn & 15, khn = hn >> 2;
        const attn_body::NextU nx{i + 1 < n && i + 1 != cv, (const abf*)(Q + hn * 64), (const abf*)(K + khn * 64), (const abf*)(V + khn * 64), latn ? bn * 2048 + 256 * qbn : RL + bn * 256, RL + bn * 256};
        s0 = attn_body::attn_unit<8>((const abf*)(Q + h * 64), 1024, (const abf*)(K + kh * 64), (const abf*)(V + kh * 64), 256, 256, (abf*)(O + h * 64),
                                     lat ? b * 2048 + 256 * qb : RL + b * 256, RL + b * 256, 4, b * 2048, lat ? 36 : 4, F.ldsg, qr, pre, s0, nx);
        pre = nx.on;
    }
}
__device__ __forceinline__ void attn_na_phase(Frame& F, bool need_ctx, int L) {
    typedef attn_body::bf16 abf;
    const bf16* Q = FWS(WS_ACT + AO_Q, bf16); const bf16* K = FWS(WS_ACT + AO_K, bf16); const bf16* V = FWS(WS_ACT + AO_V, bf16); bf16* O = FWS(WS_ACT + AO_O, bf16);
    if (F.G != 256) return;
    const int s_ = (F.vcu & 31) >> 3, g = F.vcu & 7, h = 2 * (F.vcu >> 5) + (s_ & 1);
    {
        int tid_ = threadIdx.x; asm volatile("" : "+v"(tid_));
        LAS float* T = (LAS float*)(F.lds + 86016);
        const float* rp = F.in[I_CRPB] + h * 15 * 31;
        for (int e = tid_; e < 15 * (int)attn_body::NA_STRIP; e += NTHR) {
            const int dr = e / (int)attn_body::NA_STRIP, o = e - dr * (int)attn_body::NA_STRIP;
            int dc = 0; bool real = false;
            if (o < 112) { dc = o - 56; real = dc >= -8 && dc <= 7; }
            else { const int o2 = o - 112, p = o2 / 80, w = o2 - p * 80;
                   if (w < 16) { dc = w - p; real = true; } else if (w >= 64) { dc = w - 73 - p; real = true; } }
            T[e] = real ? rp[dr * 31 + dc + 15] * LOG2E : -INFINITY;
        }
        if (tid_ < 136) T[15 * (int)attn_body::NA_STRIP + tid_] = tid_ < 68 ? 0.f : -INFINITY;
        __syncthreads();
    }
    attn_body::bf16x8 qr[6]; int s0 = 0; bool pre = false;
    const int bc = F.vcu >> 4, hc = F.vcu & 15;
    for (int i = 0; i < 8; ++i) {
        const int b = 8 * (s_ >> 1) + i, gi = (g + i) & 7, gn = (g + i + 1) & 7;
        const int lo = min(max(4 * gi - 4, 0), 24), hiR = min(max(4 * gi - 1, 0), 24) + 8, nwin = hiR - lo;
        const bool last = i == 7; const int hn = last ? hc : h, bn = last ? bc : b + 1;
        const attn_body::NextU nx{!last || need_ctx, (const abf*)(Q + hn * 64), (const abf*)(K + hn * 64), (const abf*)(V + hn * 64), last ? RL + bn * 256 : bn * 2048 + 256 * gn, RL + bn * 256};
        s0 = attn_body::attn_unit<24, true>((const abf*)(Q + h * 64), 1024, (const abf*)(K + h * 64), (const abf*)(V + h * 64), 1024, 1024, (abf*)(O + h * 64),
                                           b * 2048 + 256 * gi, RL + b * 256, 4, b * 2048 + 64 * lo, (4 + nwin + 1) & ~1, F.ldsg, qr, pre, s0, nx, 4 * gi, lo, nwin);
        pre = nx.on;
    }
    if (need_ctx) { const attn_body::NextU nx{false, nullptr, nullptr, nullptr, 0, 0};
        attn_body::attn_unit<8>((const abf*)(Q + hc * 64), 1024, (const abf*)(K + hc * 64), (const abf*)(V + hc * 64), 1024, 1024, (abf*)(O + hc * 64),
                                RL + bc * 256, RL + bc * 256, 4, bc * 2048, 4, F.ldsg, qr, pre, s0, nx); }
}

constexpr int NPHASE = 39;
#define PH(l, s) (2 + 9 * (l) + (s))
#if MK_PER_PHASE
#define SEAM() do { } while (0)
#else
#define SEAM() xcd_barrier(bar)
#endif
#ifndef DBG_SLOT
#define DBG_SLOT -1
#endif
#ifndef DBG_LAYER
#define DBG_LAYER -1
#endif
#ifndef REP_MASK
#define REP_MASK 0
#endif
#define IDEMP(l, s) ((s) == 0 ? (l) == 0 : (s) == 4 ? (l) == 0 : (s) == 1 ? (l) != 1 : true)
#ifndef REP_LAYER
#define REP_LAYER -1
#endif
#define NREP(l, s) ((((REP_MASK) >> (s)) & 1) && IDEMP(l, s) && (REP_LAYER < 0 || REP_LAYER == (l)) ? 2 : 1)
#define SLOT_ON(l, s) ((DBG_SLOT < 0 || DBG_SLOT == (s)) && (DBG_LAYER < 0 || DBG_LAYER == (l)))
#define IN(k) (lo <= (k) && (k) < hi)

template <int L> __device__ __forceinline__ void layer_program(Frame& F, const XcdBarrier& bar, int lo, int hi) {
    constexpr int KIND = L % 3, J = L / 3;
    constexpr bool need_ctx = L < DEPTH - 1;
    constexpr int MROWS = need_ctx ? RT : RL;
    bf16* WSB = FWS(WS_WS, bf16);
    const float* MOD = FWS(WS_MOD, float);
    float* ropeA = FWS(WS_ROPE, float); float* ropeB = ropeA + 2 * 2048 * 32;
    bf16* H = FWS(WS_H, bf16);
    if (SLOT_ON(L, 0) && IN(PH(L, 0))) for (int rep_ = 0; rep_ < NREP(L, 0); ++rep_) { norm1_phase<L>(F); SEAM(); }
    if (SLOT_ON(L, 1) && IN(PH(L, 1))) for (int rep_ = 0; rep_ < NREP(L, 1); ++rep_) {
        if (KIND == 0) {
            pg8::Gemm g{H, WSB + (J ? WO_AQKV1 : WO_AQKV0) / 2, 1024, nullptr}; pg8::StaticOrder S; S.init(RT, 1536, F.G, (int)blockIdx.x);
            EpiQKV<0> E{FWS(WS_ACT, bf16), F.in[I_AQN] + J * 64, F.in[I_AKN] + J * 64, ropeA, ropeA + 2048 * 32};
            pg8::gemm_phase<EpiQKV<0>, pg8::StaticOrder, false>(F.lds, g, S, E);
        } else if (KIND == 1) {
            pg8::Gemm g{H, WSB + WO_BDN / 2, 1024, nullptr}; pg8::StaticOrder S; S.init(RT, 768, F.G, (int)blockIdx.x);
            EpiBdown E{FWS(WS_ACT + AO_CQ, bf16), FWS(WS_ACT + AO_CKV, bf16), FWS(WS_ACT + AO_K, bf16), FWS(WS_RSQP, float), F.in[I_BKN] + 64, ropeB, ropeB + 2048 * 16};
            pg8::gemm_phase<EpiBdown, pg8::StaticOrder, false>(F.lds, g, S, E);
        } else {
            pg8::Gemm g{H, WSB + WO_CQKV / 2, 1024, nullptr}; pg8::StaticOrder S; S.init(RT, 3072, F.G, (int)blockIdx.x);
            EpiQKV<2> E{FWS(WS_ACT, bf16), F.in[I_CQN], F.in[I_CKN], nullptr, nullptr};
            pg8::gemm_phase<EpiQKV<2>, pg8::StaticOrder, false>(F.lds, g, S, E);
        }
        SEAM();
    }
    if (KIND == 1) { if (SLOT_ON(L, 2) && IN(PH(L, 2))) for (int rep_ = 0; rep_ < NREP(L, 2); ++rep_) {
#ifndef DBG_NO_UQ
        { pg8::Gemm g{FWS(WS_ACT + AO_CQ, bf16), WSB + WO_BUQ / 2, 384, nullptr}; pg8::StaticOrder S; S.init(RT, 1536, F.G, (int)blockIdx.x);
          EpiBuq E{FWS(WS_ACT + AO_Q, bf16), FWS(WS_RSQP, float), F.in[I_BQN], ropeB, ropeB + 2048 * 16};
          pg8::gemm_phase<EpiBuq, pg8::StaticOrder, false>(F.lds, g, S, E); }
#endif
#ifndef DBG_NO_UKV
        { pg8::Gemm g{FWS(WS_ACT + AO_CKV, bf16), WSB + WO_BUKV / 2, 256, nullptr}; pg8::StaticOrder S; S.init(RT, 2048, F.G, (int)blockIdx.x);
          EpiBukv E{FWS(WS_ACT + AO_K, bf16), FWS(WS_ACT + AO_V, bf16), FWS(WS_RSQP, float), F.in[I_BKN]};
          pg8::gemm_phase<EpiBukv, pg8::StaticOrder, false>(F.lds, g, S, E); }
#endif
        SEAM();
    } }
    if (SLOT_ON(L, 3) && IN(PH(L, 3))) for (int rep_ = 0; rep_ < NREP(L, 3); ++rep_) {
        if (KIND == 0) attn_dense64_phase(F, need_ctx, L);
        else if (KIND == 1) attn_mla_phase(F, need_ctx, L);
        else attn_na_phase(F, need_ctx, L);
        SEAM();
    }
    if (SLOT_ON(L, 4) && IN(PH(L, 4))) for (int rep_ = 0; rep_ < NREP(L, 4); ++rep_) {
        const bf16* Wt = WSB + (KIND == 0 ? (J ? WO_AWO1 : WO_AWO0) : (KIND == 1 ? WO_BWO : WO_CWO)) / 2;
        pg8::Gemm g{FWS(WS_ACT + AO_O, bf16), Wt, 1024, nullptr}; pg8::StaticOrder S; S.init(MROWS, 1024, F.G, (int)blockIdx.x);
        EpiWo E{FWS(WS_WOUT, bf16), MOD + (size_t)L * 17 * 6144};
        pg8::gemm_phase<EpiWo, pg8::StaticOrder, false>(F.lds, g, S, E);
        SEAM();
    }
    if (SLOT_ON(L, 5) && IN(PH(L, 5))) for (int rep_ = 0; rep_ < NREP(L, 5); ++rep_) { norm2_phase<L>(F, MROWS); SEAM(); }
    if (SLOT_ON(L, 6) && IN(PH(L, 6))) for (int rep_ = 0; rep_ < NREP(L, 6); ++rep_) { topk_phase(F, need_ctx); SEAM(); }
    if (SLOT_ON(L, 7) && IN(PH(L, 7))) for (int rep_ = 0; rep_ < NREP(L, 7); ++rep_) {
        pg8::Gemm g{H, FWS(WS_WMOE + (size_t)L * 96 * MiB, bf16), 1024, FWS(WS_GIDX, int)}; pg8::MoeOrder S{need_ctx ? 18 : 16, 8, F.G, (int)blockIdx.x};
        EpiMoeGU E{FWS(WS_ACT + AO_HID, bf16)};
        pg8::gemm_phase<EpiMoeGU, pg8::MoeOrder, true>(F.lds, g, S, E);
        SEAM();
    }
    if (SLOT_ON(L, 8) && IN(PH(L, 8))) for (int rep_ = 0; rep_ < NREP(L, 8); ++rep_) {
        pg8::Gemm g{FWS(WS_ACT + AO_HID, bf16), FWS(WS_WMOE + (size_t)L * 96 * MiB + 64 * MiB, bf16), 1024, nullptr}; pg8::MoeOrder S{need_ctx ? 18 : 16, 4, F.G, (int)blockIdx.x};
        EpiMoeDown E{FWS(WS_ACT + AO_Y, bf16), FWS(WS_GATE, float)};
        pg8::gemm_phase<EpiMoeDown, pg8::MoeOrder, false>(F.lds, g, S, E);
        SEAM();
    }
}

__global__ void __launch_bounds__(NTHR, 2) fwd(Args args) {
    extern __shared__ __attribute__((aligned(16))) unsigned char lds_raw[];
    Frame F;
    F.lds = (LAS unsigned char*)lds_raw; F.ldsg = (char*)lds_raw;
    F.wave = __builtin_amdgcn_readfirstlane(threadIdx.x >> 6);
    F.G = gridDim.x; { const int bx = blockIdx.x; F.vcu = (F.G % 8 == 0) ? (bx % 8) * (F.G / 8) + bx / 8 : bx; }
    F.gw = F.vcu * NWAVES + F.wave; F.NGW = F.G * NWAVES;
    F.in = args.in; F.out = args.out; F.ws = args.ws;
    volatile LAS unsigned* MISC = (volatile LAS unsigned*)(F.lds + MISC_OFF);
    for (int u = threadIdx.x; u < (LDS_BYTES - 131072) / 4; u += NTHR) ((LAS unsigned*)(F.lds + 131072))[u] = 0u;
    __syncthreads();
    XcdBarrier bar; bar.bar = (unsigned*)(F.ws + WS_CTL) + CW_BAR; bar.x = 0; bar.st = nullptr;
#if !MK_PER_PHASE
    bar = xcd_barrier_post((unsigned*)(F.ws + WS_CTL) + CW_BAR, MISC + 8);
#else
    (void)MISC;
#endif
    const int lo = args.ph_lo, hi = args.ph_hi; (void)lo; (void)hi;
    if (SLOT_ON(-2, 10) && IN(0)) _Pragma("unroll 1") for (int rep_ = 0; rep_ < NREP(0, 10); ++rep_) { p0_prologue(F); SEAM(); }
    if (SLOT_ON(-2, 11) && IN(1)) { p1_modreduce(F); SEAM(); }
    layer_program<0>(F, bar, lo, hi);
    layer_program<1>(F, bar, lo, hi);
    layer_program<2>(F, bar, lo, hi);
    layer_program<3>(F, bar, lo, hi);
    if (SLOT_ON(-2, 12) && IN(38)) final_phase(F);
}

extern "C" void kernel_launch(void* const* d_in, const int* in_sizes, int n_in, void* d_out, int out_size, void* d_ws, size_t ws_size, hipStream_t stream) {
    static int grid = 0;
    if (grid == 0) {
        if (n_in != 30 || in_sizes[0] != RL * D || out_size != RL * D || ws_size < WS_END) { fprintf(stderr, "kernel_launch: unexpected shapes / workspace (%d inputs, ws %zu < %zu)\n", n_in, ws_size, (size_t)WS_END); grid = -1; return; }
        int dev = 0, cus = 0, per_cu = 0;
        if (hipGetDevice(&dev) != hipSuccess || hipDeviceGetAttribute(&cus, hipDeviceAttributeMultiprocessorCount, dev) != hipSuccess) { grid = -1; return; }
        if (hipFuncSetAttribute((const void*)fwd, hipFuncAttributeMaxDynamicSharedMemorySize, LDS_BYTES) != hipSuccess) { fprintf(stderr, "kernel_launch: hipFuncSetAttribute failed\n"); grid = -1; return; }
        if (hipOccupancyMaxActiveBlocksPerMultiprocessor(&per_cu, (const void*)fwd, NTHR, LDS_BYTES) != hipSuccess || per_cu < 1) fprintf(stderr, "kernel_launch: occupancy query reports %d\n", per_cu);
        (void)hipGetLastError();
        grid = cus;
    }
    if (grid < 0) return;
    (void)hipMemsetAsync((char*)d_ws + WS_CTL, 0, CTL_ZERO_BYTES, stream);
    Args a{};
    for (int i = 0; i < 30; ++i) a.in[i] = (const float*)d_in[i];
    a.out = (float*)d_out; a.ws = (unsigned char*)d_ws;
#if MK_PER_PHASE
    for (int ph = 0; ph < NPHASE; ++ph) {
        if (ph >= 2 && ph < 38 && ((ph - 2) % 9) == 2 && (((ph - 2) / 9) % 3) != 1) continue;
        a.ph_lo = ph; a.ph_hi = ph + 1;
        hipLaunchKernelGGL(fwd, dim3(grid), dim3(NTHR), LDS_BYTES, stream, a);
    }
#else
    a.ph_lo = 0; a.ph_hi = NPHASE;
    hipLaunchKernelGGL(fwd, dim3(grid), dim3(NTHR), LDS_BYTES, stream, a);
#endif
}
```

```cpp
#include <hip/hip_runtime.h>
#include <hip/hip_bf16.h>
#include <cstdio>
#include <cstdint>
#include <cmath>

#ifndef MK_PER_PHASE
#define MK_PER_PHASE 0
#endif

#define GAS __attribute__((address_space(1)))
#define LAS __attribute__((address_space(3)))
typedef unsigned short bf16;
typedef short bf16x8 __attribute__((ext_vector_type(8)));
typedef short s16x4 __attribute__((ext_vector_type(4)));
typedef float f32x4 __attribute__((ext_vector_type(4)));
typedef float f32x16 __attribute__((ext_vector_type(16)));
typedef unsigned u32x4 __attribute__((ext_vector_type(4)));
typedef unsigned u32x2 __attribute__((ext_vector_type(2)));
typedef GAS unsigned gu32;

constexpr int D = 1024, NB = 16, SEQ = 2048, CTXL = 256, DEPTH = 4;
constexpr int RL = NB * SEQ, RC = NB * CTXL, RT = RL + RC;
constexpr int NE = 16, SLOTS_E = 4608, NSLOT = NE * SLOTS_E;
constexpr float EPS = 1e-6f, LOG2E = 1.4426950408889634f;
constexpr int NWAVES = 8, NTHR = 512;

constexpr size_t MiB = 1u << 20;
constexpr size_t WS_CTL = 0, CTL_ZERO_BYTES = 64 * 1024;
constexpr size_t WS_MOD = 1 * MiB;
constexpr size_t WS_MODP = 3 * MiB;
constexpr size_t WS_ROPE = 17 * MiB;
constexpr size_t WS_AFF = 18 * MiB;
constexpr size_t WS_INV = 21 * MiB;
constexpr size_t WS_GIDX = 24 * MiB;
constexpr size_t WS_GATE = 24 * MiB + 512 * 1024;
constexpr size_t WS_RSQ = 25 * MiB;
constexpr size_t WS_RSQP = 34 * MiB;
constexpr size_t WS_XC = 26 * MiB;
constexpr size_t WS_WS = 42 * MiB;
constexpr size_t WO_AQKV0 = 0, WO_AQKV1 = 3 * MiB, WO_AWO0 = 6 * MiB, WO_AWO1 = 8 * MiB, WO_BDN = 10 * MiB, WO_BUQ = 11 * MiB + 512 * 1024,
                 WO_BUKV = 13 * MiB, WO_BWO = 14 * MiB, WO_CQKV = 16 * MiB, WO_CWO = 22 * MiB;
constexpr size_t WS_WMOE = 66 * MiB;
constexpr size_t WS_H = 450 * MiB;
constexpr size_t WS_ACT = 522 * MiB;
constexpr size_t AO_Q = 0, AO_K = 108 * MiB, AO_V = 216 * MiB, AO_O = 288 * MiB, AO_CQ = 360 * MiB, AO_CKV = 387 * MiB, AO_HID = 0, AO_Y = 144 * MiB;
constexpr size_t WS_WOUT = 927 * MiB;
constexpr size_t WS_END = 999 * MiB;

constexpr int CW_BAR = 4096;
constexpr int LDS_BYTES = 147456, MISC_OFF = 131072 + 320;

#define LDS_WAIT() asm volatile("s_waitcnt lgkmcnt(0)" ::: "memory")
#define VM_WAIT() asm volatile("s_waitcnt vmcnt(0)" ::: "memory")
__device__ __forceinline__ unsigned f2bf(float f) { unsigned u = __builtin_bit_cast(unsigned, f); return (u + 0x7fffu + ((u >> 16) & 1u)) >> 16; }
__device__ __forceinline__ unsigned pk2(float lo, float hi) { return f2bf(lo) | (f2bf(hi) << 16); }
__device__ __forceinline__ float bf2f(unsigned h) { return __builtin_bit_cast(float, h << 16); }
__device__ __forceinline__ unsigned cvt_pk_bf16(float lo, float hi) { unsigned r; asm volatile("v_cvt_pk_bf16_f32 %0, %1, %2" : "=v"(r) : "v"(lo), "v"(hi)); return r; }
__device__ __forceinline__ u32x4 pack8(const f32x4 a, const f32x4 b) { u32x4 w; w.x = cvt_pk_bf16(a[0], a[1]); w.y = cvt_pk_bf16(a[2], a[3]); w.z = cvt_pk_bf16(b[0], b[1]); w.w = cvt_pk_bf16(b[2], b[3]); return w; }
__device__ __forceinline__ float wave_sum(float v) {
#pragma unroll
    for (int o = 1; o < 64; o <<= 1) v += __shfl_xor(v, o);
    return v;
}
__device__ __forceinline__ float sum4sq(const f32x4 a) { return (a[0] * a[0] + a[1] * a[1]) + (a[2] * a[2] + a[3] * a[3]); }
__device__ __forceinline__ float red_fq(float s) { s += __shfl_xor(s, 16); s += __shfl_xor(s, 32); return s; }

namespace pg8 {
constexpr int BM = 256, BK = 64, HALF = 128, HTB = HALF * BK * 2, NXCD = 8, WGM = 8;
__host__ __device__ __forceinline__ int lds_byte(int r, int c) { const int st = (r >> 4) * 2 + (c >> 5), rr = r & 15, cc = c & 31, ob = rr * 64 + cc * 2; return st * 1024 + (ob ^ (((ob >> 9) & 1) << 5)); }
__host__ __device__ __forceinline__ void stage_rc(int b, int& R, int& C) { const int st = b / 1024, sb = b % 1024, swz = sb ^ (((sb >> 9) & 1) << 5); R = (st >> 1) * 16 + swz / 64; C = (st & 1) * 32 + (swz % 64) / 2; }
__host__ __device__ __forceinline__ int perm32(int rho) { const int n = rho >> 4, i = rho & 15; return 8 * (i >> 2) + 4 * n + (i & 3); }
struct Unit { int pm, pn; };
struct Gemm { const bf16* A; const bf16* Bt; int K; const int* gidx; };
struct StaticOrder {
    int nM, nN, nwg, G, c;
    __device__ void init(int M, int N, int G_, int c_) { nM = M / BM; nN = N / BM; nwg = nM * nN; G = G_; c = c_; }
    __device__ bool next(int i, Unit& u) const {
        const long L = (long)i * G + c; if (L >= nwg) return false;
        int wgid = (int)L; { const int q = nwg / NXCD, r = nwg % NXCD, xcd = wgid % NXCD, off = wgid / NXCD; wgid = (xcd < r ? xcd * (q + 1) : r * (q + 1) + (xcd - r) * q) + off; }
        const int nig = WGM * nN, gid = wgid / nig, fm = gid * WGM, gsz = (nM - fm) < WGM ? (nM - fm) : WGM;
        u.pm = fm + ((wgid % nig) % gsz); u.pn = (wgid % nig) / gsz; return true;
    }
};
struct MoeOrder {
    int njt, npn, G, c;
    __device__ bool next(int i, Unit& u) const {
        const int x = c & 7, w = c >> 3, per = 2 * njt * npn;
        const int q = i * (G >> 3) + w; if (q >= per) return false;
        const int pe = njt * npn, el = q / pe, qq = q - el * pe, e = 2 * x + el, gsz = (njt % 8 == 0) ? 8 : 6, pg = gsz * npn, gi = qq / pg, r = qq - gi * pg;
        const int j = gi * gsz + r % gsz, pn = r / gsz;
        u.pm = e * 18 + j; u.pn = e * npn + pn; return true;
    }
};
template <class Epi, class Sched, bool GATHER>
__device__ __forceinline__ void gemm_phase(LAS unsigned char* lds, const Gemm g, const Sched& S, const Epi& E) {
    int tid_ = threadIdx.x; asm volatile("" : "+v"(tid_));
    const int tid = tid_, wid = __builtin_amdgcn_readfirstlane(tid >> 6), lane = tid & 63, wr = wid >> 2, wc = wid & 3, fr = lane & 15, fq = lane >> 4;
    const int K = g.K, nt = K / BK;
    unsigned voffB[2]; int RA[2]; unsigned CA[2];
#pragma unroll
    for (int i = 0; i < 2; ++i) { int R, C; stage_rc(tid * 16 + i * 8192, R, C); voffB[i] = (unsigned)(R * K + C) * 2u; RA[i] = R; CA[i] = (unsigned)C * 2u; }
    const size_t kstep = (size_t)(BK * 2);
    const unsigned hstep = (unsigned)HALF * (unsigned)K * 2u;
    const size_t tstep = 2 * (size_t)hstep;
    const unsigned ldsw = (unsigned)wid * 1024u;
    const int aoff = lds_byte(wr * 64 + fr, fq * 8), boff = lds_byte(wc * 32 + fr, fq * 8);
#define PG8_SA(b, h) (((b) * 2 + (h)) * HTB)
#define PG8_SB(b, h) ((4 + (b) * 2 + (h)) * HTB)
#define PG8_STAGE(bufoff, gbase, voff) do { _Pragma("unroll") for (int _i = 0; _i < 2; ++_i) \
        __builtin_amdgcn_global_load_lds((const unsigned*)((const char*)(gbase) + (voff)[_i]), (LAS unsigned*)(lds + (bufoff) + ldsw + _i * 8192), 16, 0, 0); } while (0)
#define PG8_LDA(dst, b, h) do { _Pragma("unroll") for (int m = 0; m < 4; ++m) _Pragma("unroll") for (int k = 0; k < 2; ++k) dst[m][k] = *(const LAS bf16x8*)(lds + PG8_SA(b, h) + aoff + m * 2048 + k * 1024); } while (0)
#define PG8_LDB(dst, b, h) do { _Pragma("unroll") for (int n = 0; n < 2; ++n) _Pragma("unroll") for (int k = 0; k < 2; ++k) dst[n][k] = *(const LAS bf16x8*)(lds + PG8_SB(b, h) + boff + n * 2048 + k * 1024); } while (0)
#define PG8_MMA(ai, bj, At, Bt) do { __builtin_amdgcn_s_setprio(1); _Pragma("unroll") for (int m = 0; m < 4; ++m) _Pragma("unroll") for (int n = 0; n < 2; ++n) _Pragma("unroll") for (int k = 0; k < 2; ++k) \
        acc[ai][bj][m][n] = __builtin_amdgcn_mfma_f32_16x16x32_bf16(Bt[n][k], At[m][k], acc[ai][bj][m][n], 0, 0, 0); __builtin_amdgcn_s_setprio(0); } while (0)
#define PG8_WAIT_V(n) asm volatile("s_waitcnt vmcnt(" #n ")" ::: "memory")
#define PG8_WAIT_L(n) asm volatile("s_waitcnt lgkmcnt(" #n ")" ::: "memory")
#define PG8_BAR __builtin_amdgcn_s_barrier()
#define PG8_SCHED __builtin_amdgcn_sched_barrier(0)
#define PG8_MKOFF(o, u) do { _Pragma("unroll") for (int _h = 0; _h < 2; ++_h) _Pragma("unroll") for (int _i = 0; _i < 2; ++_i) \
        o[_h][_i] = GATHER ? (unsigned)g.gidx[(u).pm * 256 + _h * 128 + RA[_i]] * (unsigned)(K * 2) + CA[_i] : (unsigned)(RA[_i] * K * 2) + CA[_i] + (unsigned)_h * hstep; } while (0)
    Unit cur, nxt; int ui = 0;
    if (!S.next(0, cur)) return;
    f32x4 acc[2][2][4][2];
#pragma unroll
    for (int a = 0; a < 2; ++a)
#pragma unroll
        for (int b = 0; b < 2; ++b)
#pragma unroll
            for (int m = 0; m < 4; ++m)
#pragma unroll
                for (int n = 0; n < 2; ++n) acc[a][b][m][n] = (f32x4){0.f, 0.f, 0.f, 0.f};
    bf16x8 At[4][2], B0[2][2], B1[2][2];
    unsigned cO[2][2], nO[2][2];
    const char* cA = GATHER ? (const char*)g.A : (const char*)g.A + (size_t)cur.pm * tstep; const char* cB = (const char*)g.Bt + (size_t)cur.pn * tstep;
    PG8_STAGE(PG8_SB(0, 0), cB, voffB); PG8_STAGE(PG8_SB(0, 1), cB + hstep, voffB);
    PG8_MKOFF(cO, cur);
    PG8_STAGE(PG8_SA(0, 0), cA, cO[0]); PG8_STAGE(PG8_SA(0, 1), cA, cO[1]);
    if (wr == 1) PG8_BAR;
    PG8_WAIT_V(2); PG8_BAR;
    PG8_STAGE(PG8_SB(1, 0), cB + kstep, voffB); PG8_STAGE(PG8_SA(1, 0), cA + kstep, cO[0]); PG8_STAGE(PG8_SB(1, 1), cB + hstep + kstep, voffB);
    PG8_WAIT_V(6); PG8_BAR;
    for (;;) {
        const bool has_next = S.next(ui + 1, nxt);
        const char* nA = has_next ? (GATHER ? (const char*)g.A : (const char*)g.A + (size_t)nxt.pm * tstep) : cA; const char* nB = has_next ? (const char*)g.Bt + (size_t)nxt.pn * tstep : cB;
        if (has_next) {
            if (GATHER) {
#pragma unroll
                for (int h = 0; h < 2; ++h)
#pragma unroll
                    for (int i = 0; i < 2; ++i) nO[h][i] = (unsigned)g.gidx[nxt.pm * 256 + h * 128 + RA[i]];
            } else { PG8_MKOFF(nO, nxt); }
        } else {
#pragma unroll
            for (int h = 0; h < 2; ++h)
#pragma unroll
                for (int i = 0; i < 2; ++i) nO[h][i] = cO[h][i]; }
#pragma unroll 1
        for (int t = 0; t < nt; t += 2) {
            const bool last = (t == nt - 2);
            const char* a1 = cA + (size_t)(t + 1) * kstep;
            const char* a2 = last ? nA : cA + (size_t)(t + 2) * kstep; const char* b2 = last ? nB : cB + (size_t)(t + 2) * kstep;
            const char* a3 = a2 + kstep; const char* b3 = b2 + kstep;
            unsigned o2[2][2];
#pragma unroll
            for (int h = 0; h < 2; ++h)
#pragma unroll
                for (int i = 0; i < 2; ++i) o2[h][i] = cO[h][i];
            if (last) {
                asm volatile("" : "+v"(nO[0][0]), "+v"(nO[0][1]), "+v"(nO[1][0]), "+v"(nO[1][1]));
                if (GATHER && has_next) {
#pragma unroll
                    for (int h = 0; h < 2; ++h)
#pragma unroll
                        for (int i = 0; i < 2; ++i) nO[h][i] = nO[h][i] * (unsigned)(K * 2) + CA[i];
                }
#pragma unroll
                for (int h = 0; h < 2; ++h)
#pragma unroll
                    for (int i = 0; i < 2; ++i) o2[h][i] = nO[h][i];
            }
            PG8_LDB(B0, 0, 0); PG8_LDB(B1, 0, 1); PG8_SCHED; PG8_LDA(At, 0, 0); PG8_STAGE(PG8_SA(1, 1), a1, cO[1]);
            PG8_WAIT_V(8); PG8_WAIT_L(0); PG8_BAR; PG8_MMA(0, 0, At, B0); PG8_MMA(0, 1, At, B1); PG8_BAR; PG8_SCHED;
            PG8_LDA(At, 0, 1); PG8_STAGE(PG8_SB(0, 0), b2, voffB); PG8_STAGE(PG8_SB(0, 1), b2 + hstep, voffB); PG8_STAGE(PG8_SA(0, 0), a2, o2[0]);
            PG8_WAIT_V(8); PG8_WAIT_L(0); PG8_BAR; PG8_MMA(1, 0, At, B0); PG8_MMA(1, 1, At, B1); PG8_BAR; PG8_SCHED;
            PG8_LDB(B0, 1, 0); PG8_LDB(B1, 1, 1); PG8_SCHED; PG8_LDA(At, 1, 0); PG8_STAGE(PG8_SA(0, 1), a2, o2[1]);
            PG8_WAIT_V(8); PG8_WAIT_L(0); PG8_BAR; PG8_MMA(0, 0, At, B0); PG8_MMA(0, 1, At, B1); PG8_BAR; PG8_SCHED;
            PG8_LDA(At, 1, 1); PG8_STAGE(PG8_SB(1, 0), b3, voffB); PG8_STAGE(PG8_SB(1, 1), b3 + hstep, voffB); PG8_STAGE(PG8_SA(1, 0), a3, o2[0]);
            PG8_WAIT_V(8); PG8_WAIT_L(0); PG8_BAR; PG8_MMA(1, 0, At, B0); PG8_MMA(1, 1, At, B1); PG8_BAR; PG8_SCHED;
        }
        if (wr == 0) PG8_BAR;
        { int fr_ = fr, fq_ = fq; asm volatile("" : "+v"(fr_), "+v"(fq_)); E(acc, cur, wr, wc, fr_, fq_); }
        if (!has_next) break;
#pragma unroll
        for (int a = 0; a < 2; ++a)
#pragma unroll
            for (int b = 0; b < 2; ++b)
#pragma unroll
                for (int m = 0; m < 4; ++m)
#pragma unroll
                    for (int n = 0; n < 2; ++n) acc[a][b][m][n] = (f32x4){0.f, 0.f, 0.f, 0.f};
        cur = nxt; cA = nA; cB = nB; ++ui;
#pragma unroll
        for (int h = 0; h < 2; ++h)
#pragma unroll
            for (int i = 0; i < 2; ++i) cO[h][i] = nO[h][i];
        if (wr == 1) PG8_BAR;
    }
    PG8_WAIT_V(0);
    PG8_BAR;
#undef PG8_SA
#undef PG8_SB
#undef PG8_STAGE
#undef PG8_LDA
#undef PG8_LDB
#undef PG8_MMA
#undef PG8_WAIT_V
#undef PG8_WAIT_L
#undef PG8_BAR
#undef PG8_SCHED
#undef PG8_MKOFF
}
}

template <int KIND> struct EpiQKV {
    bf16* act; const float *qg, *kg, *cosT, *sinT;
    __device__ __forceinline__ void operator()(const f32x4 (&acc)[2][2][4][2], const pg8::Unit& u, int wr, int wc, int fr, int fq) const {
        constexpr int NQ = 16, NK = (KIND == 0) ? 4 : 16, KVP = (KIND == 0) ? 256 : 1024;
        const int hs = 4 * u.pn + wc;
        const int type = hs < NQ ? 0 : (hs < NQ + NK ? 1 : 2);
        const int hh = type == 0 ? hs : (type == 1 ? hs - NQ : hs - NQ - NK);
        bf16* dst = act + (type == 0 ? AO_Q / 2 : (type == 1 ? AO_K / 2 : AO_V / 2)); const int pitch = type == 0 ? 1024 : KVP;
        const int dbase = 8 * fq;
        f32x4 g[2][2];
#pragma unroll
        for (int bj = 0; bj < 2; ++bj)
#pragma unroll
            for (int n = 0; n < 2; ++n) { const f32x4 a = *(const f32x4*)(qg + dbase + 32 * bj + 4 * n), b = *(const f32x4*)(kg + dbase + 32 * bj + 4 * n); g[bj][n] = (type == 0) ? a : b; }
        const float qs = type == 0 ? 0.125f * LOG2E : 1.f;
#pragma unroll
        for (int ai = 0; ai < 2; ++ai)
#pragma unroll
            for (int m = 0; m < 4; ++m) {
                const int row = u.pm * 256 + ai * 128 + wr * 64 + m * 16 + fr;
                f32x4 v[2][2];
#pragma unroll
                for (int bj = 0; bj < 2; ++bj)
#pragma unroll
                    for (int n = 0; n < 2; ++n) v[bj][n] = acc[ai][bj][m][n];
                if (type != 2) {
                    float ss = (sum4sq(v[0][0]) + sum4sq(v[0][1])) + (sum4sq(v[1][0]) + sum4sq(v[1][1]));
                    ss = red_fq(ss);
                    const float rinv = rsqrtf(ss * (1.f / 64.f) + EPS) * qs;
#pragma unroll
                    for (int bj = 0; bj < 2; ++bj)
#pragma unroll
                        for (int n = 0; n < 2; ++n) v[bj][n] = v[bj][n] * rinv * g[bj][n];
                    if (KIND == 0 && row < RL) {
                        const int pos = row & (SEQ - 1);
#pragma unroll
                        for (int n = 0; n < 2; ++n) {
                            const f32x4 c = *(const f32x4*)(cosT + pos * 32 + dbase + 4 * n), s = *(const f32x4*)(sinT + pos * 32 + dbase + 4 * n);
                            const f32x4 x1 = v[0][n], x2 = v[1][n];
                            v[0][n] = x1 * c - x2 * s; v[1][n] = x1 * s + x2 * c;
                        }
                    }
                }
                bf16* rp = dst + (size_t)row * pitch + hh * 64 + dbase;
#pragma unroll
                for (int bj = 0; bj < 2; ++bj) *(u32x4*)(rp + 32 * bj) = pack8(v[bj][0], v[bj][1]);
            }
    }
};
struct EpiWo {
    bf16* wout; const float* mod;
    __device__ __forceinline__ void operator()(const f32x4 (&acc)[2][2][4][2], const pg8::Unit& u, int wr, int wc, int fr, int fq) const {
        const int bi = u.pm < 128 ? (u.pm >> 3) : 16;
        const int col0 = u.pn * 256 + 32 * wc + 8 * fq;
        const float* m2 = mod + bi * 6144 + 2 * 1024 + col0;
        f32x4 mv[2][2];
#pragma unroll
        for (int bj = 0; bj < 2; ++bj)
#pragma unroll
            for (int n = 0; n < 2; ++n) mv[bj][n] = *(const f32x4*)(m2 + 128 * bj + 4 * n);
#pragma unroll
        for (int ai = 0; ai < 2; ++ai)
#pragma unroll
            for (int m = 0; m < 4; ++m) {
                const int row = u.pm * 256 + ai * 128 + wr * 64 + m * 16 + fr;
                bf16* wp = wout + (size_t)row * D + col0;
#pragma unroll
                for (int bj = 0; bj < 2; ++bj) *(u32x4*)(wp + 128 * bj) = pack8(mv[bj][0] * acc[ai][bj][m][0], mv[bj][1] * acc[ai][bj][m][1]);
            }
    }
};
struct EpiMoeGU {
    bf16* HID;
    __device__ __forceinline__ void operator()(const f32x4 (&acc)[2][2][4][2], const pg8::Unit& u, int wr, int wc, int fr, int fq) const {
        const int f0 = 128 * (u.pn & 7) + 32 * wc + 8 * fq;
#pragma unroll
        for (int ai = 0; ai < 2; ++ai)
#pragma unroll
            for (int m = 0; m < 4; ++m) {
                const int row = u.pm * 256 + ai * 128 + wr * 64 + m * 16 + fr;
                f32x4 h[2];
#pragma unroll
                for (int n = 0; n < 2; ++n) { const f32x4 gt = acc[ai][0][m][n], up = acc[ai][1][m][n];
#pragma unroll
                    for (int j = 0; j < 4; ++j) h[n][j] = gt[j] * __builtin_amdgcn_rcpf(1.f + __expf(-gt[j])) * up[j]; }
                *(u32x4*)(HID + (size_t)row * 1024 + f0) = pack8(h[0], h[1]);
            }
    }
};
struct EpiMoeDown {
    bf16* Y; const float* GATE;
    __device__ __forceinline__ void operator()(const f32x4 (&acc)[2][2][4][2], const pg8::Unit& u, int wr, int wc, int fr, int fq) const {
        const int col0 = 256 * (u.pn & 3) + 32 * wc + 8 * fq;
#pragma unroll
        for (int ai = 0; ai < 2; ++ai)
#pragma unroll
            for (int m = 0; m < 4; ++m) {
                const int row = u.pm * 256 + ai * 128 + wr * 64 + m * 16 + fr;
                const float gt = GATE[row];
#pragma unroll
                for (int bj = 0; bj < 2; ++bj) *(u32x4*)(Y + (size_t)row * 1024 + col0 + 128 * bj) = pack8(acc[ai][bj][m][0] * gt, acc[ai][bj][m][1] * gt);
            }
    }
};
struct EpiBdown {
    bf16 *CQ, *CKV, *Km; float *rsqp; const float *kg, *cosT, *sinT;
    __device__ __forceinline__ void operator()(const f32x4 (&acc)[2][2][4][2], const pg8::Unit& u, int wr, int wc, int fr, int fq) const {
        const int pn = u.pn;
#pragma unroll
        for (int ai = 0; ai < 2; ++ai)
#pragma unroll
            for (int m = 0; m < 4; ++m) {
                const int row = u.pm * 256 + ai * 128 + wr * 64 + m * 16 + fr;
                if (pn != 1) {
                    bf16* dst = (pn == 0 ? CQ + (size_t)row * 384 : CKV + (size_t)row * 256) + 32 * wc + 8 * fq;
                    float ss = 0.f;
#pragma unroll
                    for (int bj = 0; bj < 2; ++bj) { ss += sum4sq(acc[ai][bj][m][0]) + sum4sq(acc[ai][bj][m][1]); *(u32x4*)(dst + 128 * bj) = pack8(acc[ai][bj][m][0], acc[ai][bj][m][1]); }
                    ss = red_fq(ss);
                    if (fq == 0) rsqp[(size_t)row * 12 + (pn == 0 ? 0 : 8) + wc] = ss;
                } else {
                    float ss = sum4sq(acc[ai][0][m][0]) + sum4sq(acc[ai][0][m][1]);
                    *(u32x4*)(CQ + (size_t)row * 384 + 256 + 32 * wc + 8 * fq) = pack8(acc[ai][0][m][0], acc[ai][0][m][1]);
                    ss = red_fq(ss);
                    if (fq == 0) rsqp[(size_t)row * 12 + 4 + wc] = ss;
                    if (wc == 0) {
                        f32x4 a = acc[ai][1][m][0], b = acc[ai][1][m][1];
                        float s2 = red_fq(sum4sq(a) + sum4sq(b));
                        const float rinv = rsqrtf(s2 * (1.f / 32.f) + EPS);
                        a = a * rinv * *(const f32x4*)(kg + 4 * fq); b = b * rinv * *(const f32x4*)(kg + 16 + 4 * fq);
                        if (row < RL) { const int pos = row & (SEQ - 1); const f32x4 c = *(const f32x4*)(cosT + pos * 16 + 4 * fq), s = *(const f32x4*)(sinT + pos * 16 + 4 * fq);
                            const f32x4 x1 = a, x2 = b; a = x1 * c - x2 * s; b = x1 * s + x2 * c; }
                        u32x2 wa, wb; wa.x = cvt_pk_bf16(a[0], a[1]); wa.y = cvt_pk_bf16(a[2], a[3]); wb.x = cvt_pk_bf16(b[0], b[1]); wb.y = cvt_pk_bf16(b[2], b[3]);
                        bf16* kp = Km + (size_t)row * 1536 + 64 + 4 * fq;
#pragma unroll
                        for (int h = 0; h < 16; ++h) { *(u32x2*)(kp + 96 * h) = wa; *(u32x2*)(kp + 96 * h + 16) = wb; }
                    }
                }
            }
    }
};
struct EpiBuq {
    bf16* Qm; const float *rsqp, *qg, *cosT, *sinT;
    __device__ __forceinline__ void operator()(const f32x4 (&acc)[2][2][4][2], const pg8::Unit& u, int wr, int wc, int fr, int fq) const {
        const float C2 = 0.10206207261596575f * LOG2E;
        const int pn = u.pn;
#pragma unroll
        for (int ai = 0; ai < 2; ++ai)
#pragma unroll
            for (int m = 0; m < 4; ++m) {
                const int row = u.pm * 256 + ai * 128 + wr * 64 + m * 16 + fr;
                const f32x4 p0_ = *(const f32x4*)(rsqp + (size_t)row * 12), p1_ = *(const f32x4*)(rsqp + (size_t)row * 12 + 4);
                const float al = rsqrtf((((p0_[0] + p0_[1]) + (p0_[2] + p0_[3])) + ((p1_[0] + p1_[1]) + (p1_[2] + p1_[3]))) * (1.f / 384.f) + EPS);
                if (pn < 4) {
                    const int head = 4 * pn + wc;
                    f32x4 v[2][2]; float ss = 0.f;
#pragma unroll
                    for (int bj = 0; bj < 2; ++bj)
#pragma unroll
                        for (int n = 0; n < 2; ++n) { v[bj][n] = acc[ai][bj][m][n] * al; ss += sum4sq(v[bj][n]); }
                    ss = red_fq(ss);
                    const float rinv = rsqrtf(ss * (1.f / 64.f) + EPS) * C2;
                    bf16* rp = Qm + (size_t)row * 1536 + head * 96 + 8 * fq;
#pragma unroll
                    for (int bj = 0; bj < 2; ++bj) { const f32x4 g0 = *(const f32x4*)(qg + 32 * bj + 8 * fq), g1 = *(const f32x4*)(qg + 32 * bj + 8 * fq + 4);
                        *(u32x4*)(rp + 32 * bj) = pack8(v[bj][0] * rinv * g0, v[bj][1] * rinv * g1); }
                } else {
#pragma unroll
                    for (int bj = 0; bj < 2; ++bj) {
                        const int head = 8 * (pn - 4) + 4 * bj + wc;
                        f32x4 a = acc[ai][bj][m][0] * al, b = acc[ai][bj][m][1] * al;
                        const float ss = red_fq(sum4sq(a) + sum4sq(b));
                        const float rinv = rsqrtf(ss * (1.f / 32.f) + EPS) * C2;
                        a = a * rinv * *(const f32x4*)(qg + 64 + 4 * fq); b = b * rinv * *(const f32x4*)(qg + 80 + 4 * fq);
                        if (row < RL) { const int pos = row & (SEQ - 1); const f32x4 c = *(const f32x4*)(cosT + pos * 16 + 4 * fq), s = *(const f32x4*)(sinT + pos * 16 + 4 * fq);
                            const f32x4 x1 = a, x2 = b; a = x1 * c - x2 * s; b = x1 * s + x2 * c; }
                        u32x2 wa, wb; wa.x = cvt_pk_bf16(a[0], a[1]); wa.y = cvt_pk_bf16(a[2], a[3]); wb.x = cvt_pk_bf16(b[0], b[1]); wb.y = cvt_pk_bf16(b[2], b[3]);
                        bf16* rp = Qm + (size_t)row * 1536 + head * 96 + 64 + 4 * fq;
                        *(u32x2*)rp = wa; *(u32x2*)(rp + 16) = wb;
                    }
                }
                asm volatile("" ::: "memory");
            }
    }
};
struct EpiBukv {
    bf16 *Km, *Vm; const float *rsqp, *kg;
    __device__ __forceinline__ void operator()(const f32x4 (&acc)[2][2][4][2], const pg8::Unit& u, int wr, int wc, int fr, int fq) const {
        const int pn = u.pn;
#pragma unroll
        for (int ai = 0; ai < 2; ++ai)
#pragma unroll
            for (int m = 0; m < 4; ++m) {
                const int row = u.pm * 256 + ai * 128 + wr * 64 + m * 16 + fr;
                const f32x4 p2_ = *(const f32x4*)(rsqp + (size_t)row * 12 + 8);
                const float al = rsqrtf(((p2_[0] + p2_[1]) + (p2_[2] + p2_[3])) * (1.f / 256.f) + EPS);
                f32x4 v[2][2]; float ss = 0.f;
#pragma unroll
                for (int bj = 0; bj < 2; ++bj)
#pragma unroll
                    for (int n = 0; n < 2; ++n) { v[bj][n] = acc[ai][bj][m][n] * al; ss += sum4sq(v[bj][n]); }
                if (pn < 4) {
                    ss = red_fq(ss);
                    const float rinv = rsqrtf(ss * (1.f / 64.f) + EPS);
                    bf16* rp = Km + (size_t)row * 1536 + (4 * pn + wc) * 96 + 8 * fq;
#pragma unroll
                    for (int bj = 0; bj < 2; ++bj) { const f32x4 g0 = *(const f32x4*)(kg + 32 * bj + 8 * fq), g1 = *(const f32x4*)(kg + 32 * bj + 8 * fq + 4);
                        *(u32x4*)(rp + 32 * bj) = pack8(v[bj][0] * rinv * g0, v[bj][1] * rinv * g1); }
                } else {
                    bf16* rp = Vm + (size_t)row * 1024 + (4 * (pn - 4) + wc) * 64 + 8 * fq;
#pragma unroll
                    for (int bj = 0; bj < 2; ++bj) *(u32x4*)(rp + 32 * bj) = pack8(v[bj][0], v[bj][1]);
                }
                asm volatile("" ::: "memory");
            }
    }
};

__device__ __forceinline__ int crow(int r, int hi) { return (r & 3) + 8 * (r >> 2) + 4 * hi; }
template <int DK, int MODE>
__device__ __forceinline__ void attn_unit(LAS unsigned char* lds, const bf16* Qp, int qpitch, const bf16* Kp, int kpitch, const bf16* Vp, int vpitch, bf16* Op,
                                          int qrow0, int base0, int n0, int base1, int NT, int g4, int lo, const float* rpbh) {
    constexpr int KSTR = DK * 2 + 16, KSZ = 64 * KSTR, CPR = DK / 8, NCH = 64 * CPR;
    int tid_ = threadIdx.x; asm volatile("" : "+v"(tid_));
    const int tid = tid_, lane = tid & 63, r32 = lane & 31, hi = lane >> 5; const int wid = __builtin_amdgcn_readfirstlane(tid >> 6);
    LAS unsigned char* Kl = lds; LAS unsigned char* Vl = lds + 2 * KSZ; LAS float* rpbL = (LAS float*)(lds + 2 * KSZ + 16384);
    const int kr0 = tid / CPR, kc0 = tid % CPR, kr1 = (tid + 512) / CPR, kc1 = (tid + 512) % CPR; const bool k2 = (tid + 512) < NCH;
    const int vr = tid >> 3, vc = tid & 7;
    const unsigned kdst0 = kr0 * KSTR + kc0 * 16, kdst1 = kr1 * KSTR + kc1 * 16, vdst = (vc >> 2) * 4096 + vr * 64 + (vc & 3) * 16;
    if (MODE == 2) { if (tid < 15 * 32) { const int dr = tid >> 5, dc = tid & 31; rpbL[tid] = dc < 31 ? rpbh[dr * 31 + dc] * LOG2E : 0.f; } }
    bf16x8 qf[DK / 16];
    { const bf16* qp = Qp + (size_t)(qrow0 + wid * 32 + r32) * qpitch + hi * 8;
#pragma unroll
      for (int d0 = 0; d0 < DK / 16; ++d0) qf[d0] = *(const bf16x8*)(qp + 16 * d0); }
    f32x16 o0, o1;
#pragma unroll
    for (int i = 0; i < 16; ++i) { o0[i] = 0.f; o1[i] = 0.f; }
    float mrun = -1e30f, lrun = 0.f;
    const int rq = g4 + (wid >> 1), rs = min(max(rq - 4, 0), 24), cq = 32 * (wid & 1) + r32, cs = min(max(cq - 8, 0), 48);
    const unsigned vb = (4 * hi + ((lane & 15) >> 2)) * 64 + ((lane >> 4) & 1) * 32 + (lane & 3) * 8;
    u32x4 kreg0, kreg1, vreg;
#define ATT_TROW(t) ((t) < n0 ? base0 + 64 * (t) : base1 + 64 * ((t) - n0))
#define ATT_LOAD(t) do { const int tr_ = ATT_TROW(t); kreg0 = *(const u32x4*)(Kp + (size_t)(tr_ + kr0) * kpitch + kc0 * 8); \
        if (k2) kreg1 = *(const u32x4*)(Kp + (size_t)(tr_ + kr1) * kpitch + kc1 * 8); vreg = *(const u32x4*)(Vp + (size_t)(tr_ + vr) * vpitch + vc * 8); } while (0)
#define ATT_WRITE(b) do { *(LAS u32x4*)(Kl + (b) * KSZ + kdst0) = kreg0; if (k2) *(LAS u32x4*)(Kl + (b) * KSZ + kdst1) = kreg1; *(LAS u32x4*)(Vl + (b) * 8192 + vdst) = vreg; } while (0)
    ATT_LOAD(0); ATT_WRITE(0);
    __syncthreads();
    for (int t = 0; t < NT; ++t) {
        const int b = t & 1;
        if (t + 1 < NT) ATT_LOAD(t + 1);
        bool active = true;
        if (MODE == 2) { if (t < n0) { const int kr = lo + t; active = (kr >= rs) && (kr < rs + 8); } }
        if (active) {
            f32x16 p0, p1;
#pragma unroll
            for (int i = 0; i < 16; ++i) { p0[i] = 0.f; p1[i] = 0.f; }
            const LAS unsigned char* kb = Kl + b * KSZ + r32 * KSTR + hi * 16;
#pragma unroll
            for (int d0 = 0; d0 < DK / 16; ++d0) {
                const bf16x8 ka = *(const LAS bf16x8*)(kb + d0 * 32), kc = *(const LAS bf16x8*)(kb + 32 * KSTR + d0 * 32);
                p0 = __builtin_amdgcn_mfma_f32_32x32x16_bf16(ka, qf[d0], p0, 0, 0, 0);
                p1 = __builtin_amdgcn_mfma_f32_32x32x16_bf16(kc, qf[d0], p1, 0, 0, 0);
            }
            if (MODE == 2) { if (t < n0) {
                const LAS float* brow = rpbL + (lo + t - rq + 7) * 32;
                int cq_ = cq, cs_ = cs; asm volatile("" : "+v"(cq_), "+v"(cs_));
#pragma unroll
                for (int i = 0; i < 16; ++i) {
                    const int kc_ = crow(i, hi);
                    { const int rel = kc_ - cs_; const int bi = min(max(kc_ - cq_ + 15, 0), 30); p0[i] = ((unsigned)rel < 16u) ? p0[i] + brow[bi] : -1e30f; }
                    { const int rel = kc_ + 32 - cs_; const int bi = min(max(kc_ + 32 - cq_ + 15, 0), 30); p1[i] = ((unsigned)rel < 16u) ? p1[i] + brow[bi] : -1e30f; }
                    if ((i & 3) == 3) asm volatile("" ::: "memory");
                } } }
            float mx = fmaxf(p0[0], p1[0]);
#pragma unroll
            for (int i = 1; i < 16; ++i) mx = fmaxf(mx, fmaxf(p0[i], p1[i]));
            mx = fmaxf(mx, __shfl_xor(mx, 32));
            const float mnew = fmaxf(mrun, mx), alpha = __builtin_amdgcn_exp2f(mrun - mnew);
            mrun = mnew; lrun *= alpha;
            float rsum = 0.f;
#pragma unroll
            for (int i = 0; i < 16; ++i) { o0[i] *= alpha; o1[i] *= alpha; p0[i] = __builtin_amdgcn_exp2f(p0[i] - mnew); p1[i] = __builtin_amdgcn_exp2f(p1[i] - mnew); rsum += p0[i] + p1[i]; }
            lrun += rsum;
            bf16x8 pf[4];
#pragma unroll
            for (int ks = 0; ks < 4; ++ks) { u32x4 w;
                if (ks < 2) { const int s8 = 8 * ks; w.x = cvt_pk_bf16(p0[s8], p0[s8 + 1]); w.y = cvt_pk_bf16(p0[s8 + 2], p0[s8 + 3]); w.z = cvt_pk_bf16(p0[s8 + 4], p0[s8 + 5]); w.w = cvt_pk_bf16(p0[s8 + 6], p0[s8 + 7]); }
                else { const int s8 = 8 * (ks - 2); w.x = cvt_pk_bf16(p1[s8], p1[s8 + 1]); w.y = cvt_pk_bf16(p1[s8 + 2], p1[s8 + 3]); w.z = cvt_pk_bf16(p1[s8 + 4], p1[s8 + 5]); w.w = cvt_pk_bf16(p1[s8 + 6], p1[s8 + 7]); }
                pf[ks] = __builtin_bit_cast(bf16x8, w); }
            const LAS unsigned char* vbase = Vl + b * 8192 + vb;
#pragma unroll
            for (int ks = 0; ks < 4; ++ks) {
                const s16x4 a0 = __builtin_bit_cast(s16x4, __builtin_amdgcn_ds_read_tr16_b64_v4i16((LAS s16x4*)(vbase + ks * 1024)));
                const s16x4 a1 = __builtin_bit_cast(s16x4, __builtin_amdgcn_ds_read_tr16_b64_v4i16((LAS s16x4*)(vbase + ks * 1024 + 512)));
                const s16x4 c0 = __builtin_bit_cast(s16x4, __builtin_amdgcn_ds_read_tr16_b64_v4i16((LAS s16x4*)(vbase + 4096 + ks * 1024)));
                const s16x4 c1 = __builtin_bit_cast(s16x4, __builtin_amdgcn_ds_read_tr16_b64_v4i16((LAS s16x4*)(vbase + 4096 + ks * 1024 + 512)));
                const bf16x8 v0 = (bf16x8){a0[0], a0[1], a0[2], a0[3], a1[0], a1[1], a1[2], a1[3]}, v1 = (bf16x8){c0[0], c0[1], c0[2], c0[3], c1[0], c1[1], c1[2], c1[3]};
                o0 = __builtin_amdgcn_mfma_f32_32x32x16_bf16(v0, pf[ks], o0, 0, 0, 0);
                o1 = __builtin_amdgcn_mfma_f32_32x32x16_bf16(v1, pf[ks], o1, 0, 0, 0);
            }
        }
        if (t + 1 < NT) ATT_WRITE(b ^ 1);
        __syncthreads();
    }
#undef ATT_TROW
#undef ATT_LOAD
#undef ATT_WRITE
    lrun += __shfl_xor(lrun, 32);
    const float il = 1.f / lrun;
    bf16* op = Op + (size_t)(qrow0 + wid * 32 + r32) * 1024 + 4 * hi;
#pragma unroll
    for (int g = 0; g < 4; ++g) {
        u32x2 w0, w1; w0.x = cvt_pk_bf16(o0[4 * g] * il, o0[4 * g + 1] * il); w0.y = cvt_pk_bf16(o0[4 * g + 2] * il, o0[4 * g + 3] * il);
        w1.x = cvt_pk_bf16(o1[4 * g] * il, o1[4 * g + 1] * il); w1.y = cvt_pk_bf16(o1[4 * g + 2] * il, o1[4 * g + 3] * il);
        *(u32x2*)(op + 8 * g) = w0; *(u32x2*)(op + 32 + 8 * g) = w1;
    }
}

template <int DK>
__device__ __forceinline__ void attn_unit_pipe(LAS unsigned char* lds, const bf16* Qp, int qpitch, const bf16* Kp, int kpitch, const bf16* Vp, int vpitch, bf16* Op,
                                               int qrow0, int base0, int n0, int base1, int NT) {
    constexpr int KSTR = DK * 2 + 16, KSZ = 64 * KSTR, CPR = DK / 8, NCH = 64 * CPR;
    int tid_ = threadIdx.x; asm volatile("" : "+v"(tid_));
    const int tid = tid_, lane = tid & 63, r32 = lane & 31, hi = lane >> 5; const int wid = __builtin_amdgcn_readfirstlane(tid >> 6);
    LAS unsigned char* Kl = lds; LAS unsigned char* Vl = lds + 2 * KSZ;
    const int kr0 = tid / CPR, kc0 = tid % CPR, kr1 = (tid + 512) / CPR, kc1 = (tid + 512) % CPR; const bool k2 = (tid + 512) < NCH;
    const int vr = tid >> 3, vc = tid & 7;
    const unsigned kdst0 = kr0 * KSTR + kc0 * 16, kdst1 = kr1 * KSTR + kc1 * 16, vdst = (vc >> 2) * 4096 + vr * 64 + (vc & 3) * 16;
    bf16x8 qf[DK / 16];
    { const bf16* qp = Qp + (size_t)(qrow0 + wid * 32 + r32) * qpitch + hi * 8;
#pragma unroll
      for (int d0 = 0; d0 < DK / 16; ++d0) qf[d0] = *(const bf16x8*)(qp + 16 * d0); }
    f32x16 o0, o1, pc0, pc1, pn0, pn1;
#pragma unroll
    for (int i = 0; i < 16; ++i) { o0[i] = 0.f; o1[i] = 0.f; }
    float mrun = -1e30f, lrun = 0.f;
    const unsigned vb = (4 * hi + ((lane & 15) >> 2)) * 64 + ((lane >> 4) & 1) * 32 + (lane & 3) * 8;
    const unsigned kbo = r32 * KSTR + hi * 16;
    u32x4 kreg0, kreg1, vreg;
#define AP_TROW(t) ((t) < n0 ? base0 + 64 * (t) : base1 + 64 * ((t) - n0))
#define AP_LOADK(t) do { const int tr_ = AP_TROW(t); kreg0 = *(const u32x4*)(Kp + (size_t)(tr_ + kr0) * kpitch + kc0 * 8); if (k2) kreg1 = *(const u32x4*)(Kp + (size_t)(tr_ + kr1) * kpitch + kc1 * 8); } while (0)
#define AP_LOADV(t) do { const int tr_ = AP_TROW(t); vreg = *(const u32x4*)(Vp + (size_t)(tr_ + vr) * vpitch + vc * 8); } while (0)
#define AP_WRITEK(b) do { *(LAS u32x4*)(Kl + (b) * KSZ + kdst0) = kreg0; if (k2) *(LAS u32x4*)(Kl + (b) * KSZ + kdst1) = kreg1; } while (0)
#define AP_WRITEV(b) do { *(LAS u32x4*)(Vl + (b) * 8192 + vdst) = vreg; } while (0)
#define AP_QK(P0, P1, b) do { const LAS unsigned char* kb_ = Kl + (b) * KSZ + kbo; \
        _Pragma("unroll") for (int i_ = 0; i_ < 16; ++i_) { P0[i_] = 0.f; P1[i_] = 0.f; } \
        _Pragma("unroll") for (int d0 = 0; d0 < DK / 16; ++d0) { \
            const bf16x8 ka_ = *(const LAS bf16x8*)(kb_ + d0 * 32), kc_ = *(const LAS bf16x8*)(kb_ + 32 * KSTR + d0 * 32); \
            P0 = __builtin_amdgcn_mfma_f32_32x32x16_bf16(ka_, qf[d0], P0, 0, 0, 0); P1 = __builtin_amdgcn_mfma_f32_32x32x16_bf16(kc_, qf[d0], P1, 0, 0, 0); } } while (0)
#define AP_SMPV(P0, P1, b) do { \
        float mx_ = fmaxf(P0[0], P1[0]); \
        _Pragma("unroll") for (int i_ = 1; i_ < 16; ++i_) mx_ = fmaxf(mx_, fmaxf(P0[i_], P1[i_])); \
        mx_ = fmaxf(mx_, __shfl_xor(mx_, 32)); \
        if (__any(mx_ > mrun)) { const float mnew_ = fmaxf(mrun, mx_), alpha_ = __builtin_amdgcn_exp2f(mrun - mnew_); mrun = mnew_; lrun *= alpha_; \
            _Pragma("unroll") for (int i_ = 0; i_ < 16; ++i_) { o0[i_] *= alpha_; o1[i_] *= alpha_; } } \
        float rsum_ = 0.f; \
        _Pragma("unroll") for (int i_ = 0; i_ < 16; ++i_) { P0[i_] = __builtin_amdgcn_exp2f(P0[i_] - mrun); P1[i_] = __builtin_amdgcn_exp2f(P1[i_] - mrun); rsum_ += P0[i_] + P1[i_]; } \
        lrun += rsum_; \
        bf16x8 pf_[4]; \
        _Pragma("unroll") for (int ks = 0; ks < 4; ++ks) { u32x4 w_; \
            if (ks < 2) { const int s8 = 8 * ks; w_.x = cvt_pk_bf16(P0[s8], P0[s8 + 1]); w_.y = cvt_pk_bf16(P0[s8 + 2], P0[s8 + 3]); w_.z = cvt_pk_bf16(P0[s8 + 4], P0[s8 + 5]); w_.w = cvt_pk_bf16(P0[s8 + 6], P0[s8 + 7]); } \
            else { const int s8 = 8 * (ks - 2); w_.x = cvt_pk_bf16(P1[s8], P1[s8 + 1]); w_.y = cvt_pk_bf16(P1[s8 + 2], P1[s8 + 3]); w_.z = cvt_pk_bf16(P1[s8 + 4], P1[s8 + 5]); w_.w = cvt_pk_bf16(P1[s8 + 6], P1[s8 + 7]); } \
            pf_[ks] = __builtin_bit_cast(bf16x8, w_); } \
        const LAS unsigned char* vbase_ = Vl + (b) * 8192 + vb; \
        _Pragma("unroll") for (int ks = 0; ks < 4; ++ks) { \
            const s16x4 a0_ = __builtin_bit_cast(s16x4, __builtin_amdgcn_ds_read_tr16_b64_v4i16((LAS s16x4*)(vbase_ + ks * 1024))); \
            const s16x4 a1_ = __builtin_bit_cast(s16x4, __builtin_amdgcn_ds_read_tr16_b64_v4i16((LAS s16x4*)(vbase_ + ks * 1024 + 512))); \
            const s16x4 c0_ = __builtin_bit_cast(s16x4, __builtin_amdgcn_ds_read_tr16_b64_v4i16((LAS s16x4*)(vbase_ + 4096 + ks * 1024))); \
            const s16x4 c1_ = __builtin_bit_cast(s16x4, __builtin_amdgcn_ds_read_tr16_b64_v4i16((LAS s16x4*)(vbase_ + 4096 + ks * 1024 + 512))); \
            const bf16x8 v0_ = (bf16x8){a0_[0], a0_[1], a0_[2], a0_[3], a1_[0], a1_[1], a1_[2], a1_[3]}, v1_ = (bf16x8){c0_[0], c0_[1], c0_[2], c0_[3], c1_[0], c1_[1], c1_[2], c1_[3]}; \
            o0 = __builtin_amdgcn_mfma_f32_32x32x16_bf16(v0_, pf_[ks], o0, 0, 0, 0); o1 = __builtin_amdgcn_mfma_f32_32x32x16_bf16(v1_, pf_[ks], o1, 0, 0, 0); } } while (0)
    AP_LOADK(0); AP_LOADV(0); AP_WRITEK(0); AP_WRITEV(0);
    AP_LOADK(1); AP_WRITEK(1);
    __syncthreads();
    AP_QK(pc0, pc1, 0);
    __syncthreads();
    for (int t = 0; t < NT; ++t) {
        const int b = t & 1;
        const bool more1 = t + 1 < NT, more2 = t + 2 < NT;
        if (more2) AP_LOADK(t + 2);
        if (more1) AP_LOADV(t + 1);
        if (wid < 4) {
            if (more1) AP_QK(pn0, pn1, b ^ 1);
            AP_SMPV(pc0, pc1, b);
        } else {
            AP_SMPV(pc0, pc1, b);
            if (more1) AP_QK(pn0, pn1, b ^ 1);
        }
        if (more2) AP_WRITEK(b);
        if (more1) AP_WRITEV(b ^ 1);
        pc0 = pn0; pc1 = pn1;
        __syncthreads();
    }
#undef AP_TROW
#undef AP_LOADK
#undef AP_LOADV
#undef AP_WRITEK
#undef AP_WRITEV
#undef AP_QK
#undef AP_SMPV
    lrun += __shfl_xor(lrun, 32);
    const float il = 1.f / lrun;
    bf16* op = Op + (size_t)(qrow0 + wid * 32 + r32) * 1024 + 4 * hi;
#pragma unroll
    for (int g = 0; g < 4; ++g) {
        u32x2 w0, w1; w0.x = cvt_pk_bf16(o0[4 * g] * il, o0[4 * g + 1] * il); w0.y = cvt_pk_bf16(o0[4 * g + 2] * il, o0[4 * g + 3] * il);
        w1.x = cvt_pk_bf16(o1[4 * g] * il, o1[4 * g + 1] * il); w1.y = cvt_pk_bf16(o1[4 * g + 2] * il, o1[4 * g + 3] * il);
        *(u32x2*)(op + 8 * g) = w0; *(u32x2*)(op + 32 + 8 * g) = w1;
    }
}

namespace attn_body {
using bf16=__hip_bfloat16;
using bf16x8=__attribute__((ext_vector_type(8)))short;
using s16x4=__attribute__((ext_vector_type(4)))short;
using f32x16=__attribute__((ext_vector_type(16)))float;
using u32x4=__attribute__((ext_vector_type(4)))unsigned;
constexpr int D=64;
constexpr int NW=8,QBLK=32,QB=QBLK*NW,KVBLK=64;
constexpr int ATTN_UNIT_ROWS=QB;
__device__ __forceinline__ int crow(int r,int hi){return (r&3)+8*(r>>2)+4*hi;}
#define SBAR() __builtin_amdgcn_sched_barrier(0)
__device__ __forceinline__ void cmask(f32x16&p0,f32x16&p1,int jb,int qrel,int hi){
  const float NEG=-INFINITY; int kb=64*jb+4*hi;
  #pragma unroll
  for(int r=0;r<16;++r){int kv=kb+(r&3)+8*(r>>2); if(kv>qrel)p0[r]=NEG; if(kv+32>qrel)p1[r]=NEG;}
}

constexpr int NSLOT=3, SLOTB=8192;
constexpr int LDS_K=0, LDS_V=NSLOT*SLOTB, LDS_WS=2*NSLOT*SLOTB, LDS_OST=LDS_WS+NW*64*4, LDS_BYTES=LDS_OST+NW*4096;
constexpr float C2=0.125f*1.4426950408889634f;
__device__ __forceinline__ void glds16(const void*gsrc,unsigned lds_dst){unsigned keep;
  asm volatile("s_mov_b32 %0, m0\n\ts_mov_b32 m0, %2\n\ts_nop 0\n\tglobal_load_lds_dwordx4 %1, off\n\ts_mov_b32 m0, %0":"=&s"(keep):"v"(gsrc),"s"(lds_dst):"memory");}
__device__ __forceinline__ float max3f(float a,float b,float c){float r;asm("v_max3_f32 %0, %1, %2, %3":"=v"(r):"v"(a),"v"(b),"v"(c));return r;}
__device__ __forceinline__ float max2f(float a,float b){float r;asm("v_max_f32_e32 %0, %1, %2":"=v"(r):"v"(a),"v"(b));return r;}
__device__ __forceinline__ float fadd_s(float a,float b){float r;asm("v_add_f32_e32 %0, %1, %2":"=v"(r):"v"(a),"v"(b));return r;}
__device__ __forceinline__ float fsub_s(float a,float b){float r;asm("v_sub_f32_e32 %0, %1, %2":"=v"(r):"v"(a),"v"(b));return r;}
constexpr unsigned NA_STRIP=736u;
typedef float f32x2_t __attribute__((ext_vector_type(2))); typedef __bf16 bf16x2_t __attribute__((ext_vector_type(2)));
__device__ __forceinline__ unsigned cvtpk_s(float lo,float hi){f32x2_t v={lo,hi};bf16x2_t b=__builtin_convertvector(v,bf16x2_t);return __builtin_bit_cast(unsigned,b);}
#define WAIT_BAR(N) asm volatile("s_waitcnt vmcnt(" #N ") lgkmcnt(0)\n\ts_barrier":::"memory")

template<int ND> __device__ __forceinline__ void qkt(f32x16&p0,f32x16&p1,const char*Kslot,const bf16x8*qr,const f32x16&negm,int r32,int hi){
  const char*kb=Kslot+hi*1024+r32*16;
  #pragma unroll
  for(int d0=0;d0<ND;++d0){
    const bf16x8 b0=*reinterpret_cast<const bf16x8*>(kb+d0*2048);
    const bf16x8 b1=*reinterpret_cast<const bf16x8*>(kb+d0*2048+512);
    if(d0==0){p0=__builtin_amdgcn_mfma_f32_32x32x16_bf16(b0,qr[0],negm,0,0,0);p1=__builtin_amdgcn_mfma_f32_32x32x16_bf16(b1,qr[0],negm,0,0,0);}
    else{p0=__builtin_amdgcn_mfma_f32_32x32x16_bf16(b0,qr[d0],p0,0,0,0);p1=__builtin_amdgcn_mfma_f32_32x32x16_bf16(b1,qr[d0],p1,0,0,0);}}
}
typedef __attribute__((address_space(3))) const char* lds_cptr;
typedef short v4i16_t __attribute__((ext_vector_type(4)));
__device__ __forceinline__ void kload8(bf16x8*kf,lds_cptr kp){
  kf[0]=*(const __attribute__((address_space(3))) bf16x8*)(kp);      kf[1]=*(const __attribute__((address_space(3))) bf16x8*)(kp+512);
  kf[2]=*(const __attribute__((address_space(3))) bf16x8*)(kp+2048); kf[3]=*(const __attribute__((address_space(3))) bf16x8*)(kp+2560);
  kf[4]=*(const __attribute__((address_space(3))) bf16x8*)(kp+4096); kf[5]=*(const __attribute__((address_space(3))) bf16x8*)(kp+4608);
  kf[6]=*(const __attribute__((address_space(3))) bf16x8*)(kp+6144); kf[7]=*(const __attribute__((address_space(3))) bf16x8*)(kp+6656);
}
__device__ __forceinline__ void kload2(bf16x8*kf,lds_cptr kp,int j){ kf[2*j]=*(const __attribute__((address_space(3))) bf16x8*)(kp+j*2048); kf[2*j+1]=*(const __attribute__((address_space(3))) bf16x8*)(kp+j*2048+512); }
__device__ __forceinline__ s16x4 vtr(lds_cptr p){ return __builtin_bit_cast(s16x4,__builtin_amdgcn_ds_read_tr16_b64_v4i16((__attribute__((address_space(3))) v4i16_t*)p)); }
__device__ __forceinline__ float rowmax(const f32x16&p0,const f32x16&p1){
  float a=max3f(p0[0],p0[1],p1[0]),b=max3f(p0[2],p0[3],p1[1]);a=max3f(a,p1[2],p1[3]);
  #pragma unroll
  for(int r=4;r<16;r+=4){a=max3f(a,p0[r],p0[r+1]);b=max3f(b,p0[r+2],p0[r+3]);a=max3f(a,p1[r],p1[r+1]);b=max3f(b,p1[r+2],p1[r+3]);}
  const float m=max2f(a,b);
  auto rr=__builtin_amdgcn_permlane32_swap(__float_as_uint(m),__float_as_uint(m),false,false);
  return max2f(__uint_as_float(rr[0]),__uint_as_float(rr[1]));
}
__device__ __forceinline__ void pv(f32x16*o,int vb,bf16x8 pa0,bf16x8 pa1,bf16x8 pa2,bf16x8 pa3){
  #pragma unroll
  for(int d0=0;d0<2;++d0){s16x4 lo[4],hi[4];
    #pragma unroll
    for(int ks=0;ks<4;++ks){
      asm volatile("ds_read_b64_tr_b16 %0,%1 offset:%c2":"=&v"(lo[ks]):"v"(vb),"i"(d0*4096+ks*1024):"memory");
      asm volatile("ds_read_b64_tr_b16 %0,%1 offset:%c2":"=&v"(hi[ks]):"v"(vb),"i"(d0*4096+ks*1024+512):"memory");}
    asm volatile("s_waitcnt lgkmcnt(0)":::"memory");SBAR();
    #define PK(k) (bf16x8){lo[k][0],lo[k][1],lo[k][2],lo[k][3],hi[k][0],hi[k][1],hi[k][2],hi[k][3]}
    o[d0]=__builtin_amdgcn_mfma_f32_32x32x16_bf16(pa0,PK(0),o[d0],0,0,0);
    o[d0]=__builtin_amdgcn_mfma_f32_32x32x16_bf16(pa1,PK(1),o[d0],0,0,0);
    o[d0]=__builtin_amdgcn_mfma_f32_32x32x16_bf16(pa2,PK(2),o[d0],0,0,0);
    o[d0]=__builtin_amdgcn_mfma_f32_32x32x16_bf16(pa3,PK(3),o[d0],0,0,0);
    #undef PK
  }
}

#ifndef ATTN_STORE16
#define ATTN_STORE16(p,v) (*(u32x4*)(p)=(v))
#endif
struct NextU { bool on; const bf16*Q; const bf16*K; const bf16*V; int qrow0, base0; };
template<int THRL,bool NA=false,int DK=64,bool PFQ=true> __device__ __forceinline__ int attn_unit(const bf16*Qw0,int QP,const bf16*__restrict__ Kh,const bf16*__restrict__ Vh,int KP,int VP,bf16*Ow0,int qrow0,int base0,int n0,int base1,int NT,char*shm,
                                                                bf16x8 (&qr)[6],bool pre,int s0,const NextU&nx,int g4=0,int lo=0,int nwin=0){
  int tid_=threadIdx.x; asm volatile("":"+v"(tid_));
  const int tid=tid_,lane=tid&63,r32=lane&31,hi=lane>>5; const int wid=__builtin_amdgcn_readfirstlane(tid>>6);
  constexpr int ND=DK/16, KSLOT=64*DK*2, L_K=0, L_V=NSLOT*KSLOT, L_WS=L_V+NSLOT*SLOTB, L_OST=L_WS+NW*64*4;
  #define KO(sl) ((DK==64)?(sl):((sl)+((sl)>>1)))
  #define WAIT_BARK(a_,b_) do{ if(DK==64){WAIT_BAR(a_);}else{WAIT_BAR(b_);} }while(0)
  const bf16*Qw=Qw0+(long)(qrow0+wid*QBLK)*QP;
  const unsigned lds0=(unsigned)(uintptr_t)shm;
  float*wsf=(float*)(shm+L_WS)+wid*64;
  const __attribute__((address_space(3))) float*rpbL=(const __attribute__((address_space(3))) float*)((__attribute__((address_space(3))) const char*)shm+86016);
  const int na_rq=g4+(wid>>1), na_rs=min(max(na_rq-4,0),24), na_cq=32*(wid&1)+r32;
  const unsigned na_base=(unsigned)(uintptr_t)rpbL+16u*(unsigned)hi+4u*(unsigned)(na_cq<8?112+80*na_cq:(na_cq>56?128+80*(na_cq-57):56-na_cq));
  const unsigned na_flat=(unsigned)(uintptr_t)rpbL+15u*4u*NA_STRIP+16u*(unsigned)hi;
  const bf16*ksrc=Kh+(long)lane*KP+wid*8;
  const bf16*vsrc=Vh+(long)(16*(wid&3)+(lane>>2))*VP+(wid>>2)*32+(lane&3)*8;
  const bf16*ksrc2=Kh+(long)lane*KP+(8+(wid&3))*8;
  const unsigned kdst=lds0+L_K+wid*1024, kdst2=lds0+L_K+(8+(wid&3))*1024, vdst=lds0+L_V+wid*1024;
  #define TROW(t) ((t)<n0?base0+64*(t):base1+64*((t)-n0))
  #define DMA_K(t,slot) do{ glds16(ksrc+(long)TROW(t)*KP,(unsigned)__builtin_amdgcn_readfirstlane(kdst+KO(slot))); if(DK==96) glds16(ksrc2+(long)TROW(t)*KP,(unsigned)__builtin_amdgcn_readfirstlane(kdst2+KO(slot))); }while(0)
  #define DMA_V(t,slot) glds16(vsrc+(long)TROW(t)*VP,(unsigned)__builtin_amdgcn_readfirstlane(vdst+(slot)))
  #define DMA_KN(t,slot) do{ glds16(ksrc+dKn_+(long)(b0n_+64*(t))*KP,(unsigned)__builtin_amdgcn_readfirstlane(kdst+KO(slot))); if(DK==96) glds16(ksrc2+dKn_+(long)(b0n_+64*(t))*KP,(unsigned)__builtin_amdgcn_readfirstlane(kdst2+KO(slot))); }while(0)
  #define DMA_VN(t,slot) glds16(vsrc+dVn_+(long)(b0n_+64*(t))*VP,(unsigned)__builtin_amdgcn_readfirstlane(vdst+(slot)))
  const int vb0=(int)(lds0+L_V)+((lane>>4)&1)*32+(lane&3)*8+(4*hi+((lane&15)>>2))*64;
  const char*Kbase=shm+L_K; bf16x8 kf[12];
  const lds_cptr shm3=(lds_cptr)shm; const lds_cptr kp0=shm3+L_K+hi*1024+r32*16; const lds_cptr vp0=shm3+L_V+((lane>>4)&1)*32+(lane&3)*8+(4*hi+((lane&15)>>2))*64;
  const int s1=(s0==(NSLOT-1)*SLOTB)?0:s0+SLOTB, s2=(s1==(NSLOT-1)*SLOTB)?0:s1+SLOTB;
  if(!pre){ DMA_K(0,s0);DMA_V(0,s0);DMA_K(1,s1); }
  if(!pre||!PFQ){
    #pragma unroll
    for(int d0=0;d0<ND;++d0)qr[d0]=*reinterpret_cast<const bf16x8*>(&Qw[(long)r32*QP+d0*16+hi*8]);
  }
  float z_; asm volatile("v_mov_b32 %0, 0":"=v"(z_));
  float mhat=0.f,l_reg=0.f;f32x16 o[2],negm,zero16;
  #pragma unroll
  for(int r=0;r<16;++r){o[0][r]=z_;o[1][r]=z_;negm[r]=z_;zero16[r]=z_;}
  if(!NA){asm volatile("":"+v"(negm));}
  #define CMASK(P0,P1,t) do{}while(0)
  bool resc=false, na_m0=true;
  #define START(P0,P1) do{ const float rm=rowmax(P0,P1); resc=false; \
    { float dl=rm; if(NA){ if(__builtin_expect(__any(__builtin_fabsf(rm)>(float)THRL),0)){ na_m0=false; } else { dl=0.f; } } mhat=fadd_s(mhat,dl); \
      _Pragma("unroll") for(int r=0;r<16;++r){P0[r]=fsub_s(P0[r],dl);P1[r]=fsub_s(P1[r],dl);} \
      if(!NA){ _Pragma("unroll") for(int r=0;r<16;++r)negm[r]=-mhat; asm volatile("":"+v"(negm)); } } \
    _Pragma("unroll") for(int r=0;r<16;++r)P0[r]=__builtin_amdgcn_exp2f(P0[r]); }while(0)
  #define RESC() do{ if(resc){ asm volatile("s_waitcnt lgkmcnt(0)":::"memory"); \
      _Pragma("unroll") for(int d_=0;d_<2;++d_) _Pragma("unroll") for(int r=0;r<16;++r)o[d_][r]*=wsf[crow(r,hi)]; } }while(0)
  f32x16 pA0,pA1,pB0,pB1;
  int sl_prev=s0,sl_cur=s0,sl_next=s1;
  #define ROT() do{sl_prev=sl_cur;sl_cur=sl_next;sl_next=(sl_next==(NSLOT-1)*SLOTB)?0:sl_next+SLOTB;}while(0)
  if(!pre){
    DMA_K(2,s2);
    WAIT_BARK(3,5);
  } else { if(PFQ){ WAIT_BAR(4); } else { WAIT_BAR(0); } }
  DMA_V(1,s1);
  qkt<ND>(pA0,pA1,Kbase+KO(s0),qr,zero16,r32,hi);asm volatile("s_nop 15\n\ts_nop 7":"+v"(pA0),"+v"(pA1));CMASK(pA0,pA1,0);
  START(pA0,pA1);
  _Pragma("unroll") for(int r=0;r<16;++r)pA1[r]=__builtin_amdgcn_exp2f(pA1[r]);
  if(NA){ _Pragma("unroll") for(int r=0;r<16;++r){pB0[r]=z_;pB1[r]=z_;} }
  WAIT_BAR(1);
  DMA_K(3,s0);
  ROT();
  _Pragma("unroll") for(int j_=0;j_<ND;++j_) kload2(kf,kp0+KO(sl_cur),j_);
  WAIT_BARK(2,3);
  s16x4 vlo[8],vhi[8]; u32x4 pw0,pw1,pw2,pw3;
  #define PKW(P,B) cvtpk_s(P[B],P[B+1])
  #define PAF(k) __builtin_bit_cast(bf16x8,pw##k)
  #define VFR(i) (bf16x8){vlo[i][0],vlo[i][1],vlo[i][2],vlo[i][3],vhi[i][0],vhi[i][1],vhi[i][2],vhi[i][3]}
  #define PIN(x) asm volatile("":"+v"(x))
  #define MX3(a,b,c) __builtin_fmaxf(__builtin_fmaxf((a),(b)),(c))
  #define GAPA(MF,A0,A1,A2,A3,W0,W1,PW) do{ MF; sacc+=A0; sacc+=A1; sacc+=A2; sacc+=A3; PIN(sacc); W0; W1; PIN(PW); SBAR(); }while(0)
  #define EX(v) __builtin_amdgcn_exp2f(v)
  #define GAPB(MF,X,B,FILL) do{ MF; X[B]=EX(X[B]); X[B+1]=EX(X[B+1]); X[B+2]=EX(X[B+2]); X[B+3]=EX(X[B+3]); PIN(X); FILL; SBAR(); }while(0)
  #define LDSF(x) (*(const __attribute__((address_space(3))) float*)(x))
  #define NAC(r) (4u*(unsigned)(((r)&3)+8*((r)>>2)))
  #define NAF_LD(F0,F1,g) do{ F0[2*(g)]=LDSF(na_a+NAC(2*(g))); F0[2*(g)+1]=LDSF(na_a+NAC(2*(g)+1)); F1[2*(g)]=LDSF(na_a+NAC(2*(g))+128u); F1[2*(g)+1]=LDSF(na_a+NAC(2*(g)+1)+128u); }while(0)
  #define NAF_FIN(F0,F1,g) do{ F0[2*(g)]-=mhat; F0[2*(g)+1]-=mhat; F1[2*(g)]-=mhat; F1[2*(g)+1]-=mhat; }while(0)
  #define NAF(F0,F1,g) do{ if(NA){ NAF_LD(F0,F1,g); } }while(0)
  #define VRD(i) do{ vlo[i]=vtr(vp_+(((i)>>2)*4096+((i)&3)*1024)); vhi[i]=vtr(vp_+(((i)>>2)*4096+((i)&3)*1024+512)); }while(0)
  #define KRD(G,j) do{ if(G){ kload2(kf,kp0+KO(sl_next),j); SBAR(); } }while(0)
  #define STEP(C0,C1,P0,P1,t,GK,GV,GL,NX) do{ \
    if(NA){ if(__builtin_expect(!na_m0,0)){ _Pragma("unroll") for(int r=0;r<16;++r){C0[r]-=mhat;C1[r]-=mhat;} } } \
    SBAR(); \
    const lds_cptr vp_=vp0+sl_prev; \
    VRD(0); SBAR(); float sacc=(P0[0]+P0[1]); \
    GAPA(C0=__builtin_amdgcn_mfma_f32_32x32x16_bf16(kf[0],qr[0],(NA?C0:negm),0,0,0), P0[2],P0[3],P0[4],P0[5],     pw0[0]=PKW(P0,0), pw0[1]=PKW(P0,2), pw0); \
    VRD(4); SBAR(); GAPA(C1=__builtin_amdgcn_mfma_f32_32x32x16_bf16(kf[1],qr[0],(NA?C1:negm),0,0,0), P0[6],P0[7],P0[8],P0[9],     pw0[2]=PKW(P0,4), pw0[3]=PKW(P0,6), pw0); \
    VRD(1); SBAR(); GAPA(C0=__builtin_amdgcn_mfma_f32_32x32x16_bf16(kf[2],qr[1],C0,0,0,0),   P0[10],P0[11],P0[12],P0[13], pw1[0]=PKW(P0,8), pw1[1]=PKW(P0,10), pw1); \
    VRD(5); SBAR(); GAPA(C1=__builtin_amdgcn_mfma_f32_32x32x16_bf16(kf[3],qr[1],C1,0,0,0),   P0[14],P0[15],P1[0],P1[1],   pw1[2]=PKW(P0,12),pw1[3]=PKW(P0,14), pw1); \
    VRD(2); SBAR(); GAPA(C0=__builtin_amdgcn_mfma_f32_32x32x16_bf16(kf[4],qr[2],C0,0,0,0),   P1[2],P1[3],P1[4],P1[5],     pw2[0]=PKW(P1,0), pw2[1]=PKW(P1,2), pw2); \
    VRD(6); SBAR(); GAPA(C1=__builtin_amdgcn_mfma_f32_32x32x16_bf16(kf[5],qr[2],C1,0,0,0),   P1[6],P1[7],P1[8],P1[9],     pw2[2]=PKW(P1,4), pw2[3]=PKW(P1,6), pw2); \
    VRD(3); SBAR(); GAPA(C0=__builtin_amdgcn_mfma_f32_32x32x16_bf16(kf[6],qr[3],C0,0,0,0),   P1[10],P1[11],P1[12],P1[13], pw3[0]=PKW(P1,8), pw3[1]=PKW(P1,10), pw3); \
    VRD(7); SBAR(); GAPA(C1=__builtin_amdgcn_mfma_f32_32x32x16_bf16(kf[7],qr[3],C1,0,0,0),   P1[14],P1[15],0.f,0.f,       pw3[2]=PKW(P1,12),pw3[3]=PKW(P1,14), pw3); \
    if(DK==96){ C0=__builtin_amdgcn_mfma_f32_32x32x16_bf16(kf[8],qr[4],C0,0,0,0); SBAR(); C1=__builtin_amdgcn_mfma_f32_32x32x16_bf16(kf[9],qr[4],C1,0,0,0); SBAR(); \
      C0=__builtin_amdgcn_mfma_f32_32x32x16_bf16(kf[10],qr[5],C0,0,0,0); SBAR(); C1=__builtin_amdgcn_mfma_f32_32x32x16_bf16(kf[11],qr[5],C1,0,0,0); SBAR(); } \
    l_reg+=sacc; \
    if(GK){DMA_K((t)+3,sl_cur);} if(GV){DMA_V((t)+1,sl_next);} \
    if(NX){ const long dKn_=nx.K-Kh,dVn_=nx.V-Vh; const int b0n_=nx.base0; DMA_KN(0,sl_next); DMA_VN(0,sl_next); DMA_KN(1,sl_prev); DMA_KN(2,sl_cur); } \
    CMASK(C0,C1,t); \
    { float a=MX3(C0[0],C0[1],C1[0]),b=MX3(C0[2],C0[3],C1[1]); a=MX3(a,C1[2],C1[3]); \
      _Pragma("unroll") for(int r=4;r<16;r+=4){a=MX3(a,C0[r],C0[r+1]);b=MX3(b,C0[r+2],C0[r+3]);a=MX3(a,C1[r],C1[r+1]);b=MX3(b,C1[r+2],C1[r+3]);} \
      float rm=__builtin_fmaxf(a,b); { auto rr=__builtin_amdgcn_permlane32_swap(__float_as_uint(rm),__float_as_uint(rm),false,false); rm=__builtin_fmaxf(__uint_as_float(rr[0]),__uint_as_float(rr[1])); } \
      resc=false; \
      if(__builtin_expect(__any(rm>(float)THRL),0)){ const float dl=__builtin_fmaxf(rm,0.f); mhat+=dl; \
        _Pragma("unroll") for(int r=0;r<16;++r){C0[r]-=dl;C1[r]-=dl;} \
        if(!NA){ _Pragma("unroll") for(int r=0;r<16;++r)negm[r]=-mhat; asm volatile("":"+v"(negm)); } \
        const float f=__builtin_amdgcn_exp2f(-dl); l_reg*=f; if(hi==0)wsf[r32]=f; resc=true; if(NA){na_m0=false;} } } \
    unsigned na_a=0u; if(NA){ const int tn_=(t)+1,tw_=tn_-4,kr_=lo+tw_; const bool cx_=tn_<4; \
      const bool win_=!cx_&&tw_<nwin&&kr_>=na_rs&&kr_<na_rs+8;     \
      na_a=win_?na_base+(4u*NA_STRIP)*(unsigned)(kr_-na_rq+7):na_flat+(cx_?0u:272u); asm volatile("":"+v"(na_a)); } \
    SBAR(); \
    GAPB(o[0]=__builtin_amdgcn_mfma_f32_32x32x16_bf16(PAF(0),VFR(0),o[0],0,0,0), C0,0,NAF(P0,P1,0)); \
    GAPB(o[1]=__builtin_amdgcn_mfma_f32_32x32x16_bf16(PAF(0),VFR(4),o[1],0,0,0), C0,4,NAF(P0,P1,1)); \
    KRD(GL,0); GAPB(o[0]=__builtin_amdgcn_mfma_f32_32x32x16_bf16(PAF(1),VFR(1),o[0],0,0,0), C0,8,NAF(P0,P1,2)); \
    KRD(GL,1); GAPB(o[1]=__builtin_amdgcn_mfma_f32_32x32x16_bf16(PAF(1),VFR(5),o[1],0,0,0), C0,12,NAF(P0,P1,3)); \
    KRD(GL,2); GAPB(o[0]=__builtin_amdgcn_mfma_f32_32x32x16_bf16(PAF(2),VFR(2),o[0],0,0,0), C1,0,NAF(P0,P1,4)); \
    KRD(GL,3); GAPB(o[1]=__builtin_amdgcn_mfma_f32_32x32x16_bf16(PAF(2),VFR(6),o[1],0,0,0), C1,4,NAF(P0,P1,5)); \
    if(DK==96){KRD(GL,4);} GAPB(o[0]=__builtin_amdgcn_mfma_f32_32x32x16_bf16(PAF(3),VFR(3),o[0],0,0,0), C1,8,NAF(P0,P1,6)); \
    if(DK==96){KRD(GL,5);} GAPB(o[1]=__builtin_amdgcn_mfma_f32_32x32x16_bf16(PAF(3),VFR(7),o[1],0,0,0), C1,12,NAF(P0,P1,7)); \
    }while(0)
  int t=1;
  if constexpr(DK==64){
    for(;t+3<NT;t+=2){
      STEP(pB0,pB1,pA0,pA1,t,true,true,true,false);     WAIT_BARK(2,3); RESC(); ROT();
      STEP(pA0,pA1,pB0,pB1,t+1,true,true,true,false);   WAIT_BARK(2,3); RESC(); ROT();
    }
    STEP(pB0,pB1,pA0,pA1,t,false,true,true,false);      WAIT_BAR(1); RESC(); ROT();
    STEP(pA0,pA1,pB0,pB1,t+1,false,true,true,false);    WAIT_BAR(1); RESC(); ROT();
  } else {
    for(;t+5<NT;t+=2){
      STEP(pB0,pB1,pA0,pA1,t,true,true,true,false);     WAIT_BARK(2,3); RESC(); ROT();
      STEP(pA0,pA1,pB0,pB1,t+1,true,true,true,false);   WAIT_BARK(2,3); RESC(); ROT();
    }
    #define ENDW(tt) do{ if((tt)+3<NT){WAIT_BARK(2,3);} else {WAIT_BAR(1);} }while(0)
    for(;t+1<NT;t+=2){
      STEP(pB0,pB1,pA0,pA1,t,(t+3<NT),(t+1<NT),(t+1<NT),false);       ENDW(t);   RESC(); ROT();
      STEP(pA0,pA1,pB0,pB1,t+1,(t+4<NT),(t+2<NT),(t+2<NT),false);     ENDW(t+1); RESC(); ROT();
    }
    #undef ENDW
  }
  STEP(pB0,pB1,pA0,pA1,NT-1,false,false,false,nx.on);
  if(nx.on){ WAIT_BARK(4,7); } else { WAIT_BAR(0); }
  RESC();
  { float sacc=pB0[0]+pB0[1]; _Pragma("unroll") for(int r=2;r<16;++r)sacc+=pB0[r]; _Pragma("unroll") for(int r=0;r<16;++r)sacc+=pB1[r]; l_reg+=sacc;
    pw0=(u32x4){PKW(pB0,0),PKW(pB0,2),PKW(pB0,4),PKW(pB0,6)};pw1=(u32x4){PKW(pB0,8),PKW(pB0,10),PKW(pB0,12),PKW(pB0,14)};pw2=(u32x4){PKW(pB1,0),PKW(pB1,2),PKW(pB1,4),PKW(pB1,6)};pw3=(u32x4){PKW(pB1,8),PKW(pB1,10),PKW(pB1,12),PKW(pB1,14)};
    SBAR(); pv(o,vb0+sl_cur,PAF(0),PAF(1),PAF(2),PAF(3)); }
  if(PFQ&&nx.on){ const bf16*Qn=nx.Q+(long)(nx.qrow0+wid*QBLK)*QP;
    #pragma unroll
    for(int d0=0;d0<ND;++d0)qr[d0]=*reinterpret_cast<const bf16x8*>(&Qn[(long)r32*QP+d0*16+hi*8]); }
  #undef PKW
  #undef PAF
  #undef VFR
  #undef PIN
  #undef MX3
  #undef GAPA
  #undef GAPB
  #undef NAF
  #undef NAF_LD
  #undef NAF_FIN
  #undef NAC
  #undef LDSF
  #undef EX
  #undef VRD
  #undef KRD
  #undef STEP
  {auto rr=__builtin_amdgcn_permlane32_swap(__float_as_uint(l_reg),__float_as_uint(l_reg),false,false);l_reg=__uint_as_float(rr[0])+__uint_as_float(rr[1]);}
  if(hi==0)wsf[32+r32]=l_reg;asm volatile("s_waitcnt lgkmcnt(0)":::"memory");
  float rli[16];
  #pragma unroll
  for(int r=0;r<16;++r)rli[r]=__builtin_amdgcn_rcpf(wsf[32+crow(r,hi)]);
  bf16*Ow=Ow0+(long)(qrow0+wid*QBLK)*1024;
  { bf16*stg=(bf16*)(shm+L_OST)+wid*2048;
    #pragma unroll
    for(int r=0;r<16;++r){const int orow=crow(r,hi);
      #pragma unroll
      for(int d0=0;d0<2;++d0)stg[orow*64+d0*32+r32]=__float2bfloat16(o[d0][r]*rli[r]);}
    asm volatile("s_waitcnt lgkmcnt(0)":::"memory");
    #pragma unroll
    for(int i=0;i<4;++i){const int row=i*8+(lane>>3),ch=lane&7; const u32x4 v=*(const u32x4*)(stg+row*64+ch*8); ATTN_STORE16(Ow+(long)row*1024+ch*8,v);} }
  if(nx.on){ asm volatile("s_waitcnt lgkmcnt(0)":::"memory"); } else { asm volatile("s_waitcnt lgkmcnt(0)\n\ts_barrier":::"memory"); }
  #undef DMA_K
  #undef DMA_KN
  #undef DMA_VN
  #undef KO
  #undef WAIT_BARK
  #undef TROW
  #undef DMA_V
  #undef CMASK
  #undef START
  #undef RESC
  #undef ROT
  return sl_next;
}
constexpr int ATTN_LDS_BYTES=LDS_BYTES;
#undef SBAR
#undef WAIT_BAR
}
#define XB_TMO      128
#define XB_XCNT(j)  (256  + 64 * (j))
#define XB_XSUB(j)  (1280 + 64 * (j))
#define XB_XGEN(j)  (2304 + 64 * (j))
#define XB_TOP      3328
#define XB_TOPGEN   3392
#define XCD_BAR_WORDS 3456
#define XB_SPIN_CAP (1u << 18)
__device__ __forceinline__ unsigned xb_ld(unsigned* p)              { return __hip_atomic_load(p, __ATOMIC_RELAXED, __HIP_MEMORY_SCOPE_AGENT); }
__device__ __forceinline__ unsigned xb_add(unsigned* p, unsigned v) { return __hip_atomic_fetch_add(p, v, __ATOMIC_RELAXED, __HIP_MEMORY_SCOPE_AGENT); }
__device__ __forceinline__ unsigned xb_xcc_id() { return (unsigned)__builtin_amdgcn_s_getreg((3 << 11) | 20) & 0xFu; }
#define XB_SPIN(cond, bar) do { unsigned _sp = 0; while (cond) { __builtin_amdgcn_s_sleep(1); \
    if ((++_sp & 255u) == 0u) { if (xb_ld(&(bar)[XB_TMO])) break; if (_sp > XB_SPIN_CAP) { atomicAdd(&(bar)[XB_TMO], 1u); break; } } } } while (0)
struct XcdBarrier { unsigned* bar; unsigned x; volatile LAS unsigned* st; };
__device__ __forceinline__ XcdBarrier xcd_barrier_post(unsigned* bar, volatile LAS unsigned* st) {
    XcdBarrier b; b.bar = bar; b.x = xb_xcc_id(); b.st = st;
    if (threadIdx.x == 0) (void)xb_add(&bar[XB_XCNT(b.x)], 1u);
    return b;
}
__device__ __forceinline__ void xcd_barrier_complete(unsigned* bar, unsigned x, unsigned& nloc, unsigned& nx) {
    const unsigned G = gridDim.x * gridDim.y * gridDim.z;
    unsigned sum, cnt, mine, sp = 0u;
    for (;;) {
        sum = 0u; cnt = 0u; mine = 0u;
#pragma unroll
        for (unsigned j = 0; j < 16; ++j) { const unsigned c = xb_ld(&bar[XB_XCNT(j)]); sum += c; cnt += (c > 0u) ? 1u : 0u; mine = (j == x) ? c : mine; }
        if (sum == G) break;
        __builtin_amdgcn_s_sleep(1);
        if ((++sp & 255u) == 0u) { if (xb_ld(&bar[XB_TMO])) break; if (sp > XB_SPIN_CAP) { atomicAdd(&bar[XB_TMO], 1u); break; } }
    }
    nloc = mine > 0u ? mine : 1u; nx = cnt > 0u ? cnt : 1u;
}
__device__ __forceinline__ void xcd_barrier(const XcdBarrier& b) {
    asm volatile("s_waitcnt vmcnt(0)" ::: "memory");
    __syncthreads();
    if (threadIdx.x == 0) {
        unsigned* bar = b.bar;
        __builtin_amdgcn_s_waitcnt(0);
        unsigned nloc = b.st[0], nx = b.st[1];
        if (nloc == 0u) { xcd_barrier_complete(bar, b.x, nloc, nx); b.st[0] = nloc; b.st[1] = nx; }
        const unsigned old = xb_add(&bar[XB_XSUB(b.x)], 1u);
        const unsigned gen = old / nloc;
        if (old + 1u == (gen + 1u) * nloc) {
            __builtin_amdgcn_fence(__ATOMIC_RELEASE, "agent");
            asm volatile("s_waitcnt vmcnt(0)" ::: "memory");
            const unsigned og = xb_add(&bar[XB_TOP], 1u);
            const unsigned tg = og / nx;
            if (og + 1u == (tg + 1u) * nx) xb_add(&bar[XB_TOPGEN], 1u);
            else XB_SPIN(xb_ld(&bar[XB_TOPGEN]) == tg, bar);
            __builtin_amdgcn_fence(__ATOMIC_ACQUIRE, "agent");
            asm volatile("s_waitcnt vmcnt(0)" ::: "memory");
        } else {
            XB_SPIN(xb_ld(&bar[XB_TOPGEN]) == gen, bar);
            __builtin_amdgcn_fence(__ATOMIC_ACQUIRE, "agent");
            asm volatile("s_waitcnt vmcnt(0)" ::: "memory");
        }
    }
    __syncthreads();
}

struct Args { const float* in[30]; float* out; unsigned char* ws; int ph_lo, ph_hi; };
enum { I_X = 0, I_C, I_CTX, I_CCTX, I_ADAW, I_ADAB, I_N1W, I_N2W, I_AWQKV, I_AQN, I_AKN, I_AWO, I_BWDQ, I_BQNL, I_BWUQ, I_BWDKV, I_BKVNL, I_BWUKV, I_BQN, I_BKN, I_BWO,
       I_CWQKV, I_CQN, I_CKN, I_CRPB, I_CWO, I_ROUTER, I_WG, I_WU, I_WD };
struct Frame {
    LAS unsigned char* lds; char* ldsg;
    int wave, vcu, G, gw, NGW;
    const float* const* in; float* out; unsigned char* ws;
};
__device__ __forceinline__ unsigned opq32(unsigned o) { asm volatile("" : "+v"(o)); return (unsigned)__builtin_amdgcn_readfirstlane((int)o); }
#define FWS(off, T) ((T*)(F.ws + (size_t)opq32((unsigned)(off))))
#define XB_ROW(r) ((r) < RL ? (bf16*)F.out + (size_t)(r) * 2048 + 1024 : FWS(WS_XC, bf16) + (size_t)((r) - RL) * 1024)
__device__ __forceinline__ f32x4 bf4_to_f32(u32x2 q) { return (f32x4){__builtin_bit_cast(float, q.x << 16), __builtin_bit_cast(float, q.x & 0xffff0000u), __builtin_bit_cast(float, q.y << 16), __builtin_bit_cast(float, q.y & 0xffff0000u)}; }
#define PHASE_IDS() int tid_ = threadIdx.x; asm volatile("" : "+v"(tid_)); const int tid = tid_, lane = tid & 63; (void)lane

struct WSrc { const float* W; int ld; int col0; int perm; const float* ks; };
struct PrepJob { WSrc s; int K, G, kb; bf16* Bt; };
__device__ __forceinline__ PrepJob prep_decode(const float* const* in, unsigned char* ws, int it) {
    constexpr int J0 = 768, J1 = J0 + 768, J2 = J1 + 512, J3 = J2 + 512, J4 = J3 + 384, J5 = J4 + 288, J6 = J5 + 256, J7 = J6 + 512, J8 = J7 + 1536, J9 = J8 + 512;
    constexpr int NSMALL = J9;
    bf16* WSB = (bf16*)(ws + WS_WS);
    PrepJob j; WSrc& s = j.s; s.ks = nullptr; s.perm = 1; j.K = 1024; int G, kb; bf16* Bt;
    if (it >= NSMALL) {
        int r = it - NSMALL; const int l = r / 24576; r -= l * 24576;
        if (r < 16384) { G = r >> 4; kb = r & 15; const int e = G >> 6, g = G & 63, pn = g >> 3, bj = (g >> 2) & 1, wc = g & 3;
            s.W = (bj ? in[I_WU] : in[I_WG]) + (size_t)(l * 16 + e) * 1048576; s.ld = 1024; s.col0 = 128 * pn + 32 * wc; Bt = (bf16*)(ws + WS_WMOE + (size_t)l * 96 * MiB); }
        else { r -= 16384; G = r >> 4; kb = r & 15; const int e = G >> 5, g = G & 31;
            s.W = in[I_WD] + (size_t)(l * 16 + e) * 1048576; s.ld = 1024; s.col0 = 32 * g; Bt = (bf16*)(ws + WS_WMOE + (size_t)l * 96 * MiB + 64 * MiB); }
    } else if (it < J1) { const int inst = it >= J0; const int r = it - inst * J0; G = r >> 4; kb = r & 15; const int pn = G >> 3, bj = (G >> 2) & 1, wc = G & 3;
        s.W = in[I_AWQKV] + (size_t)inst * 1024 * 1536; s.ld = 1536; s.col0 = 64 * (4 * pn + wc) + 32 * bj; Bt = WSB + (inst ? WO_AQKV1 : WO_AQKV0) / 2; }
    else if (it < J3) { const int inst = it >= J2; const int r = it - (inst ? J2 : J1); G = r >> 4; kb = r & 15;
        s.W = in[I_AWO] + (size_t)inst * 1048576; s.ld = 1024; s.col0 = 32 * G; Bt = WSB + (inst ? WO_AWO1 : WO_AWO0) / 2; }
    else if (it < J4) { const int r = it - J3; G = r >> 4; kb = r & 15; Bt = WSB + WO_BDN / 2;
        if (G < 12) { s.W = in[I_BWDQ]; s.ld = 384; s.col0 = 32 * G; }
        else if (G == 12) { s.W = in[I_BWDKV]; s.ld = 288; s.col0 = 256; s.perm = 0; }
        else if (G < 16) { s.W = nullptr; s.ld = 0; s.col0 = 0; }
        else { s.W = in[I_BWDKV]; s.ld = 288; s.col0 = 32 * (G - 16); } }
    else if (it < J5) { const int r = it - J4; G = r / 6; kb = r % 6; j.K = 384; Bt = WSB + WO_BUQ / 2; s.W = in[I_BWUQ]; s.ld = 1536; s.ks = in[I_BQNL];
        if (G < 32) { const int pn = G >> 3, bj = (G >> 2) & 1, wc = G & 3; s.col0 = 96 * (4 * pn + wc) + 32 * bj; }
        else { const int g = G - 32, pn = g >> 3, bj = (g >> 2) & 1, wc = g & 3; s.col0 = 96 * (8 * pn + 4 * bj + wc) + 64; s.perm = 0; } }
    else if (it < J6) { const int r = it - J5; G = r >> 2; kb = r & 3; j.K = 256; Bt = WSB + WO_BUKV / 2; s.W = in[I_BWUKV]; s.ld = 2048; s.ks = in[I_BKVNL];
        if (G < 32) { const int pn = G >> 3, bj = (G >> 2) & 1, wc = G & 3; s.col0 = 128 * (4 * pn + wc) + 32 * bj; }
        else { const int g = G - 32, pn = g >> 3, bj = (g >> 2) & 1, wc = g & 3; s.col0 = 128 * (4 * pn + wc) + 64 + 32 * bj; } }
    else if (it < J7) { const int r = it - J6; G = r >> 4; kb = r & 15; s.W = in[I_BWO]; s.ld = 1024; s.col0 = 32 * G; Bt = WSB + WO_BWO / 2; }
    else if (it < J8) { const int r = it - J7; G = r >> 4; kb = r & 15; const int pn = G >> 3, bj = (G >> 2) & 1, wc = G & 3;
        s.W = in[I_CWQKV]; s.ld = 3072; s.col0 = 64 * (4 * pn + wc) + 32 * bj; Bt = WSB + WO_CQKV / 2; }
    else { const int r = it - J8; G = r >> 4; kb = r & 15; s.W = in[I_CWO]; s.ld = 1024; s.col0 = 32 * G; Bt = WSB + WO_CWO / 2; }
    j.G = G; j.kb = kb; j.Bt = Bt; return j;
}
__device__ __forceinline__ void prep_load(const PrepJob& j, f32x4 (&v)[8], int lane) {
    const int k0 = 64 * j.kb;
#pragma unroll
    for (int i = 0; i < 8; ++i) { const int kk = 8 * i + (lane >> 3);
        if (j.s.W) { f32x4 x = *(const f32x4*)(j.s.W + (size_t)(k0 + kk) * j.s.ld + j.s.col0 + 4 * (lane & 7)); if (j.s.ks) x = x * j.s.ks[k0 + kk]; v[i] = x; }
        else v[i] = (f32x4){0.f, 0.f, 0.f, 0.f}; }
}
__device__ __forceinline__ void prep_store(const PrepJob& j, const f32x4 (&v)[8], LAS float* scr, int lane) {
    const int k0 = 64 * j.kb;
#pragma unroll
    for (int i = 0; i < 8; ++i) { const int kk = 8 * i + (lane >> 3); LAS float* d = scr + kk * 33 + 4 * (lane & 7); d[0] = v[i][0]; d[1] = v[i][1]; d[2] = v[i][2]; d[3] = v[i][3]; }
    LDS_WAIT(); asm volatile("" ::: "memory");
    const int c = lane & 7;
#pragma unroll
    for (int q = 0; q < 4; ++q) { const int n = (lane >> 3) + 8 * q; const int sn = j.s.perm ? pg8::perm32(n) : n; const LAS float* sp = scr + (8 * c) * 33 + sn;
        u32x4 o; o.x = cvt_pk_bf16(sp[0 * 33], sp[1 * 33]); o.y = cvt_pk_bf16(sp[2 * 33], sp[3 * 33]); o.z = cvt_pk_bf16(sp[4 * 33], sp[5 * 33]); o.w = cvt_pk_bf16(sp[6 * 33], sp[7 * 33]);
        *(u32x4*)(j.Bt + (size_t)(32 * j.G + n) * j.K + k0 + 8 * c) = o; }
    LDS_WAIT(); asm volatile("" ::: "memory");
}
__device__ __forceinline__ void p0_prologue(Frame& F) {
    PHASE_IDS();
    const float* const* in = F.in;
    {
        LAS float* sv = (LAS float*)F.lds;
        float* MODP = FWS(WS_MODP, float);
        for (int it = blockIdx.x; it < 4 * 12 * 8; it += F.G) {
            const int kc = it & 7, nb = (it >> 3) % 12, l = it / 96;
            for (int u = tid; u < 17 * 128; u += NTHR) { const int bi = u >> 7, k = kc * 128 + (u & 127); const float cv = bi < 16 ? in[I_C][bi * 1024 + k] : in[I_CCTX][k]; sv[u] = cv / (1.f + expf(-cv)); }
            __syncthreads();
            const int n = nb * 512 + tid; const float* W = in[I_ADAW] + ((size_t)l * 1024 + kc * 128) * 6144 + n;
            float acc[17];
#pragma unroll
            for (int bi = 0; bi < 17; ++bi) acc[bi] = 0.f;
            for (int k8 = 0; k8 < 128; k8 += 16) {
                float w[16];
#pragma unroll
                for (int k = 0; k < 16; ++k) w[k] = W[(size_t)(k8 + k) * 6144];
#pragma unroll
                for (int k = 0; k < 16; ++k)
#pragma unroll
                    for (int bi = 0; bi < 17; ++bi) acc[bi] += sv[bi * 128 + k8 + k] * w[k];
            }
#pragma unroll
            for (int bi = 0; bi < 17; ++bi) MODP[((size_t)(kc * 4 + l) * 17 + bi) * 6144 + n] = acc[bi];
            __syncthreads();
        }
    }
    {
        LAS float* scr = (LAS float*)(F.lds + F.wave * 8448);
        constexpr int NITEMS = 6048;
        for (int base = F.gw; base < NITEMS; base += 4 * F.NGW) {
            PrepJob j0 = prep_decode(in, F.ws, base), j1, j2, j3; const int i1 = base + F.NGW, i2 = base + 2 * F.NGW, i3 = base + 3 * F.NGW;
            const bool h1 = i1 < NITEMS, h2 = i2 < NITEMS, h3 = i3 < NITEMS;
            f32x4 v0[8], v1[8], v2[8], v3[8];
            prep_load(j0, v0, lane);
            if (h1) { j1 = prep_decode(in, F.ws, i1); prep_load(j1, v1, lane); }
            if (h2) { j2 = prep_decode(in, F.ws, i2); prep_load(j2, v2, lane); }
            if (h3) { j3 = prep_decode(in, F.ws, i3); prep_load(j3, v3, lane); }
            prep_store(j0, v0, scr, lane);
            if (h1) prep_store(j1, v1, scr, lane);
            if (h2) prep_store(j2, v2, scr, lane);
            if (h3) prep_store(j3, v3, scr, lane);
        }
    }
    {
        float* RA = FWS(WS_ROPE, float); float* RB = RA + 2 * 2048 * 32;
        const int gt = F.gw * 64 + lane, NT_ = F.NGW * 64;
        for (int i = gt; i < 2048 * 32; i += NT_) { const int t = i >> 5, d = i & 31; const float inv = powf(10000.f, -(float)(d & 15) / 16.f); const float pos = (float)(d < 16 ? (t >> 6) : (t & 63));
            const float a = pos * inv; RA[i] = cosf(a); RA[2048 * 32 + i] = sinf(a); }
        for (int i = gt; i < 2048 * 16; i += NT_) { const int t = i >> 4, d = i & 15; const float inv = powf(10000.f, -(float)(d & 7) / 8.f); const float pos = (float)(d < 8 ? (t >> 6) : (t & 63));
            const float a = pos * inv; RB[i] = cosf(a); RB[2048 * 16 + i] = sinf(a); }
    }
}
__device__ __forceinline__ void p1_modreduce(Frame& F) {
    PHASE_IDS();
    const float* MODP = FWS(WS_MODP, float); float* MOD = FWS(WS_MOD, float);
    const int gt = F.gw * 64 + lane, NT_ = F.NGW * 64;
    for (int i = gt; i < 4 * 17 * 6144; i += NT_) {
        const int l = i / (17 * 6144), rem = i - l * 17 * 6144, bi = rem / 6144, n = rem - bi * 6144;
        float v = F.in[I_ADAB][l * 6144 + n];
#pragma unroll
        for (int kc = 0; kc < 8; ++kc) v += MODP[((size_t)(kc * 4 + l) * 17 + bi) * 6144 + n];
        const int ch = n >> 10, nn = n & 1023;
        if (ch == 1) v = F.in[I_N1W][l * 1024 + nn] * (1.f + v);
        if (ch == 4) v = F.in[I_N2W][l * 1024 + nn] * (1.f + v);
        MOD[i] = v;
    }
}

__device__ __forceinline__ int slot_of(int row, int e, int s) { return e * SLOTS_E + (row < RL ? (row >> 11) * 256 + s : 4096 + ((row - RL) >> 8) * 32 + s); }
__device__ __forceinline__ void gather_y2(const bf16* Y, int r0, int r1, int inv0, int inv1, bool ok1, int lane, f32x4 (&a0)[4], f32x4 (&a1)[4]) {
    unsigned m0 = (unsigned)__ballot(lane < 16 && inv0 >= 0) & 0xffffu, m1 = ok1 ? ((unsigned)__ballot(lane < 16 && inv1 >= 0) & 0xffffu) : 0u;
    while (m0 | m1) {
        const bool h0 = m0 != 0u, h1 = m1 != 0u;
        const int e0 = h0 ? __builtin_ctz(m0) : 0, e1 = h1 ? __builtin_ctz(m1) : 0;
        m0 &= m0 - 1u; m1 &= m1 - 1u;
        const int s0 = __builtin_amdgcn_readlane(inv0, e0), s1 = __builtin_amdgcn_readlane(inv1, e1);
        const int sl0 = h0 ? slot_of(r0, e0, s0) : 0, sl1 = h1 ? slot_of(r1, e1, s1) : 0;
        const float w0 = h0 ? 1.f : 0.f, w1 = h1 ? 1.f : 0.f;
        const bf16* y0 = Y + (size_t)sl0 * 1024 + 4 * lane; const bf16* y1 = Y + (size_t)sl1 * 1024 + 4 * lane;
        u32x2 q0[4], q1[4];
#pragma unroll
        for (int j = 0; j < 4; ++j) { q0[j] = *(const u32x2*)(y0 + 256 * j); q1[j] = *(const u32x2*)(y1 + 256 * j); }
#pragma unroll
        for (int j = 0; j < 4; ++j) {
            a0[j][0] += w0 * bf2f(q0[j].x & 0xffffu); a0[j][1] += w0 * bf2f(q0[j].x >> 16); a0[j][2] += w0 * bf2f(q0[j].y & 0xffffu); a0[j][3] += w0 * bf2f(q0[j].y >> 16);
            a1[j][0] += w1 * bf2f(q1[j].x & 0xffffu); a1[j][1] += w1 * bf2f(q1[j].x >> 16); a1[j][2] += w1 * bf2f(q1[j].y & 0xffffu); a1[j][3] += w1 * bf2f(q1[j].y >> 16);
        }
    }
}
template <int L> __device__ __forceinline__ void norm1_phase(Frame& F) {
    PHASE_IDS();
    const float* MOD = FWS(WS_MOD, float); bf16* H = FWS(WS_H, bf16); const int* INV = FWS(WS_INV, int); const bf16* Y = FWS(WS_ACT + AO_Y, bf16); float* XC = FWS(WS_XC, float);
    const bf16* WOUT = FWS(WS_WOUT, bf16);
    for (int rb = F.gw; rb < RT; rb += 2 * F.NGW) {
        const int r0 = rb, r1c = rb + F.NGW; const bool ok1 = r1c < RT; const int r1 = ok1 ? r1c : rb;
        const int bi0 = r0 < RL ? (r0 >> 11) : 16, bi1 = r1 < RL ? (r1 >> 11) : 16;
        f32x4 v0[4], v1[4];
        if (L <= 1) {
            const float* xs0 = r0 < RL ? F.in[I_X] + (size_t)r0 * D : F.in[I_CTX] + (size_t)(r0 - RL) * D;
            const float* xs1 = r1 < RL ? F.in[I_X] + (size_t)r1 * D : F.in[I_CTX] + (size_t)(r1 - RL) * D;
#pragma unroll
            for (int j = 0; j < 4; ++j) { v0[j] = *(const f32x4*)(xs0 + 4 * lane + 256 * j); v1[j] = *(const f32x4*)(xs1 + 4 * lane + 256 * j); }
        } else {
            const bf16* xs0 = XB_ROW(r0); const bf16* xs1 = XB_ROW(r1);
            u32x2 q0[4], q1[4];
#pragma unroll
            for (int j = 0; j < 4; ++j) { q0[j] = *(const u32x2*)(xs0 + 4 * lane + 256 * j); q1[j] = *(const u32x2*)(xs1 + 4 * lane + 256 * j); }
#pragma unroll
            for (int j = 0; j < 4; ++j) { v0[j] = bf4_to_f32(q0[j]); v1[j] = bf4_to_f32(q1[j]); }
        }
        if (L > 0) {
            const int inv0 = INV[(size_t)r0 * 16 + (lane & 15)], inv1 = INV[(size_t)r1 * 16 + (lane & 15)];
            f32x4 a0[4], a1[4];
#pragma unroll
            for (int j = 0; j < 4; ++j) { a0[j] = (f32x4){0.f, 0.f, 0.f, 0.f}; a1[j] = (f32x4){0.f, 0.f, 0.f, 0.f}; }
            u32x2 wq0[4], wq1[4];
#pragma unroll
            for (int j = 0; j < 4; ++j) { wq0[j] = *(const u32x2*)(WOUT + (size_t)r0 * D + 4 * lane + 256 * j); wq1[j] = *(const u32x2*)(WOUT + (size_t)r1 * D + 4 * lane + 256 * j); }
            gather_y2(Y, r0, r1, inv0, inv1, ok1, lane, a0, a1);
            const float* m50 = MOD + ((size_t)(L - 1) * 17 + bi0) * 6144 + 5 * 1024 + 4 * lane; const float* m51 = MOD + ((size_t)(L - 1) * 17 + bi1) * 6144 + 5 * 1024 + 4 * lane;
            bf16* xd0 = XB_ROW(r0); bf16* xd1 = XB_ROW(r1);
#pragma unroll
            for (int j = 0; j < 4; ++j) { const f32x4 w = (f32x4){bf2f(wq0[j].x & 0xffffu), bf2f(wq0[j].x >> 16), bf2f(wq0[j].y & 0xffffu), bf2f(wq0[j].y >> 16)};
                v0[j] += w + *(const f32x4*)(m50 + 256 * j) * a0[j]; u32x2 xw; xw.x = cvt_pk_bf16(v0[j][0], v0[j][1]); xw.y = cvt_pk_bf16(v0[j][2], v0[j][3]); *(u32x2*)(xd0 + 4 * lane + 256 * j) = xw; }
            if (ok1) {
#pragma unroll
                for (int j = 0; j < 4; ++j) { const f32x4 w = (f32x4){bf2f(wq1[j].x & 0xffffu), bf2f(wq1[j].x >> 16), bf2f(wq1[j].y & 0xffffu), bf2f(wq1[j].y >> 16)};
                    v1[j] += w + *(const f32x4*)(m51 + 256 * j) * a1[j]; u32x2 xw; xw.x = cvt_pk_bf16(v1[j][0], v1[j][1]); xw.y = cvt_pk_bf16(v1[j][2], v1[j][3]); *(u32x2*)(xd1 + 4 * lane + 256 * j) = xw; } }
        }
        const float ss0 = (sum4sq(v0[0]) + sum4sq(v0[1])) + (sum4sq(v0[2]) + sum4sq(v0[3])), ss1 = (sum4sq(v1[0]) + sum4sq(v1[1])) + (sum4sq(v1[2]) + sum4sq(v1[3]));
        const float rinv0 = rsqrtf(wave_sum(ss0) * (1.f / D) + EPS), rinv1 = rsqrtf(wave_sum(ss1) * (1.f / D) + EPS);
        const float* ml0 = MOD + ((size_t)L * 17 + bi0) * 6144 + 4 * lane; const float* ml1 = MOD + ((size_t)L * 17 + bi1) * 6144 + 4 * lane;
        bf16* hp0 = H + (size_t)r0 * D + 4 * lane; bf16* hp1 = H + (size_t)r1 * D + 4 * lane;
#pragma unroll
        for (int j = 0; j < 4; ++j) { const f32x4 sh = *(const f32x4*)(ml0 + 256 * j), a1_ = *(const f32x4*)(ml0 + 1024 + 256 * j); const f32x4 h = v0[j] * rinv0 * a1_ + sh;
            u32x2 w; w.x = cvt_pk_bf16(h[0], h[1]); w.y = cvt_pk_bf16(h[2], h[3]); *(u32x2*)(hp0 + 256 * j) = w; }
        if (ok1) {
#pragma unroll
            for (int j = 0; j < 4; ++j) { const f32x4 sh = *(const f32x4*)(ml1 + 256 * j), a1_ = *(const f32x4*)(ml1 + 1024 + 256 * j); const f32x4 h = v1[j] * rinv1 * a1_ + sh;
                u32x2 w; w.x = cvt_pk_bf16(h[0], h[1]); w.y = cvt_pk_bf16(h[2], h[3]); *(u32x2*)(hp1 + 256 * j) = w; } }
    }
}
__device__ __forceinline__ void final_phase(Frame& F) {
    PHASE_IDS();
    const float* MOD = FWS(WS_MOD, float); const int* INV = FWS(WS_INV, int); const bf16* Y = FWS(WS_ACT + AO_Y, bf16);
    for (int rb = F.gw; rb < RL; rb += 2 * F.NGW) {
        const int r0 = rb, r1c = rb + F.NGW; const bool ok1 = r1c < RL; const int r1 = ok1 ? r1c : rb;
        float* xs0 = F.out + (size_t)r0 * D; float* xs1 = F.out + (size_t)r1 * D;
        f32x4 v0[4], v1[4];
        { const bf16* xb0 = XB_ROW(r0); const bf16* xb1 = XB_ROW(r1); u32x2 q0[4], q1[4];
#pragma unroll
          for (int j = 0; j < 4; ++j) { q0[j] = *(const u32x2*)(xb0 + 4 * lane + 256 * j); q1[j] = *(const u32x2*)(xb1 + 4 * lane + 256 * j); }
#pragma unroll
          for (int j = 0; j < 4; ++j) { v0[j] = bf4_to_f32(q0[j]); v1[j] = bf4_to_f32(q1[j]); } }
        const int inv0 = INV[(size_t)r0 * 16 + (lane & 15)], inv1 = INV[(size_t)r1 * 16 + (lane & 15)];
        f32x4 a0[4], a1[4];
#pragma unroll
        for (int j = 0; j < 4; ++j) { a0[j] = (f32x4){0.f, 0.f, 0.f, 0.f}; a1[j] = (f32x4){0.f, 0.f, 0.f, 0.f}; }
        const bf16* WOUT = FWS(WS_WOUT, bf16);
        u32x2 wq0[4], wq1[4];
#pragma unroll
        for (int j = 0; j < 4; ++j) { wq0[j] = *(const u32x2*)(WOUT + (size_t)r0 * D + 4 * lane + 256 * j); wq1[j] = *(const u32x2*)(WOUT + (size_t)r1 * D + 4 * lane + 256 * j); }
        gather_y2(Y, r0, r1, inv0, inv1, ok1, lane, a0, a1);
        const float* m50 = MOD + ((size_t)3 * 17 + (r0 >> 11)) * 6144 + 5 * 1024 + 4 * lane; const float* m51 = MOD + ((size_t)3 * 17 + (r1 >> 11)) * 6144 + 5 * 1024 + 4 * lane;
        asm volatile("s_waitcnt vmcnt(0)" ::: "memory");
#pragma unroll
        for (int j = 0; j < 4; ++j) { const f32x4 w = (f32x4){bf2f(wq0[j].x & 0xffffu), bf2f(wq0[j].x >> 16), bf2f(wq0[j].y & 0xffffu), bf2f(wq0[j].y >> 16)};
            *(f32x4*)(xs0 + 4 * lane + 256 * j) = v0[j] + w + *(const f32x4*)(m50 + 256 * j) * a0[j]; }
        if (ok1) {
#pragma unroll
            for (int j = 0; j < 4; ++j) { const f32x4 w = (f32x4){bf2f(wq1[j].x & 0xffffu), bf2f(wq1[j].x >> 16), bf2f(wq1[j].y & 0xffffu), bf2f(wq1[j].y >> 16)};
                *(f32x4*)(xs1 + 4 * lane + 256 * j) = v1[j] + w + *(const f32x4*)(m51 + 256 * j) * a1[j]; } }
    }
}
__device__ __forceinline__ float red16(const float (&lg)[16], int lane) {
    const bool b5 = lane & 32, b4 = lane & 16, b3 = lane & 8, b2 = lane & 4;
    float t8[8], t4[4], t2[2];
#pragma unroll
    for (int j = 0; j < 8; ++j) { const float snd = b5 ? lg[j] : lg[j + 8], kp = b5 ? lg[j + 8] : lg[j]; t8[j] = kp + __shfl_xor(snd, 32); }
#pragma unroll
    for (int j = 0; j < 4; ++j) { const float snd = b4 ? t8[j] : t8[j + 4], kp = b4 ? t8[j + 4] : t8[j]; t4[j] = kp + __shfl_xor(snd, 16); }
#pragma unroll
    for (int j = 0; j < 2; ++j) { const float snd = b3 ? t4[j] : t4[j + 2], kp = b3 ? t4[j + 2] : t4[j]; t2[j] = kp + __shfl_xor(snd, 8); }
    float t1; { const float snd = b2 ? t2[0] : t2[1], kp = b2 ? t2[1] : t2[0]; t1 = kp + __shfl_xor(snd, 4); }
    t1 += __shfl_xor(t1, 2); t1 += __shfl_xor(t1, 1);
    return t1;
}
template <int L> __device__ __forceinline__ void norm2_phase(Frame& F, int NR) {
    PHASE_IDS();
    const float* MOD = FWS(WS_MOD, float); bf16* H = FWS(WS_H, bf16); float* AFF = FWS(WS_AFF, float); const float* XC = FWS(WS_XC, float); const bf16* WOUT = FWS(WS_WOUT, bf16);
    LAS float* RL_ = (LAS float*)F.lds;
    const float* rt = F.in[I_ROUTER] + (size_t)L * 1024 * 16;
    unsigned xa[16], xb[16]; unsigned wa[16], wb[16];
#define N2_LOAD(rbase) do { const int q0_ = (rbase), q1c_ = (rbase) + F.NGW; const int q1_ = q1c_ < NR ? q1c_ : q0_; \
        const bf16* w0_ = WOUT + (size_t)q0_ * D + lane; const bf16* w1_ = WOUT + (size_t)q1_ * D + lane; \
        if (L == 0) { \
            const float* s0_ = (q0_ < RL ? F.in[I_X] + (size_t)q0_ * D : F.in[I_CTX] + (size_t)(q0_ - RL) * D) + lane; \
            const float* s1_ = (q1_ < RL ? F.in[I_X] + (size_t)q1_ * D : F.in[I_CTX] + (size_t)(q1_ - RL) * D) + lane; \
            _Pragma("unroll") for (int i = 0; i < 16; ++i) { xa[i] = __float_as_uint(s0_[64 * i]); wa[i] = (unsigned)((const unsigned short*)w0_)[64 * i]; xb[i] = __float_as_uint(s1_[64 * i]); wb[i] = (unsigned)((const unsigned short*)w1_)[64 * i]; } \
        } else { \
            const unsigned short* s0_ = (const unsigned short*)XB_ROW(q0_) + lane; const unsigned short* s1_ = (const unsigned short*)XB_ROW(q1_) + lane; \
            _Pragma("unroll") for (int i = 0; i < 16; ++i) { xa[i] = (unsigned)s0_[64 * i]; wa[i] = (unsigned)((const unsigned short*)w0_)[64 * i]; xb[i] = (unsigned)s1_[64 * i]; wb[i] = (unsigned)((const unsigned short*)w1_)[64 * i]; } \
        } } while (0)
    if (F.gw < NR) N2_LOAD(F.gw);
    for (int u = tid; u < 4096; u += NTHR) { const f32x4 w = *(const f32x4*)(rt + 4 * u); *(LAS f32x4*)(RL_ + (u >> 2) * 20 + (u & 3) * 4) = w; }
    __syncthreads();
    for (int rb = F.gw; rb < NR; rb += 2 * F.NGW) {
        const int r0 = rb, r1c = rb + F.NGW; const bool ok1 = r1c < NR; const int r1 = ok1 ? r1c : rb;
        const int bi0 = r0 < RL ? (r0 >> 11) : 16, bi1 = r1 < RL ? (r1 >> 11) : 16;
        const float* ml0 = MOD + ((size_t)L * 17 + bi0) * 6144 + 3 * 1024 + lane; const float* ml1 = MOD + ((size_t)L * 17 + bi1) * 6144 + 3 * 1024 + lane;
        float x0[16], x1[16];
        bf16* hp0 = H + (size_t)r0 * D + lane; bf16* hp1 = H + (size_t)r1 * D + lane;
#pragma unroll
        for (int i = 0; i < 16; ++i) { x0[i] = __uint_as_float(L == 0 ? xa[i] : xa[i] << 16) + __uint_as_float(wa[i] << 16); x1[i] = __uint_as_float(L == 0 ? xb[i] : xb[i] << 16) + __uint_as_float(wb[i] << 16); }
        __builtin_amdgcn_sched_barrier(0);
        {
            float sa[16], sh[16], ss = 0.f;
#pragma unroll
            for (int i = 0; i < 16; ++i) { sa[i] = ml0[1024 + 64 * i]; sh[i] = ml0[64 * i]; }
#pragma unroll
            for (int i = 0; i < 16; ++i) ss += x0[i] * x0[i];
            const float rinv = rsqrtf(wave_sum(ss) * (1.f / D) + EPS);
#pragma unroll
            for (int i = 0; i < 16; ++i) { x0[i] = x0[i] * rinv * sa[i] + sh[i]; hp0[64 * i] = (bf16)f2bf(x0[i]); }
        }
        __builtin_amdgcn_sched_barrier(0);
        {
            float sa[16], sh[16], ss = 0.f;
#pragma unroll
            for (int i = 0; i < 16; ++i) { sa[i] = ml1[1024 + 64 * i]; sh[i] = ml1[64 * i]; }
#pragma unroll
            for (int i = 0; i < 16; ++i) ss += x1[i] * x1[i];
            const float rinv = rsqrtf(wave_sum(ss) * (1.f / D) + EPS);
#pragma unroll
            for (int i = 0; i < 16; ++i) { x1[i] = x1[i] * rinv * sa[i] + sh[i]; if (ok1) hp1[64 * i] = (bf16)f2bf(x1[i]); }
        }
        __builtin_amdgcn_sched_barrier(0);
        if (rb + 2 * F.NGW < NR) N2_LOAD(rb + 2 * F.NGW);
        __builtin_amdgcn_sched_barrier(0);
        float lga[16], lgb[16];
#pragma unroll
        for (int e = 0; e < 16; ++e) { lga[e] = 0.f; lgb[e] = 0.f; }
#pragma unroll
        for (int i = 0; i < 16; ++i) {
            const LAS float* rr = RL_ + (lane + 64 * i) * 20; const float xa = x0[i], xb = x1[i];
#pragma unroll
            for (int q = 0; q < 4; ++q) { const f32x4 w = *(const LAS f32x4*)(rr + 4 * q);
#pragma unroll
                for (int c = 0; c < 4; ++c) { lga[4 * q + c] += xa * w[c]; lgb[4 * q + c] += xb * w[c]; } }
            asm volatile("" : "+v"(lga[0]), "+v"(lga[1]), "+v"(lga[2]), "+v"(lga[3]), "+v"(lga[4]), "+v"(lga[5]), "+v"(lga[6]), "+v"(lga[7]), "+v"(lga[8]), "+v"(lga[9]), "+v"(lga[10]), "+v"(lga[11]), "+v"(lga[12]), "+v"(lga[13]), "+v"(lga[14]), "+v"(lga[15]) :: "memory");
            asm volatile("" : "+v"(lgb[0]), "+v"(lgb[1]), "+v"(lgb[2]), "+v"(lgb[3]), "+v"(lgb[4]), "+v"(lgb[5]), "+v"(lgb[6]), "+v"(lgb[7]), "+v"(lgb[8]), "+v"(lgb[9]), "+v"(lgb[10]), "+v"(lgb[11]), "+v"(lgb[12]), "+v"(lgb[13]), "+v"(lgb[14]), "+v"(lgb[15]) :: "memory");
        }
#pragma unroll
        for (int rr_ = 0; rr_ < 2; ++rr_) {
            const float t = rr_ ? red16(lgb, lane) : red16(lga, lane);
            float mx = t;
#pragma unroll
            for (int o = 4; o < 64; o <<= 1) mx = fmaxf(mx, __shfl_xor(mx, o));
            const float p = expf(t - mx);
            float sm = p;
#pragma unroll
            for (int o = 4; o < 64; o <<= 1) sm += __shfl_xor(sm, o);
            if ((lane & 3) == 0 && (rr_ == 0 || ok1)) AFF[(size_t)(rr_ ? r1 : r0) * 16 + (lane >> 2)] = p / sm;
        }
    }
}
#undef N2_LOAD
__device__ __forceinline__ void topk_phase(Frame& F, bool with_ctx) {
    PHASE_IDS();
    const float* AFF = FWS(WS_AFF, float); int* INV = FWS(WS_INV, int); int* GIDX = FWS(WS_GIDX, int); float* GATE = FWS(WS_GATE, float);
    volatile LAS int* sm = (volatile LAS int*)F.lds;
    for (int q = blockIdx.x; q < 256; q += F.G) {
        const int b = q >> 4, e = q & 15;
        unsigned key[5];
#pragma unroll
        for (int j = 0; j < 4; ++j) key[j] = __float_as_uint(AFF[(size_t)(b * 2048 + 4 * tid + j) * 16 + e]);
        key[4] = (with_ctx && tid < 256) ? __float_as_uint(AFF[(size_t)(RL + b * 256 + tid) * 16 + e]) : 0u;
        unsigned prefix0 = 0u, prefix1 = 0u;
        for (int bit = 29; bit >= 0; --bit) {
            const unsigned cand0 = prefix0 | (1u << bit), cand1 = prefix1 | (1u << bit);
            int c0 = 0;
#pragma unroll
            for (int j = 0; j < 4; ++j) c0 += __builtin_popcountll(__ballot(key[j] >= cand0));
            const int c1 = __builtin_popcountll(__ballot(key[4] >= cand1));
            if (lane == 0) { sm[(bit & 1) * 16 + F.wave] = c0; sm[(bit & 1) * 16 + 8 + F.wave] = c1; }
            __syncthreads();
            typedef int i32x4_t __attribute__((ext_vector_type(4)));
            const LAS i32x4_t* cv_ = (const LAS i32x4_t*)(F.lds + ((bit & 1) * 16) * 4);
            const i32x4_t a0_ = cv_[0], a1_ = cv_[1], b0_ = cv_[2], b1_ = cv_[3];
            const int tot0 = ((a0_[0] + a0_[1]) + (a0_[2] + a0_[3])) + ((a1_[0] + a1_[1]) + (a1_[2] + a1_[3]));
            const int tot1 = ((b0_[0] + b0_[1]) + (b0_[2] + b0_[3])) + ((b1_[0] + b1_[1]) + (b1_[2] + b1_[3]));
            if (tot0 >= 256) prefix0 = cand0;
            if (tot1 >= 32) prefix1 = cand1;
        }
#pragma unroll 1
        for (int part = 0; part < (with_ctx ? 2 : 1); ++part) {
            const bool lat = part == 0; const unsigned prefix = lat ? prefix0 : prefix1;
            const int cap = lat ? 256 : 32, rowbase = lat ? b * 2048 : RL + b * 256, slotbase = e * SLOTS_E + (lat ? b * 256 : 4096 + b * 32);
            int cg = 0, cq = 0;
#pragma unroll
            for (int j = 0; j < 4; ++j) { const unsigned k = lat ? key[j] : (j == 0 ? key[4] : 0u); const bool ok = lat || (j == 0 && tid < 256); cg += ok && k > prefix; cq += ok && k == prefix; }
            const int v = cg | (cq << 16);
            int x = v;
#pragma unroll
            for (int o = 1; o < 64; o <<= 1) { const int y = __shfl_up(x, o); if (lane >= o) x += y; }
            if (lane == 63) sm[64 + part * 8 + F.wave] = x;
            __syncthreads();
            int wp = 0, total = 0;
            { typedef int i32x4_t __attribute__((ext_vector_type(4))); const LAS i32x4_t* sv_ = (const LAS i32x4_t*)(F.lds + (64 + part * 8) * 4); const i32x4_t s0_ = sv_[0], s1_ = sv_[1];
#pragma unroll
              for (int w = 0; w < 8; ++w) { const int tv = w < 4 ? s0_[w & 3] : s1_[w & 3]; total += tv; if (w < F.wave) wp += tv; } }
            const int excl = x - v + wp, n_gt = total & 0xffff, need_eq = cap - n_gt;
            int eg = excl & 0xffff, eq = excl >> 16;
#pragma unroll
            for (int j = 0; j < 4; ++j) {
                const int t = lat ? 4 * tid + j : tid; const bool ok = lat || (j == 0 && tid < 256); const unsigned k = lat ? key[j] : key[4];
                if (ok) { int pos = -1;
                    if (k > prefix) pos = eg++;
                    else if (k == prefix) { if (eq < need_eq) pos = n_gt + eq; ++eq; }
                    INV[(size_t)(rowbase + t) * 16 + e] = pos;
                    if (pos >= 0) { GIDX[slotbase + pos] = rowbase + t; GATE[slotbase + pos] = __uint_as_float(k); } }
            }
        }
        __syncthreads();
    }
}

__device__ __forceinline__ void attn_map(int vcu, int i, int& bh, int& qb) { bh = (vcu & ~31) + 4 * i + ((vcu & 31) >> 3); qb = vcu & 7; }
__device__ __forceinline__ void conv_chunk(Frame& F, int first_item, int count) {
    int tid_ = threadIdx.x; asm volatile("" : "+v"(tid_)); const int lane = tid_ & 63;
    LAS float* scr = (LAS float*)(F.lds + F.wave * 8448);
    const int first = 6048 + first_item;
#pragma unroll 1
    for (int base = F.gw; base < count; base += 2 * F.NGW) {
        const int i1 = base + F.NGW; const bool h1 = i1 < count;
        PrepJob j0 = prep_decode(F.in, F.ws, first + base), j1 = prep_decode(F.in, F.ws, first + (h1 ? i1 : base));
        f32x4 v0[8], v1[8];
        prep_load(j0, v0, lane); prep_load(j1, v1, lane);
        prep_store(j0, v0, scr, lane);
        if (h1) prep_store(j1, v1, scr, lane);
    }
    asm volatile("s_waitcnt vmcnt(0) lgkmcnt(0)" ::: "memory");
    __syncthreads();
}
__device__ __forceinline__ void attn_mla_phase(Frame& F, bool need_ctx, int L) {
    typedef attn_body::bf16 abf;
    const bf16* Q = FWS(WS_ACT + AO_Q, bf16); const bf16* K = FWS(WS_ACT + AO_K, bf16); const bf16* V = FWS(WS_ACT + AO_V, bf16); bf16* O = FWS(WS_ACT + AO_O, bf16);
    if (F.G != 256) return;
    attn_body::bf16x8 qr[6]; int s0 = 0; bool pre = false; const int n = need_ctx ? 9 : 8;
    for (int i = 0; i < n; ++i) {
        int bh, qb; attn_map(F.vcu, i & 7, bh, qb); const bool lat = i < 8; if (!lat) bh = F.vcu;
        const int b = bh >> 4, h = bh & 15;
        int bhn, qbn; attn_map(F.vcu, (i + 1) & 7, bhn, qbn); const bool latn = i + 1 < 8; if (!latn) bhn = F.vcu;
        const int bn = bhn >> 4, hn = bhn & 15;
        const attn_body::NextU nx{i + 1 < n, (const abf*)(Q + hn * 96), (const abf*)(K + hn * 96), (const abf*)(V + hn * 64), latn ? bn * 2048 + 256 * qbn : RL + bn * 256, RL + bn * 256};
        s0 = attn_body::attn_unit<8, false, 96, false>((const abf*)(Q + h * 96), 1536, (const abf*)(K + h * 96), (const abf*)(V + h * 64), 1536, 1024, (abf*)(O + h * 64),
                                                lat ? b * 2048 + 256 * qb : RL + b * 256, RL + b * 256, 4, b * 2048, lat ? 36 : 4, F.ldsg, qr, pre, s0, nx);
        pre = nx.on;
    }
}
__device__ __forceinline__ void attn_dense64_phase(Frame& F, bool need_ctx, int L) {
    typedef attn_body::bf16 abf;
    const bf16* Q = FWS(WS_ACT + AO_Q, bf16); const bf16* K = FWS(WS_ACT + AO_K, bf16); const bf16* V = FWS(WS_ACT + AO_V, bf16); bf16* O = FWS(WS_ACT + AO_O, bf16);
    if (F.G != 256) return;
    attn_body::bf16x8 qr[6]; int s0 = 0; bool pre = false; const int n = need_ctx ? 9 : 8, cv = F.vcu & 7;
    for (int i = 0; i < n; ++i) {
        if (i == cv) { conv_chunk(F, L == 0 ? 0 : 3 * 24576, L == 0 ? 3 * 24576 : 24576); _Pragma("unroll") for (int d = 0; d < 4; ++d) qr[d] = attn_body::bf16x8{}; }
        int bh, qb; attn_map(F.vcu, i & 7, bh, qb); const bool lat = i < 8; if (!lat) bh = F.vcu;
        const int b = bh >> 4, h = bh & 15, kh = h >> 2;
        int bhn, qbn; attn_map(F.vcu, (i + 1) & 7, bhn, qbn); const bool latn = i + 1 < 8; if (!latn) bhn = F.vcu;
        const int bn = bhn >> 4, hn = bhn & 15, khn = hn >> 2;
        const attn_body::NextU nx{i + 1 < n && i + 1 != cv, (const abf*)(Q + hn * 64), (const abf*)(K + khn * 64), (const abf*)(V + khn * 64), latn ? bn * 2048 + 256 * qbn : RL + bn * 256, RL + bn * 256};
        s0 = attn_body::attn_unit<8>((const abf*)(Q + h * 64), 1024, (const abf*)(K + kh * 64), (const abf*)(V + kh * 64), 256, 256, (abf*)(O + h * 64),
                                     lat ? b * 2048 + 256 * qb : RL + b * 256, RL + b * 256, 4, b * 2048, lat ? 36 : 4, F.ldsg, qr, pre, s0, nx);
        pre = nx.on;
    }
}
__device__ __forceinline__ void attn_na_phase(Frame& F, bool need_ctx, int L) {
    typedef attn_body::bf16 abf;
    const bf16* Q = FWS(WS_ACT + AO_Q, bf16); const bf16* K = FWS(WS_ACT + AO_K, bf16); const bf16* V = FWS(WS_ACT + AO_V, bf16); bf16* O = FWS(WS_ACT + AO_O, bf16);
    if (F.G != 256) return;
    const int s_ = (F.vcu & 31) >> 3, g = F.vcu & 7, h = 2 * (F.vcu >> 5) + (s_ & 1);
    {
        int tid_ = threadIdx.x; asm volatile("" : "+v"(tid_));
        LAS float* T = (LAS float*)(F.lds + 86016);
        const float* rp = F.in[I_CRPB] + h * 15 * 31;
        for (int e = tid_; e < 15 * (int)attn_body::NA_STRIP; e += NTHR) {
            const int dr = e / (int)attn_body::NA_STRIP, o = e - dr * (int)attn_body::NA_STRIP;
            int dc = 0; bool real = false;
            if (o < 112) { dc = o - 56; real = dc >= -8 && dc <= 7; }
            else { const int o2 = o - 112, p = o2 / 80, w = o2 - p * 80;
                   if (w < 16) { dc = w - p; real = true; } else if (w >= 64) { dc = w - 73 - p; real = true; } }
            T[e] = real ? rp[dr * 31 + dc + 15] * LOG2E : -INFINITY;
        }
        if (tid_ < 136) T[15 * (int)attn_body::NA_STRIP + tid_] = tid_ < 68 ? 0.f : -INFINITY;
        __syncthreads();
    }
    attn_body::bf16x8 qr[6]; int s0 = 0; bool pre = false;
    const int bc = F.vcu >> 4, hc = F.vcu & 15;
    for (int i = 0; i < 8; ++i) {
        const int b = 8 * (s_ >> 1) + i, gi = (g + i) & 7, gn = (g + i + 1) & 7;
        const int lo = min(max(4 * gi - 4, 0), 24), hiR = min(max(4 * gi - 1, 0), 24) + 8, nwin = hiR - lo;
        const bool last = i == 7; const int hn = last ? hc : h, bn = last ? bc : b + 1;
        const attn_body::NextU nx{!last || need_ctx, (const abf*)(Q + hn * 64), (const abf*)(K + hn * 64), (const abf*)(V + hn * 64), last ? RL + bn * 256 : bn * 2048 + 256 * gn, RL + bn * 256};
        s0 = attn_body::attn_unit<24, true>((const abf*)(Q + h * 64), 1024, (const abf*)(K + h * 64), (const abf*)(V + h * 64), 1024, 1024, (abf*)(O + h * 64),
                                           b * 2048 + 256 * gi, RL + b * 256, 4, b * 2048 + 64 * lo, (4 + nwin + 1) & ~1, F.ldsg, qr, pre, s0, nx, 4 * gi, lo, nwin);
        pre = nx.on;
    }
    if (need_ctx) { const attn_body::NextU nx{false, nullptr, nullptr, nullptr, 0, 0};
        attn_body::attn_unit<8>((const abf*)(Q + hc * 64), 1024, (const abf*)(K + hc * 64), (const abf*)(V + hc * 64), 1024, 1024, (abf*)(O + hc * 64),
                                RL + bc * 256, RL + bc * 256, 4, bc * 2048, 4, F.ldsg, qr, pre, s0, nx); }
}

constexpr int NPHASE = 39;
#define PH(l, s) (2 + 9 * (l) + (s))
#if MK_PER_PHASE
#define SEAM() do { } while (0)
#else
#define SEAM() xcd_barrier(bar)
#endif
#ifndef DBG_SLOT
#define DBG_SLOT -1
#endif
#ifndef DBG_LAYER
#define DBG_LAYER -1
#endif
#ifndef REP_MASK
#define REP_MASK 0
#endif
#define IDEMP(l, s) ((s) == 0 ? (l) == 0 : (s) == 4 ? (l) == 0 : (s) == 1 ? (l) != 1 : true)
#ifndef REP_LAYER
#define REP_LAYER -1
#endif
#define NREP(l, s) ((((REP_MASK) >> (s)) & 1) && IDEMP(l, s) && (REP_LAYER < 0 || REP_LAYER == (l)) ? 2 : 1)
#define SLOT_ON(l, s) ((DBG_SLOT < 0 || DBG_SLOT == (s)) && (DBG_LAYER < 0 || DBG_LAYER == (l)))
#define IN(k) (lo <= (k) && (k) < hi)

template <int L> __device__ __forceinline__ void layer_program(Frame& F, const XcdBarrier& bar, int lo, int hi) {
    constexpr int KIND = L % 3, J = L / 3;
    constexpr bool need_ctx = L < DEPTH - 1;
    constexpr int MROWS = need_ctx ? RT : RL;
    bf16* WSB = FWS(WS_WS, bf16);
    const float* MOD = FWS(WS_MOD, float);
    float* ropeA = FWS(WS_ROPE, float); float* ropeB = ropeA + 2 * 2048 * 32;
    bf16* H = FWS(WS_H, bf16);
    if (SLOT_ON(L, 0) && IN(PH(L, 0))) for (int rep_ = 0; rep_ < NREP(L, 0); ++rep_) { norm1_phase<L>(F); SEAM(); }
    if (SLOT_ON(L, 1) && IN(PH(L, 1))) for (int rep_ = 0; rep_ < NREP(L, 1); ++rep_) {
        if (KIND == 0) {
            pg8::Gemm g{H, WSB + (J ? WO_AQKV1 : WO_AQKV0) / 2, 1024, nullptr}; pg8::StaticOrder S; S.init(RT, 1536, F.G, (int)blockIdx.x);
            EpiQKV<0> E{FWS(WS_ACT, bf16), F.in[I_AQN] + J * 64, F.in[I_AKN] + J * 64, ropeA, ropeA + 2048 * 32};
            pg8::gemm_phase<EpiQKV<0>, pg8::StaticOrder, false>(F.lds, g, S, E);
        } else if (KIND == 1) {
            pg8::Gemm g{H, WSB + WO_BDN / 2, 1024, nullptr}; pg8::StaticOrder S; S.init(RT, 768, F.G, (int)blockIdx.x);
            EpiBdown E{FWS(WS_ACT + AO_CQ, bf16), FWS(WS_ACT + AO_CKV, bf16), FWS(WS_ACT + AO_K, bf16), FWS(WS_RSQP, float), F.in[I_BKN] + 64, ropeB, ropeB + 2048 * 16};
            pg8::gemm_phase<EpiBdown, pg8::StaticOrder, false>(F.lds, g, S, E);
        } else {
            pg8::Gemm g{H, WSB + WO_CQKV / 2, 1024, nullptr}; pg8::StaticOrder S; S.init(RT, 3072, F.G, (int)blockIdx.x);
            EpiQKV<2> E{FWS(WS_ACT, bf16), F.in[I_CQN], F.in[I_CKN], nullptr, nullptr};
            pg8::gemm_phase<EpiQKV<2>, pg8::StaticOrder, false>(F.lds, g, S, E);
        }
        SEAM();
    }
    if (KIND == 1) { if (SLOT_ON(L, 2) && IN(PH(L, 2))) for (int rep_ = 0; rep_ < NREP(L, 2); ++rep_) {
#ifndef DBG_NO_UQ
        { pg8::Gemm g{FWS(WS_ACT + AO_CQ, bf16), WSB + WO_BUQ / 2, 384, nullptr}; pg8::StaticOrder S; S.init(RT, 1536, F.G, (int)blockIdx.x);
          EpiBuq E{FWS(WS_ACT + AO_Q, bf16), FWS(WS_RSQP, float), F.in[I_BQN], ropeB, ropeB + 2048 * 16};
          pg8::gemm_phase<EpiBuq, pg8::StaticOrder, false>(F.lds, g, S, E); }
#endif
#ifndef DBG_NO_UKV
        { pg8::Gemm g{FWS(WS_ACT + AO_CKV, bf16), WSB + WO_BUKV / 2, 256, nullptr}; pg8::StaticOrder S; S.init(RT, 2048, F.G, (int)blockIdx.x);
          EpiBukv E{FWS(WS_ACT + AO_K, bf16), FWS(WS_ACT + AO_V, bf16), FWS(WS_RSQP, float), F.in[I_BKN]};
          pg8::gemm_phase<EpiBukv, pg8::StaticOrder, false>(F.lds, g, S, E); }
#endif
        SEAM();
    } }
    if (SLOT_ON(L, 3) && IN(PH(L, 3))) for (int rep_ = 0; rep_ < NREP(L, 3); ++rep_) {
        if (KIND == 0) attn_dense64_phase(F, need_ctx, L);
        else if (KIND == 1) attn_mla_phase(F, need_ctx, L);
        else attn_na_phase(F, need_ctx, L);
        SEAM();
    }
    if (SLOT_ON(L, 4) && IN(PH(L, 4))) for (int rep_ = 0; rep_ < NREP(L, 4); ++rep_) {
        const bf16* Wt = WSB + (KIND == 0 ? (J ? WO_AWO1 : WO_AWO0) : (KIND == 1 ? WO_BWO : WO_CWO)) / 2;
        pg8::Gemm g{FWS(WS_ACT + AO_O, bf16), Wt, 1024, nullptr}; pg8::StaticOrder S; S.init(MROWS, 1024, F.G, (int)blockIdx.x);
        EpiWo E{FWS(WS_WOUT, bf16), MOD + (size_t)L * 17 * 6144};
        pg8::gemm_phase<EpiWo, pg8::StaticOrder, false>(F.lds, g, S, E);
        SEAM();
    }
    if (SLOT_ON(L, 5) && IN(PH(L, 5))) for (int rep_ = 0; rep_ < NREP(L, 5); ++rep_) { norm2_phase<L>(F, MROWS); SEAM(); }
    if (SLOT_ON(L, 6) && IN(PH(L, 6))) for (int rep_ = 0; rep_ < NREP(L, 6); ++rep_) { topk_phase(F, need_ctx); SEAM(); }
    if (SLOT_ON(L, 7) && IN(PH(L, 7))) for (int rep_ = 0; rep_ < NREP(L, 7); ++rep_) {
        pg8::Gemm g{H, FWS(WS_WMOE + (size_t)L * 96 * MiB, bf16), 1024, FWS(WS_GIDX, int)}; pg8::MoeOrder S{need_ctx ? 18 : 16, 8, F.G, (int)blockIdx.x};
        EpiMoeGU E{FWS(WS_ACT + AO_HID, bf16)};
        pg8::gemm_phase<EpiMoeGU, pg8::MoeOrder, true>(F.lds, g, S, E);
        SEAM();
    }
    if (SLOT_ON(L, 8) && IN(PH(L, 8))) for (int rep_ = 0; rep_ < NREP(L, 8); ++rep_) {
        pg8::Gemm g{FWS(WS_ACT + AO_HID, bf16), FWS(WS_WMOE + (size_t)L * 96 * MiB + 64 * MiB, bf16), 1024, nullptr}; pg8::MoeOrder S{need_ctx ? 18 : 16, 4, F.G, (int)blockIdx.x};
        EpiMoeDown E{FWS(WS_ACT + AO_Y, bf16), FWS(WS_GATE, float)};
        pg8::gemm_phase<EpiMoeDown, pg8::MoeOrder, false>(F.lds, g, S, E);
        SEAM();
    }
}

__global__ void __launch_bounds__(NTHR, 2) fwd(Args args) {
    extern __shared__ __attribute__((aligned(16))) unsigned char lds_raw[];
    Frame F;
    F.lds = (LAS unsigned char*)lds_raw; F.ldsg = (char*)lds_raw;
    F.wave = __builtin_amdgcn_readfirstlane(threadIdx.x >> 6);
    F.G = gridDim.x; { const int bx = blockIdx.x; F.vcu = (F.G % 8 == 0) ? (bx % 8) * (F.G / 8) + bx / 8 : bx; }
    F.gw = F.vcu * NWAVES + F.wave; F.NGW = F.G * NWAVES;
    F.in = args.in; F.out = args.out; F.ws = args.ws;
    volatile LAS unsigned* MISC = (volatile LAS unsigned*)(F.lds + MISC_OFF);
    for (int u = threadIdx.x; u < (LDS_BYTES - 131072) / 4; u += NTHR) ((LAS unsigned*)(F.lds + 131072))[u] = 0u;
    __syncthreads();
    XcdBarrier bar; bar.bar = (unsigned*)(F.ws + WS_CTL) + CW_BAR; bar.x = 0; bar.st = nullptr;
#if !MK_PER_PHASE
    bar = xcd_barrier_post((unsigned*)(F.ws + WS_CTL) + CW_BAR, MISC + 8);
#else
    (void)MISC;
#endif
    const int lo = args.ph_lo, hi = args.ph_hi; (void)lo; (void)hi;
    if (SLOT_ON(-2, 10) && IN(0)) _Pragma("unroll 1") for (int rep_ = 0; rep_ < NREP(0, 10); ++rep_) { p0_prologue(F); SEAM(); }
    if (SLOT_ON(-2, 11) && IN(1)) { p1_modreduce(F); SEAM(); }
    layer_program<0>(F, bar, lo, hi);
    layer_program<1>(F, bar, lo, hi);
    layer_program<2>(F, bar, lo, hi);
    layer_program<3>(F, bar, lo, hi);
    if (SLOT_ON(-2, 12) && IN(38)) final_phase(F);
}

extern "C" void kernel_launch(void* const* d_in, const int* in_sizes, int n_in, void* d_out, int out_size, void* d_ws, size_t ws_size, hipStream_t stream) {
    static int grid = 0;
    if (grid == 0) {
        if (n_in != 30 || in_sizes[0] != RL * D || out_size != RL * D || ws_size < WS_END) { fprintf(stderr, "kernel_launch: unexpected shapes / workspace (%d inputs, ws %zu < %zu)\n", n_in, ws_size, (size_t)WS_END); grid = -1; return; }
        int dev = 0, cus = 0, per_cu = 0;
        if (hipGetDevice(&dev) != hipSuccess || hipDeviceGetAttribute(&cus, hipDeviceAttributeMultiprocessorCount, dev) != hipSuccess) { grid = -1; return; }
        if (hipFuncSetAttribute((const void*)fwd, hipFuncAttributeMaxDynamicSharedMemorySize, LDS_BYTES) != hipSuccess) { fprintf(stderr, "kernel_launch: hipFuncSetAttribute failed\n"); grid = -1; return; }
        if (hipOccupancyMaxActiveBlocksPerMultiprocessor(&per_cu, (const void*)fwd, NTHR, LDS_BYTES) != hipSuccess || per_cu < 1) fprintf(stderr, "kernel_launch: occupancy query reports %d\n", per_cu);
        (void)hipGetLastError();
        grid = cus;
    }
    if (grid < 0) return;
    (void)hipMemsetAsync((char*)d_ws + WS_CTL, 0, CTL_ZERO_BYTES, stream);
    Args a{};
    for (int i = 0; i < 30; ++i) a.in[i] = (const float*)d_in[i];
    a.out = (float*)d_out; a.ws = (unsigned char*)d_ws;
#if MK_PER_PHASE
    for (int ph = 0; ph < NPHASE; ++ph) {
        if (ph >= 2 && ph < 38 && ((ph - 2) % 9) == 2 && (((ph - 2) / 9) % 3) != 1) continue;
        a.ph_lo = ph; a.ph_hi = ph + 1;
        hipLaunchKernelGGL(fwd, dim3(grid), dim3(NTHR), LDS_BYTES, stream, a);
    }
#else
    a.ph_lo = 0; a.ph_hi = NPHASE;
    hipLaunchKernelGGL(fwd, dim3(grid), dim3(NTHR), LDS_BYTES, stream, a);
#endif
}
```
